# Optimizing an MI355X kernel written in HIP

```python
import jax, jax.numpy as jnp
from jax import lax
import numpy as np

D_MODEL = 2048
BATCH = 1
SEQ = 8192
DEPTH = 1

N_META = 16
D_MIX = D_MODEL
HEAD_DIM = 128
ATT_WIDTH = D_MIX // 2
N_ATT_HEADS = ATT_WIDTH // HEAD_DIM
CONV_CH = D_MIX - ATT_WIDTH
N_CONV_GROUPS = 8
CONV_KERNEL = 31
Q_BLOCK = 128
IN_COLS = 3 * ATT_WIDTH + N_ATT_HEADS + 2 * CONV_CH
SPLITS = [ATT_WIDTH, 2 * ATT_WIDTH, 3 * ATT_WIDTH, 3 * ATT_WIDTH + N_ATT_HEADS,
          3 * ATT_WIDTH + N_ATT_HEADS + CONV_CH]
N_EXPERTS = 32
TOP_K = 4
D_FF = D_MODEL
SWIGLU_LIMIT = 7.0
SWIGLU_ALPHA = 1.702
MOE_BLOCK = 128
NORM_EPS = 1e-5
NEG_BIG = -1e30

kernel_name = "hymba_fox_conformer_moe_block"


def rms_norm(x, g):
    xf = x.astype(jnp.float32)
    y = xf * lax.rsqrt(jnp.mean(xf * xf, axis=-1, keepdims=True) + NORM_EPS)
    return (y * g.astype(jnp.float32)).astype(x.dtype)


def group_norm(u, g, b):
    bsz, length, ch = u.shape
    ug = u.astype(jnp.float32).reshape(bsz, length, N_CONV_GROUPS, ch // N_CONV_GROUPS)
    mu = jnp.mean(ug, axis=-1, keepdims=True)
    var = jnp.mean(jnp.square(ug - mu), axis=-1, keepdims=True)
    y = ((ug - mu) * lax.rsqrt(var + NORM_EPS)).reshape(bsz, length, ch)
    return (y * g.astype(jnp.float32) + b.astype(jnp.float32)).astype(u.dtype)


def conformer_conv_mixer(glu_a, glu_g, b_glu, conv_w, conv_b, gn_g, gn_b):
    u = (glu_a + b_glu[:CONV_CH]) * jax.nn.sigmoid(glu_g + b_glu[CONV_CH:])
    u = lax.conv_general_dilated(
        u, conv_w[:, None, :].astype(u.dtype), window_strides=(1,),
        padding=[(CONV_KERNEL - 1, 0)], dimension_numbers=("NWC", "WIO", "NWC"),
        feature_group_count=CONV_CH) + conv_b
    return jax.nn.silu(group_norm(u, gn_g, gn_b))


def forgetting_attention(q, k, v, log_f):
    bsz, length, heads, dh = q.shape
    pad = Q_BLOCK - N_META
    pw = ((0, 0), (pad, 0), (0, 0), (0, 0))
    q, k, v = jnp.pad(q, pw), jnp.pad(k, pw), jnp.pad(v, pw)
    log_f = jnp.pad(log_f, ((0, 0), (pad, 0), (0, 0)))
    lp = length + pad
    nb = lp // Q_BLOCK
    c = jnp.cumsum(log_f, axis=1)
    c_k = c.transpose(0, 2, 1)
    kh = k.transpose(0, 2, 1, 3)
    vh = v.transpose(0, 2, 1, 3)
    qb = q.reshape(bsz, nb, Q_BLOCK, heads, dh).transpose(1, 0, 3, 2, 4)
    cb = c.reshape(bsz, nb, Q_BLOCK, heads).transpose(1, 0, 3, 2)
    key_pos = jnp.arange(lp)
    scale = 1.0 / float(np.sqrt(dh))

    def block(args):
        i, qi, ci = args
        s = jnp.einsum("bhqd,bhkd->bhqk", qi, kh).astype(jnp.float32) * scale
        s = s + ci[..., None] - c_k[:, :, None, :]
        q_pos = i * Q_BLOCK + jnp.arange(Q_BLOCK)
        valid = (key_pos[None, :] <= q_pos[:, None]) & (key_pos[None, :] >= pad)
        s = jnp.where(valid, s, NEG_BIG)
        p = jax.nn.softmax(s, axis=-1)
        return jnp.einsum("bhqk,bhkd->bhqd", p.astype(vh.dtype), vh)

    o = lax.map(block, (jnp.arange(nb), qb, cb))
    o = o.transpose(1, 0, 3, 2, 4).reshape(bsz, lp, heads * dh)
    return o[:, pad:, :]


def moe_ffn(h, router_w, router_b, w_gate_up, b_gate_up, w_down, b_down):
    t, d = h.shape
    logits = (h @ router_w).astype(jnp.float32) + router_b.astype(jnp.float32)
    top_v, top_i = lax.top_k(logits, TOP_K)
    gates = jax.nn.softmax(top_v, axis=-1)
    tk = t * TOP_K
    flat_e = top_i.reshape(-1)
    flat_tok = jnp.arange(tk) // TOP_K
    order = jnp.argsort(flat_e)
    sorted_e = flat_e[order]
    sorted_tok = flat_tok[order]
    sorted_gate = gates.reshape(-1)[order]
    counts = jnp.zeros((N_EXPERTS,), jnp.int32).at[flat_e].add(1)
    grp_start = jnp.cumsum(counts) - counts
    padded = ((counts + MOE_BLOCK - 1) // MOE_BLOCK) * MOE_BLOCK
    pad_end = jnp.cumsum(padded)
    pad_start = pad_end - padded
    dest = pad_start[sorted_e] + (jnp.arange(tk) - grp_start[sorted_e])
    n_blocks = -(-(tk + N_EXPERTS * (MOE_BLOCK - 1)) // MOE_BLOCK)
    n_rows = n_blocks * MOE_BLOCK
    row_tok = jnp.full((n_rows,), t, jnp.int32).at[dest].set(sorted_tok)
    h_ext = jnp.concatenate([h, jnp.zeros((1, d), h.dtype)], axis=0)
    xb = h_ext[row_tok].reshape(n_blocks, MOE_BLOCK, d)
    block_expert = jnp.minimum(
        jnp.searchsorted(pad_end, jnp.arange(n_blocks) * MOE_BLOCK, side="right"), N_EXPERTS - 1)

    def expert_block(args):
        xblk, e = args
        gu = xblk @ w_gate_up[e] + b_gate_up[e]
        gate, up = jnp.split(gu, 2, axis=-1)
        gate = jnp.minimum(gate, SWIGLU_LIMIT)
        up = jnp.clip(up, -SWIGLU_LIMIT, SWIGLU_LIMIT)
        act = gate * jax.nn.sigmoid(SWIGLU_ALPHA * gate) * (up + 1.0)
        return act @ w_down[e] + b_down[e]

    yb = lax.map(expert_block, (xb, block_expert)).reshape(n_rows, d)
    contrib = yb[dest] * sorted_gate[:, None].astype(yb.dtype)
    return jnp.zeros((t, d), yb.dtype).at[sorted_tok].add(contrib)


def setup_inputs(seed: int = 0) -> dict:
    key = jax.random.key(seed)
    ks = jax.random.split(key, 20)
    f32 = jnp.float32
    nrm = lambda k, shape, s: (jax.random.normal(k, shape, f32) * s)
    x = jax.random.normal(ks[0], (BATCH, SEQ, D_MODEL), f32)
    meta_tokens = nrm(ks[1], (N_META, D_MODEL), 1.0)
    norm_mix_g = 1.0 + nrm(ks[2], (DEPTH, D_MODEL), 0.02)
    w_in = nrm(ks[3], (DEPTH, D_MODEL, IN_COLS), D_MODEL ** -0.5)
    b_fgate = jnp.linspace(1.0, 6.0, N_ATT_HEADS, dtype=f32)[None, :] + nrm(ks[4], (DEPTH, N_ATT_HEADS), 0.1)
    b_glu = nrm(ks[5], (DEPTH, 2 * CONV_CH), 0.02)
    conv_w = nrm(ks[6], (DEPTH, CONV_KERNEL, CONV_CH), CONV_KERNEL ** -0.5)
    conv_b = nrm(ks[7], (DEPTH, CONV_CH), 0.02)
    gn_g = 1.0 + nrm(ks[8], (DEPTH, CONV_CH), 0.02)
    gn_b = nrm(ks[9], (DEPTH, CONV_CH), 0.02)
    w_out = nrm(ks[10], (DEPTH, D_MIX, D_MODEL), D_MIX ** -0.5)
    norm_ffn_g = 1.0 + nrm(ks[11], (DEPTH, D_MODEL), 0.02)
    router_w = nrm(ks[12], (DEPTH, D_MODEL, N_EXPERTS), D_MODEL ** -0.5)
    router_b = nrm(ks[13], (DEPTH, N_EXPERTS), 0.01)
    w_gate_up = nrm(ks[14], (DEPTH, N_EXPERTS, D_MODEL, 2 * D_FF), D_MODEL ** -0.5)
    b_gate_up = nrm(ks[15], (DEPTH, N_EXPERTS, 2 * D_FF), 0.02)
    w_down = nrm(ks[16], (DEPTH, N_EXPERTS, D_FF, D_MODEL), D_FF ** -0.5)
    b_down = nrm(ks[17], (DEPTH, N_EXPERTS, D_MODEL), 0.02)
    norm_final_g = 1.0 + nrm(ks[18], (D_MODEL,), 0.02)
    return {"x": x, "meta_tokens": meta_tokens, "norm_mix_g": norm_mix_g, "w_in": w_in,
            "b_fgate": b_fgate, "b_glu": b_glu, "conv_w": conv_w, "conv_b": conv_b,
            "gn_g": gn_g, "gn_b": gn_b, "w_out": w_out, "norm_ffn_g": norm_ffn_g,
            "router_w": router_w, "router_b": router_b, "w_gate_up": w_gate_up,
            "b_gate_up": b_gate_up, "w_down": w_down, "b_down": b_down,
            "norm_final_g": norm_final_g}


def reference(x, meta_tokens, norm_mix_g, w_in, b_fgate, b_glu, conv_w, conv_b, gn_g, gn_b,
              w_out, norm_ffn_g, router_w, router_b, w_gate_up, b_gate_up, w_down, b_down,
              norm_final_g):
    bsz = x.shape[0]
    meta = jnp.broadcast_to(meta_tokens[None].astype(x.dtype), (bsz, N_META, D_MODEL))
    h = jnp.concatenate([meta, x], axis=1)
    length = h.shape[1]
    for layer in range(DEPTH):
        hn = rms_norm(h, norm_mix_g[layer])
        proj = hn @ w_in[layer]
        q, k, v, f_logit, glu_a, glu_g = jnp.split(proj, SPLITS, axis=-1)
        hs = (bsz, length, N_ATT_HEADS, HEAD_DIM)
        log_f = jax.nn.log_sigmoid((f_logit + b_fgate[layer]).astype(jnp.float32))
        att = forgetting_attention(q.reshape(hs), k.reshape(hs), v.reshape(hs), log_f)
        conv = conformer_conv_mixer(glu_a, glu_g, b_glu[layer], conv_w[layer], conv_b[layer],
                                    gn_g[layer], gn_b[layer])
        mixed = jnp.concatenate([att, conv], axis=-1)
        h = h + mixed @ w_out[layer]
        hn2 = rms_norm(h, norm_ffn_g[layer]).reshape(bsz * length, D_MODEL)
        ff = moe_ffn(hn2, router_w[layer], router_b[layer], w_gate_up[layer], b_gate_up[layer],
                     w_down[layer], b_down[layer])
        h = h + ff.reshape(bsz, length, D_MODEL)
    return rms_norm(h, norm_final_g)[:, N_META:, :]
```

```cpp
#include <hip/hip_runtime.h>
#include <hip/hip_bf16.h>
#include <cstdio>
#include <cstdint>
namespace pg8 {
#define PG8_LAS __attribute__((address_space(3)))
typedef unsigned short bf16_t;
typedef short bf16x8 __attribute__((ext_vector_type(8)));
typedef float f32x4 __attribute__((ext_vector_type(4)));
typedef unsigned u32x4 __attribute__((ext_vector_type(4)));
constexpr int BM = 256, BK = 64, HALF = 128, HTB = HALF * BK * 2  , STAGE_BYTES = 8 * HTB, NXCD = 8, WGM = 8;

__host__ __device__ __forceinline__ int lds_byte(int r, int c) { const int st = (r >> 4) * 2 + (c >> 5), rr = r & 15, cc = c & 31, ob = rr * 64 + cc * 2; return st * 1024 + (ob ^ (((ob >> 9) & 1) << 5)); }
__host__ __device__ __forceinline__ void stage_rc(int b, int& R, int& C) { const int st = b / 1024, sb = b % 1024, swz = sb ^ (((sb >> 9) & 1) << 5); R = (st >> 1) * 16 + swz / 64; C = (st & 1) * 32 + (swz % 64) / 2; }
__host__ __device__ __forceinline__ int perm32(int rho) { const int n = rho >> 4, i = rho & 15; return 8 * (i >> 2) + 4 * n + (i & 3); }

struct Unit { int pm, pn; };
struct Gemm { const bf16_t* A; const bf16_t* Bt; int M, N, K; };

struct StaticOrder {
    int nM, nN, nwg, G, c;
    __host__ __device__ void init(int M, int N, int G_, int c_) { nM = M / BM; nN = N / BM; nwg = nM * nN; G = G_; c = c_; }
    __host__ __device__ bool next(int i, Unit& u) const {
        const long L = (long)i * G + c; if (L >= nwg) return false;
        int wgid = (int)L; { const int q = nwg / NXCD, r = nwg % NXCD, xcd = wgid % NXCD, off = wgid / NXCD; wgid = (xcd < r ? xcd * (q + 1) : r * (q + 1) + (xcd - r) * q) + off; }
        const int nig = WGM * nN, gid = wgid / nig, fm = gid * WGM, gsz = (nM - fm) < WGM ? (nM - fm) : WGM;
        u.pm = fm + ((wgid % nig) % gsz); u.pn = (wgid % nig) / gsz; return true;
    }
    __device__ __forceinline__ void a_ready(const Unit&) const {}
    __device__ __forceinline__ void done(const Unit&) const {}
};

__device__ __forceinline__ unsigned cvt_pk_bf16(float lo, float hi) { unsigned r; asm volatile("v_cvt_pk_bf16_f32 %0, %1, %2" : "=v"(r) : "v"(lo), "v"(hi)); return r; }
typedef float f32x2 __attribute__((ext_vector_type(2)));
__device__ __forceinline__ f32x2 gelu_pk(f32x2 v) {
    const f32x2 av = __builtin_elementwise_abs(v), d = av * 0.2316418882f + 1.0f;
    f32x2 t; t.x = __builtin_amdgcn_rcpf(d.x); t.y = __builtin_amdgcn_rcpf(d.y);
    f32x2 q = t * 0.5307027145f + (-0.7265760135f); q = q * t + 0.7107068705f; q = q * t + (-0.142248368f); q = q * t + 0.127414796f; q = q * t;
    const f32x2 s = (v * v) * (-0.72134752044f);
    f32x2 e; e.x = __builtin_amdgcn_exp2f(s.x); e.y = __builtin_amdgcn_exp2f(s.y);
    const f32x2 m = v * (q * e), r = v - m;
    f32x2 o; o.x = v.x < 0.f ? m.x : r.x; o.y = v.y < 0.f ? m.y : r.y; return o;
}


__device__ __forceinline__ float sigmoidf_fast(float x) { return __builtin_amdgcn_rcpf(1.0f + __builtin_amdgcn_exp2f(-1.4426950408889634f * x)); }
__device__ __forceinline__ u32x4 pack8_bf16(const f32x4 v0, const f32x4 v1) { u32x4 w; w.x = cvt_pk_bf16(v0[0], v0[1]); w.y = cvt_pk_bf16(v0[2], v0[3]); w.z = cvt_pk_bf16(v1[0], v1[1]); w.w = cvt_pk_bf16(v1[2], v1[3]); return w; }

struct EpiIn {
    static constexpr bool PERM = true, AFTER_DRAIN = false;
    bf16_t* Q; size_t koff, voff; bf16_t* U; const float* bglu;
    __device__ __forceinline__ void operator()(const f32x4 (&acc)[2][2][4][2], const Unit& u, int wr, int wc, int fr, int fq) const {
        const int pn = u.pn, pm = u.pm, dcol = wc * 32 + 8 * fq;
        if (pn < 12) {
            const int which = pn >> 2;
            if (which == 0 && pm >= 32) return;
            const size_t boff = which == 0 ? 0 : (which == 1 ? koff : voff);
            bf16_t* base = (bf16_t*)((unsigned char*)Q + boff);
            const int rph = which == 0 ? 8192 : 8256;
#pragma unroll
            for (int ai = 0; ai < 2; ++ai)
#pragma unroll
                for (int m = 0; m < 4; ++m) {
                    const int rl = ai * HALF + wr * 64 + m * 16 + fr;
                    const bool ok = pm < 32 || rl < 16;
                    const int idx = pm < 32 ? pm * BM + rl + (which ? 64 : 0) : 48 + rl;
#pragma unroll
                    for (int bj = 0; bj < 2; ++bj) { const int head = 2 * (pn & 3) + bj;
                        if (ok) *(u32x4*)(base + ((size_t)head * rph + idx) * 128 + dcol) = pack8_bf16(acc[ai][bj][m][0], acc[ai][bj][m][1]); }
                }
        } else {
            const int c0 = 128 * (pn - 12) + dcol;
            f32x4 ba[2], bg[2];
#pragma unroll
            for (int n = 0; n < 2; ++n) { ba[n] = *(const f32x4*)(bglu + c0 + 4 * n); bg[n] = *(const f32x4*)(bglu + 1024 + c0 + 4 * n); }
#pragma unroll
            for (int ai = 0; ai < 2; ++ai)
#pragma unroll
                for (int m = 0; m < 4; ++m) {
                    const int rl = ai * HALF + wr * 64 + m * 16 + fr;
                    const bool ok = pm < 32 || rl < 16;
                    const int pos = pm < 32 ? 16 + pm * BM + rl : rl;
                    f32x4 o[2];
#pragma unroll
                    for (int n = 0; n < 2; ++n) { const f32x4 a = acc[ai][0][m][n] + ba[n], g = acc[ai][1][m][n] + bg[n];
#pragma unroll
                        for (int j = 0; j < 4; ++j) o[n][j] = a[j] * sigmoidf_fast(g[j]); }
                    if (ok) *(u32x4*)(U + (size_t)pos * 1024 + c0) = pack8_bf16(o[0], o[1]);
                }
        }
    }
};
struct EpiOut {
    static constexpr bool PERM = false, AFTER_DRAIN = false;
    const float* X; float* Hh;
    __device__ __forceinline__ void operator()(const f32x4 (&acc)[2][2][4][2], const Unit& u, int wr, int wc, int fr, int fq) const {
        const int row0 = u.pm * BM + wr * 64 + fr, col0 = u.pn * BM + wc * 32 + 4 * fq;
#pragma unroll
        for (int ai = 0; ai < 2; ++ai)
#pragma unroll
            for (int m = 0; m < 4; ++m) { const size_t off = (size_t)(row0 + ai * HALF + m * 16) * 2048 + col0;
#pragma unroll
                for (int bj = 0; bj < 2; ++bj)
#pragma unroll
                    for (int n = 0; n < 2; ++n) { const f32x4 xv = *(const f32x4*)(X + off + bj * HALF + n * 16); *(f32x4*)(Hh + off + bj * HALF + n * 16) = xv + acc[ai][bj][m][n]; }
                asm volatile("" ::: "memory"); }
    }
};
struct EpiGU {
    static constexpr bool PERM = true, AFTER_DRAIN = false;
    bf16_t* ACT; const float* bgu;
    __device__ __forceinline__ void operator()(const f32x4 (&acc)[2][2][4][2], const Unit& u, int wr, int wc, int fr, int fq) const {
        const int e = u.pn >> 4, c0 = 128 * (u.pn & 15) + wc * 32 + 8 * fq;
        f32x4 bg[2], bu[2];
#pragma unroll
        for (int n = 0; n < 2; ++n) { bg[n] = *(const f32x4*)(bgu + (size_t)e * 4096 + c0 + 4 * n); bu[n] = *(const f32x4*)(bgu + (size_t)e * 4096 + 2048 + c0 + 4 * n); }
#pragma unroll
        for (int ai = 0; ai < 2; ++ai)
#pragma unroll
            for (int m = 0; m < 4; ++m) {
                const int row = u.pm * BM + ai * HALF + wr * 64 + m * 16 + fr;
                f32x4 o[2];
#pragma unroll
                for (int n = 0; n < 2; ++n) { const f32x4 g = acc[ai][0][m][n] + bg[n], up = acc[ai][1][m][n] + bu[n];
#pragma unroll
                    for (int j = 0; j < 4; ++j) { const float gg = fminf(g[j], 7.0f), uu = fminf(fmaxf(up[j], -7.0f), 7.0f); o[n][j] = gg * sigmoidf_fast(1.702f * gg) * (uu + 1.0f); } }
                *(u32x4*)(ACT + (size_t)row * 2048 + c0) = pack8_bf16(o[0], o[1]);
            }
    }
};
struct EpiDN {
    static constexpr bool PERM = true, AFTER_DRAIN = false;
    bf16_t* Y; const float* bdn;
    __device__ __forceinline__ void operator()(const f32x4 (&acc)[2][2][4][2], const Unit& u, int wr, int wc, int fr, int fq) const {
        const int e = u.pn >> 3, c0 = 256 * (u.pn & 7) + wc * 32 + 8 * fq;
        f32x4 bv[2][2];
#pragma unroll
        for (int bj = 0; bj < 2; ++bj)
#pragma unroll
            for (int n = 0; n < 2; ++n) bv[bj][n] = *(const f32x4*)(bdn + (size_t)e * 2048 + c0 + bj * HALF + 4 * n);
#pragma unroll
        for (int ai = 0; ai < 2; ++ai)
#pragma unroll
            for (int m = 0; m < 4; ++m) {
                const int row = u.pm * BM + ai * HALF + wr * 64 + m * 16 + fr;
#pragma unroll
                for (int bj = 0; bj < 2; ++bj) *(u32x4*)(Y + (size_t)row * 2048 + c0 + bj * HALF) = pack8_bf16(acc[ai][bj][m][0] + bv[bj][0], acc[ai][bj][m][1] + bv[bj][1]);
            }
    }
};
struct GroupedOrder {
    const int* texp; int NPN, nwg, G, c;
    __device__ void init(const int* texp_, int T, int NPN_, int G_, int c_) { texp = texp_; NPN = NPN_; nwg = T * NPN_; G = G_; c = c_; }
    __device__ bool next(int i, Unit& u) const {
        const long L = (long)i * G + c; if (L >= nwg) return false;
        int wgid = (int)L; { const int q = nwg / NXCD, r = nwg % NXCD, xcd = wgid % NXCD, off = wgid / NXCD; wgid = (xcd < r ? xcd * (q + 1) : r * (q + 1) + (xcd - r) * q) + off; }
        const int mt = wgid / NPN, t = wgid - mt * NPN;
        const int e = __builtin_amdgcn_readfirstlane(__hip_atomic_load(texp + mt, __ATOMIC_RELAXED, __HIP_MEMORY_SCOPE_AGENT));
        u.pm = mt; u.pn = e * NPN + t; return true;
    }
    __device__ __forceinline__ void a_ready(const Unit&) const {}
    __device__ __forceinline__ void done(const Unit&) const {}
};
template <class Epi, class Sched, bool ALIGN_EPI = false, bool SP2 = false>
__device__ __forceinline__ void gemm_phase(PG8_LAS unsigned char* lds, const Gemm g, const Sched& S, const Epi& E) {
    const int tid = threadIdx.x, wid = __builtin_amdgcn_readfirstlane(tid >> 6), lane = tid & 63, wr = wid >> 2, wc = wid & 3, fr = lane & 15, fq = lane >> 4;
    const int K = g.K, nt = K / BK;
    unsigned voffA[2], voffB[2];
#pragma unroll
    for (int i = 0; i < 2; ++i) { int R, C; stage_rc(tid * 16 + i * 8192, R, C); const int Rb = Epi::PERM ? ((R & ~31) + perm32(R & 31)) : R;
        voffA[i] = (unsigned)(R * K + C) * 2u; voffB[i] = (unsigned)(Rb * K + C) * 2u; }
    const size_t kstep = (size_t)(BK * 2);
    const size_t hstep = (size_t)HALF * K * 2;
    const size_t tstep = 2 * hstep;
    const unsigned ldsw = (unsigned)wid * 1024u;
    const int aoff = lds_byte(wr * 64 + fr, fq * 8), boff = lds_byte(wc * 32 + fr, fq * 8);
#define PG8_SA(b, h) (((b) * 2 + (h)) * HTB)
#define PG8_SB(b, h) ((4 + (b) * 2 + (h)) * HTB)
#define PG8_STAGE(bufoff, gbase, voff) do { _Pragma("unroll") for (int _i = 0; _i < 2; ++_i) \
        __builtin_amdgcn_global_load_lds((const unsigned*)((const char*)(gbase) + (voff)[_i]), (PG8_LAS unsigned*)(lds + (bufoff) + ldsw + _i * 8192), 16, 0, 0); } while (0)
#define PG8_LDA(dst, b, h) do { _Pragma("unroll") for (int m = 0; m < 4; ++m) _Pragma("unroll") for (int k = 0; k < 2; ++k) dst[m][k] = *(const PG8_LAS bf16x8*)(lds + PG8_SA(b, h) + aoff + m * 2048 + k * 1024); } while (0)
#define PG8_LDB(dst, b, h) do { _Pragma("unroll") for (int n = 0; n < 2; ++n) _Pragma("unroll") for (int k = 0; k < 2; ++k) dst[n][k] = *(const PG8_LAS bf16x8*)(lds + PG8_SB(b, h) + boff + n * 2048 + k * 1024); } while (0)
#define PG8_MMA(ai, bj, At, Bt) do { __builtin_amdgcn_s_setprio(1); _Pragma("unroll") for (int m = 0; m < 4; ++m) _Pragma("unroll") for (int n = 0; n < 2; ++n) _Pragma("unroll") for (int k = 0; k < 2; ++k) \
        acc[ai][bj][m][n] = __builtin_amdgcn_mfma_f32_16x16x32_bf16(Bt[n][k], At[m][k], acc[ai][bj][m][n], 0, 0, 0); __builtin_amdgcn_s_setprio(0); } while (0)
#define PG8_WAIT_V(n) asm volatile("s_waitcnt vmcnt(" #n ")" ::: "memory")
#define PG8_WAIT_L(n) asm volatile("s_waitcnt lgkmcnt(" #n ")" ::: "memory")
#define PG8_BAR __builtin_amdgcn_s_barrier()
#define PG8_SCHED __builtin_amdgcn_sched_barrier(0)
    Unit cur, nxt; int ui = 0;
    if (!S.next(0, cur)) return;
    f32x4 acc[2][2][4][2];
#pragma unroll
    for (int a = 0; a < 2; ++a)
#pragma unroll
        for (int b = 0; b < 2; ++b)
#pragma unroll
            for (int m = 0; m < 4; ++m)
#pragma unroll
                for (int n = 0; n < 2; ++n) acc[a][b][m][n] = (f32x4){0.f, 0.f, 0.f, 0.f};
    bf16x8 At[4][2], B0[2][2], B1[2][2];
    const char* cA = (const char*)g.A + (size_t)cur.pm * tstep; const char* cB = (const char*)g.Bt + (size_t)cur.pn * tstep;
    S.a_ready(cur);
    if constexpr (SP2) {
        PG8_STAGE(PG8_SB(0, 0), cB, voffB); PG8_STAGE(PG8_SB(0, 1), cB + hstep, voffB); PG8_STAGE(PG8_SA(0, 0), cA, voffA); PG8_STAGE(PG8_SA(0, 1), cA + hstep, voffA);
        if (wr == 1) PG8_BAR;
        PG8_WAIT_V(2); PG8_BAR;
        PG8_STAGE(PG8_SB(1, 0), cB + kstep, voffB); PG8_STAGE(PG8_SA(1, 0), cA + kstep, voffA); PG8_STAGE(PG8_SB(1, 1), cB + hstep + kstep, voffB);
        PG8_WAIT_V(6); PG8_BAR;
    } else {
        PG8_STAGE(PG8_SB(0, 0), cB, voffB); PG8_STAGE(PG8_SA(0, 0), cA, voffA); PG8_STAGE(PG8_SB(0, 1), cB + hstep, voffB); PG8_STAGE(PG8_SA(0, 1), cA + hstep, voffA);
        if (wr == 1) PG8_BAR;
        PG8_WAIT_V(4); PG8_BAR;
        PG8_STAGE(PG8_SB(1, 0), cB + kstep, voffB); PG8_STAGE(PG8_SA(1, 0), cA + kstep, voffA); PG8_STAGE(PG8_SB(1, 1), cB + hstep + kstep, voffB);
        PG8_WAIT_V(6); PG8_BAR;
    }
    for (;;) {
        const bool has_next = S.next(ui + 1, nxt);
        const char* nA = has_next ? (const char*)g.A + (size_t)nxt.pm * tstep : cA; const char* nB = has_next ? (const char*)g.Bt + (size_t)nxt.pn * tstep : cB;
        for (int t = 0; t < nt; t += 2) {
            const bool last = (t == nt - 2);
            const char* a1 = cA + (size_t)(t + 1) * kstep;
            const char* a2 = last ? nA : cA + (size_t)(t + 2) * kstep; const char* b2 = last ? nB : cB + (size_t)(t + 2) * kstep;
            const char* a3 = a2 + kstep; const char* b3 = b2 + kstep;
            if (last && has_next) S.a_ready(nxt);
            if constexpr (SP2) {
            PG8_LDB(B0, 0, 0); PG8_LDB(B1, 0, 1); PG8_SCHED; PG8_LDA(At, 0, 0); PG8_STAGE(PG8_SA(1, 1), a1 + hstep, voffA);
            PG8_WAIT_V(8); PG8_WAIT_L(0); PG8_BAR; PG8_MMA(0, 0, At, B0); PG8_MMA(0, 1, At, B1); PG8_BAR; PG8_SCHED;
            PG8_LDA(At, 0, 1); PG8_STAGE(PG8_SB(0, 0), b2, voffB); PG8_STAGE(PG8_SB(0, 1), b2 + hstep, voffB); PG8_STAGE(PG8_SA(0, 0), a2, voffA);
            PG8_WAIT_V(8); PG8_WAIT_L(0); PG8_BAR; PG8_MMA(1, 0, At, B0); PG8_MMA(1, 1, At, B1); PG8_BAR; PG8_SCHED;
            PG8_LDB(B0, 1, 0); PG8_LDB(B1, 1, 1); PG8_SCHED; PG8_LDA(At, 1, 0); PG8_STAGE(PG8_SA(0, 1), a2 + hstep, voffA);
            PG8_WAIT_V(8); PG8_WAIT_L(0); PG8_BAR; PG8_MMA(0, 0, At, B0); PG8_MMA(0, 1, At, B1); PG8_BAR; PG8_SCHED;
            PG8_LDA(At, 1, 1); PG8_STAGE(PG8_SB(1, 0), b3, voffB); PG8_STAGE(PG8_SB(1, 1), b3 + hstep, voffB); PG8_STAGE(PG8_SA(1, 0), a3, voffA);
            PG8_WAIT_V(8); PG8_WAIT_L(0); PG8_BAR; PG8_MMA(1, 0, At, B0); PG8_MMA(1, 1, At, B1); PG8_BAR; PG8_SCHED;
            } else {
            PG8_LDB(B0, 0, 0); PG8_SCHED; PG8_LDA(At, 0, 0); PG8_STAGE(PG8_SA(1, 1), a1 + hstep, voffA);
            PG8_WAIT_L(8); PG8_BAR; PG8_WAIT_L(0); PG8_MMA(0, 0, At, B0); PG8_BAR; PG8_SCHED;
            PG8_LDB(B1, 0, 1); PG8_STAGE(PG8_SB(0, 0), b2, voffB);
            PG8_BAR; PG8_WAIT_L(0); PG8_MMA(0, 1, At, B1); PG8_BAR;
            PG8_LDA(At, 0, 1); PG8_STAGE(PG8_SA(0, 0), a2, voffA);
            PG8_BAR; PG8_WAIT_L(0); PG8_MMA(1, 0, At, B0); PG8_BAR; PG8_SCHED;
            PG8_STAGE(PG8_SB(0, 1), b2 + hstep, voffB);
            PG8_WAIT_V(6); PG8_BAR; PG8_MMA(1, 1, At, B1); PG8_BAR;
            PG8_LDB(B0, 1, 0); PG8_SCHED; PG8_LDA(At, 1, 0); PG8_STAGE(PG8_SA(0, 1), a2 + hstep, voffA);
            PG8_WAIT_L(8); PG8_BAR; PG8_WAIT_L(0); PG8_MMA(0, 0, At, B0); PG8_BAR; PG8_SCHED;
            PG8_LDB(B1, 1, 1); PG8_STAGE(PG8_SB(1, 0), b3, voffB);
            PG8_BAR; PG8_WAIT_L(0); PG8_MMA(0, 1, At, B1); PG8_BAR;
            PG8_LDA(At, 1, 1); PG8_STAGE(PG8_SA(1, 0), a3, voffA);
            PG8_BAR; PG8_WAIT_L(0); PG8_MMA(1, 0, At, B0); PG8_BAR; PG8_SCHED;
            PG8_STAGE(PG8_SB(1, 1), b3 + hstep, voffB);
            PG8_WAIT_V(6); PG8_BAR; PG8_MMA(1, 1, At, B1); PG8_BAR;
            }
        }
        if constexpr (ALIGN_EPI) { if (wr == 0) PG8_BAR; }
        if constexpr (!Epi::AFTER_DRAIN) { E(acc, cur, wr, wc, fr, fq); S.done(cur); }
        if (!has_next) break;
#pragma unroll
        for (int a = 0; a < 2; ++a)
#pragma unroll
            for (int b = 0; b < 2; ++b)
#pragma unroll
                for (int m = 0; m < 4; ++m)
#pragma unroll
                    for (int n = 0; n < 2; ++n) acc[a][b][m][n] = (f32x4){0.f, 0.f, 0.f, 0.f};
        cur = nxt; cA = nA; cB = nB; ++ui;
        if constexpr (ALIGN_EPI) { if (wr == 1) PG8_BAR; }
    }
    PG8_WAIT_V(0);
    if constexpr (!ALIGN_EPI) { if (wr == 0) PG8_BAR; }
    PG8_BAR;
    if constexpr (Epi::AFTER_DRAIN) { E.fused(acc, cur, wr, wc, fr, fq, lds, wid, lane); S.done(cur); }
#undef PG8_SA
#undef PG8_SB
#undef PG8_STAGE
#undef PG8_LDA
#undef PG8_LDB
#undef PG8_MMA
#undef PG8_WAIT_V
#undef PG8_WAIT_L
#undef PG8_BAR
#undef PG8_SCHED
}
}
namespace fox {
constexpr float THR = 8.f; constexpr int D = 128;
constexpr float SCALE = 0.08838834764831845f;
constexpr int NW = 8, QBLK = 32, KVBLK = 64, QB = NW * QBLK;
constexpr int SHM_V = KVBLK * D * 2, SHM_K = KVBLK * D * 2;
using bf16 = __hip_bfloat16;
typedef short bf16x8 __attribute__((ext_vector_type(8)));
typedef short s16x4 __attribute__((ext_vector_type(4)));
typedef float f32x16 __attribute__((ext_vector_type(16)));
typedef float f32x4 __attribute__((ext_vector_type(4)));
typedef unsigned u32x4 __attribute__((ext_vector_type(4)));
template <class A, class Bt> struct same_t { static constexpr bool v = false; };
template <class A> struct same_t<A, A> { static constexpr bool v = true; };

#define KSWZ(row, colB) ((row) * 256 + ((colB) ^ (((row) & 7) << 4)))
#define SBAR() __builtin_amdgcn_sched_barrier(0)
__device__ __forceinline__ int v_st(int k, int c) { const int kk = (k & ~0xC) | ((k & 4) << 1) | ((k & 8) >> 1); return ((kk >> 3) * 4 + (c >> 5)) * 512 + ((kk & 7) * 32 + (c & 31)) * 2; }
__device__ __forceinline__ int v_rd_base(int lane) { return ((lane & 3) << 3) | (((lane >> 2) & 3) << 6) | (((lane >> 4) & 1) << 5) | (((lane >> 5) & 1) << 8); }
constexpr int v_rd_off(int d0, int ks, int half) { return d0 * 512 + ks * 4096 + half * 2048; }
__device__ __forceinline__ int crow(int r, int hi) { return (r & 3) + 8 * (r >> 2) + 4 * hi; }
__device__ __forceinline__ unsigned cvtpk(float lo, float hi) {
    unsigned r; asm volatile("v_cvt_pk_bf16_f32 %0, %1, %2" : "=v"(r) : "v"(lo), "v"(hi)); return r;
}
__device__ __forceinline__ bf16x8 pack8(f32x4 a, f32x4 b) {
    u32x4 w = {cvtpk(a[0], a[1]), cvtpk(a[2], a[3]), cvtpk(b[0], b[1]), cvtpk(b[2], b[3])};
    return *reinterpret_cast<bf16x8*>(&w);
}
template <class T> __device__ __forceinline__ bf16x8 load8(const T* p) {
    if constexpr (same_t<T, float>::v) { return pack8(*(const f32x4*)p, *(const f32x4*)(p + 4)); }
    else { return *reinterpret_cast<const bf16x8*>(p); }
}
__device__ __forceinline__ void mask_tile(f32x16& p0, f32x16& p1, int dq, unsigned W) {
    const float NEG = -__builtin_inff();
#pragma unroll
    for (int r = 0; r < 16; ++r) {
        const int c = (r & 3) + 8 * (r >> 2);
        if ((unsigned)(dq - c) >= W) p0[r] = NEG;
        if ((unsigned)(dq - c - 32) >= W) p1[r] = NEG;
    }
}
__device__ __forceinline__ void partialSM(f32x16& p0, f32x16& p1, float& m_reg, float& mn, float& alpha) {
    float pmax = p0[0]; for (int r = 1; r < 16; ++r) pmax = fmaxf(pmax, p0[r]); for (int r = 0; r < 16; ++r) pmax = fmaxf(pmax, p1[r]);
    { auto rr = __builtin_amdgcn_permlane32_swap(__float_as_uint(pmax), __float_as_uint(pmax), false, false);
      pmax = fmaxf(__uint_as_float(rr[0]), __uint_as_float(rr[1])); }
    constexpr float C2 = 1.4426950408889634f * SCALE;
    if (__builtin_expect(__all((pmax - m_reg) * SCALE <= THR), 1)) { mn = m_reg; alpha = 1.f; }
    else { mn = fmaxf(m_reg, pmax); alpha = __builtin_amdgcn_exp2f((m_reg - mn) * C2); m_reg = mn; }
    const float mnL = -mn * C2;
    for (int r = 0; r < 16; ++r) p0[r] = fmaf(p0[r], C2, mnL); for (int r = 0; r < 16; ++r) p1[r] = fmaf(p1[r], C2, mnL);
    for (int r = 0; r < 16; ++r) p0[r] = __builtin_amdgcn_exp2f(p0[r]);
}
__device__ __forceinline__ void finishSM(f32x16& p0, f32x16& p1, float alpha, float& l_reg, bf16x8& pa0, bf16x8& pa1, bf16x8& pa2, bf16x8& pa3) {
    for (int r = 0; r < 16; ++r) p1[r] = __builtin_amdgcn_exp2f(p1[r]);
    float ps = 0; for (int r = 0; r < 16; ++r) ps += p0[r]; for (int r = 0; r < 16; ++r) ps += p1[r];
    { auto rr = __builtin_amdgcn_permlane32_swap(__float_as_uint(ps), __float_as_uint(ps), false, false);
      ps = __uint_as_float(rr[0]) + __uint_as_float(rr[1]); }
    l_reg = l_reg * alpha + ps;
#define PK4(P, B_, OUT) do { unsigned a0 = cvtpk(P[B_+0], P[B_+1]), a1 = cvtpk(P[B_+2], P[B_+3]);                          \
        unsigned b0 = cvtpk(P[B_+4], P[B_+5]), b1 = cvtpk(P[B_+6], P[B_+7]);                                             \
        auto r0 = __builtin_amdgcn_permlane32_swap(a0, b0, false, false); auto r1 = __builtin_amdgcn_permlane32_swap(a1, b1, false, false); \
        u32x4 w = {r0[0], r1[0], r0[1], r1[1]}; OUT = *reinterpret_cast<bf16x8*>(&w); } while (0)
    PK4(p0, 0, pa0); PK4(p0, 8, pa1); PK4(p1, 0, pa2); PK4(p1, 8, pa3);
#undef PK4
}
template <int KB, bool SK>
__device__ __forceinline__ void qkt(f32x16& p0, f32x16& p1, const char* K_lds, int r32, int hi, const char* Qw, bool act) {
    if (SK && !act) { const float NEG = -__builtin_inff();
#pragma unroll
        for (int r = 0; r < 16; ++r) { p0[r] = NEG; p1[r] = NEG; } return; }
    p0 = f32x16{}; p1 = f32x16{};
    const char* kb[4]; const char* qb4[4];
#pragma unroll
    for (int dd = 0; dd < 4; ++dd) { kb[dd] = K_lds + KB * SHM_K + KSWZ(r32, (dd * 16 + hi * 8) * 2); qb4[dd] = Qw + KSWZ(r32, (dd * 16 + hi * 8) * 2); }
#pragma unroll
    for (int d0 = 0; d0 < 8; ++d0) { const char* a = kb[d0 & 3] + (d0 >> 2) * 128;
        bf16x8 b0 = *reinterpret_cast<const bf16x8*>(a);
        bf16x8 b1 = *reinterpret_cast<const bf16x8*>(a + 32 * 256);
        bf16x8 qf = *reinterpret_cast<const bf16x8*>(qb4[d0 & 3] + (d0 >> 2) * 128);
        p0 = __builtin_amdgcn_mfma_f32_32x32x16_bf16(b0, qf, p0, 0, 0, 0);
        p1 = __builtin_amdgcn_mfma_f32_32x32x16_bf16(b1, qf, p1, 0, 0, 0); }
}
template <int VB, bool SK>
__device__ __forceinline__ void pv_tile(f32x16* o, int vb0, bf16x8 pa0, bf16x8 pa1, bf16x8 pa2, bf16x8 pa3, bool act) {
    if (SK && !act) return;
#define TRRD(dst, off) asm volatile("ds_read_b64_tr_b16 %0, %1 offset:%2" : "=&v"(dst) : "v"(vb0), "i"(off) : "memory")
#define PV_D0(d0) do { s16x4 l0, l1, l2, l3, h0, h1, h2, h3; constexpr int b_ = VB * SHM_V + v_rd_off(d0, 0, 0);     \
        TRRD(l0, b_); TRRD(h0, b_ + 2048); TRRD(l1, b_ + 4096); TRRD(h1, b_ + 6144); TRRD(l2, b_ + 8192); TRRD(h2, b_ + 10240); TRRD(l3, b_ + 12288); TRRD(h3, b_ + 14336); \
        asm volatile("s_waitcnt lgkmcnt(0)" ::: "memory"); SBAR();                 \
        o[d0] = __builtin_amdgcn_mfma_f32_32x32x16_bf16(pa0, (bf16x8){l0[0], l0[1], l0[2], l0[3], h0[0], h0[1], h0[2], h0[3]}, o[d0], 0, 0, 0);   \
        o[d0] = __builtin_amdgcn_mfma_f32_32x32x16_bf16(pa1, (bf16x8){l1[0], l1[1], l1[2], l1[3], h1[0], h1[1], h1[2], h1[3]}, o[d0], 0, 0, 0);   \
        o[d0] = __builtin_amdgcn_mfma_f32_32x32x16_bf16(pa2, (bf16x8){l2[0], l2[1], l2[2], l2[3], h2[0], h2[1], h2[2], h2[3]}, o[d0], 0, 0, 0);   \
        o[d0] = __builtin_amdgcn_mfma_f32_32x32x16_bf16(pa3, (bf16x8){l3[0], l3[1], l3[2], l3[3], h3[0], h3[1], h3[2], h3[3]}, o[d0], 0, 0, 0); } while (0)
    PV_D0(0); PV_D0(1); PV_D0(2); PV_D0(3);
#undef PV_D0
#undef TRRD
}
constexpr int LDS_CK = 2 * SHM_V + 2 * SHM_K + NW * 64 * 4, LDS_Q = LDS_CK + 2 * 64 * 4, LDS_BYTES_FOX = LDS_Q + NW * QBLK * D * 2;
struct FoxRef { const bf16* Q; const bf16* K; const bf16* V; const float* C; bf16* O; float* ML; int P0, j_lo, j_hi; };
struct FoxSeam { bf16x8 qr[8]; bf16x8 st_v0, st_v1, st_k0, st_k1; float st_c; };
#define ROW(p, k0, rr) ((p) + (size_t)((k0) + (rr)) * D + sc)
#define VMW() asm volatile("s_waitcnt vmcnt(0)" ::: "memory")
#define VMWN(n) asm volatile("s_waitcnt vmcnt(%0)" :: "i"(n) : "memory")
#define SLOAD_H(Kp, Vp, Cp, k0) do { S.st_v0 = load8<bf16>(ROW(Vp, k0, sr)); S.st_v1 = load8<bf16>(ROW(Vp, k0, 32 + sr));              \
                         S.st_k0 = load8<bf16>(ROW(Kp, k0, sr)); S.st_k1 = load8<bf16>(ROW(Kp, k0, 32 + sr)); S.st_c = (Cp)[(k0) + (tid & 63)]; } while (0)
#define SWRITE_HK(bf) do { *(bf16x8*)(K_lds + (bf) * SHM_K + kws) = S.st_k0; *(bf16x8*)(K_lds + (bf) * SHM_K + kws + 32 * 256) = S.st_k1; \
                           if (tid < 64) ck_lds[(bf) * 64 + tid] = S.st_c; } while (0)
#define SWRITE_HV(bf) do { *(bf16x8*)(V_lds + (bf) * SHM_V + vst0) = S.st_v0; *(bf16x8*)(V_lds + (bf) * SHM_V + vst1) = S.st_v1; } while (0)
#define SWRITE_H(bf) do { SWRITE_HV(bf); SWRITE_HK(bf); } while (0)
__device__ __forceinline__ void fox_prime(const FoxRef& cur, char* lds, FoxSeam& S) {
    const int tid = threadIdx.x, wid = __builtin_amdgcn_readfirstlane(tid >> 6), lane = tid & 63, r32 = lane & 31, hi = lane >> 5;
    const int sr = tid >> 4, sc = (tid & 15) * 8, kws = KSWZ(sr, sc * 2); char* K_lds = lds + 2 * SHM_V; float* ck_lds = (float*)(lds + LDS_CK);
    const int kb0 = cur.j_lo * KVBLK;
    for (int d0 = 0; d0 < 8; ++d0) S.qr[d0] = load8<bf16>(cur.Q + (size_t)(wid * QBLK + r32) * D + d0 * 16 + hi * 8);
    SLOAD_H(cur.K, cur.V, cur.C, kb0); VMW(); SWRITE_HK(0);
    __syncthreads();
}
__device__ __forceinline__ void fox_block(const FoxRef& cur, const FoxRef& nxt, char* lds, FoxSeam& S) {
    constexpr bool SK = false; constexpr unsigned W = 0x7fffffffu;
    int tid_o = threadIdx.x; asm volatile("" : "+v"(tid_o));
    const int tid = tid_o, wid = __builtin_amdgcn_readfirstlane(tid >> 6), lane = tid & 63, r32 = lane & 31, hi = lane >> 5;
    const int j_lo = cur.j_lo, j_hi = cur.j_hi;
    const int NT = j_hi - j_lo;
    const int kbn = nxt.j_lo * KVBLK;
    const int qlo = cur.P0 + wid * QBLK, qm = qlo + r32 - 4 * hi;
    char* V_lds = lds; char* K_lds = lds + 2 * SHM_V;
    float* ws = (float*)(lds + 2 * SHM_V + 2 * SHM_K) + wid * 64; float* li_l = ws, * al_l = ws + 32;
    float* ck_lds = (float*)(lds + LDS_CK);
    float m_reg = -1e30f, l_reg = 0; f32x16 o[4] = {};
    const int sr = tid >> 4, sc = (tid & 15) * 8, vst0 = v_st(sr, sc), vst1 = v_st(32 + sr, sc), kws = KSWZ(sr, sc * 2);
    const int vb0 = (int)(uintptr_t)V_lds + v_rd_base(lane);
    const bf16* Kh = cur.K; const bf16* Vh = cur.V; const float* Ch = cur.C;
#define RESC(a) do { if (__any((a) < 1.f)) { if (hi == 0) al_l[r32] = (a); asm volatile("s_waitcnt lgkmcnt(0)" ::: "memory");              \
                     for (int d_ = 0; d_ < 4; ++d_) for (int r = 0; r < 16; ++r) o[d_][r] *= al_l[crow(r, hi)]; } } while (0)
#define KBASE(t) ((j_lo + (t)) * KVBLK)
#define BIAS(P0_, P1_, KB_) do { const float* cb_ = ck_lds + (KB_) * 64 + 4 * hi;                                                  \
        _Pragma("unroll") for (int g_ = 0; g_ < 4; ++g_) { const f32x4 c0_ = *(const f32x4*)(cb_ + 8 * g_), c1_ = *(const f32x4*)(cb_ + 32 + 8 * g_); \
            _Pragma("unroll") for (int j_ = 0; j_ < 4; ++j_) { P0_[4 * g_ + j_] -= c0_[j_]; P1_[4 * g_ + j_] -= c1_[j_]; } } } while (0)
#define MASKT(P0_, P1_, t) do { const int kb_ = KBASE(t); if (kb_ + KVBLK - 1 > qlo) mask_tile(P0_, P1_, qm - kb_, W); } while (0)
    constexpr int NQL = 8;
#define SEAM_K0() do { VMWN(NQL); SWRITE_HK(0); SBAR(); } while (0)
    f32x16 pA0, pA1, pB0, pB1; float mnA, mnB, alA, alB; bf16x8 pa0, pa1, pa2, pa3;
    char* Qw = lds + LDS_Q + wid * (QBLK * D * 2);
#pragma unroll
    for (int d0 = 0; d0 < 8; ++d0) *(bf16x8*)(Qw + KSWZ(r32, ((d0 & 3) * 16 + hi * 8) * 2) + (d0 >> 2) * 128) = S.qr[d0];
    SWRITE_HV(0); SBAR();
    if (NT > 1) { SLOAD_H(Kh, Vh, Ch, KBASE(1)); }
    SBAR(); qkt<0, SK>(pA0, pA1, K_lds, r32, hi, Qw, true);
    BIAS(pA0, pA1, 0); MASKT(pA0, pA1, 0); partialSM(pA0, pA1, m_reg, mnA, alA);
    if (NT > 1) { VMW(); SWRITE_H(1); }
    __syncthreads();
#define HALF_STEP(PX0, PX1, mnX, alX, PY0, PY1, alY, t, KB, VB, SB) do {                                                      \
        SBAR(); qkt<KB, SK>(PX0, PX1, K_lds, r32, hi, Qw, true);                                                            \
        finishSM(PY0, PY1, alY, l_reg, pa0, pa1, pa2, pa3); SBAR();                                                           \
        if ((t) + 1 < NT) { SLOAD_H(Kh, Vh, Ch, KBASE((t) + 1)); SBAR(); }                                                    \
        pv_tile<VB, SK>(o, vb0, pa0, pa1, pa2, pa3, true); BIAS(PX0, PX1, KB); MASKT(PX0, PX1, (t)); partialSM(PX0, PX1, m_reg, mnX, alX); \
        __syncthreads();                                                                                                      \
        if ((t) + 1 < NT) { VMW(); SWRITE_H(SB); }                                                                            \
        RESC(alX); __syncthreads(); } while (0)
    for (int t = 1; t + 1 < NT; t += 2) {
        HALF_STEP(pB0, pB1, mnB, alB, pA0, pA1, alA, t, 1, 0, 0);
        HALF_STEP(pA0, pA1, mnA, alA, pB0, pB1, alB, t + 1, 0, 1, 1);
    }
    const bool even = (NT & 1) == 0;
    if (even) { SBAR(); qkt<1, SK>(pB0, pB1, K_lds, r32, hi, Qw, true); SBAR(); }
    SLOAD_H(nxt.K, nxt.V, nxt.C, kbn); SBAR();
#pragma unroll
    for (int d0 = 0; d0 < 8; ++d0) S.qr[d0] = load8<bf16>(nxt.Q + (size_t)(wid * QBLK + r32) * D + d0 * 16 + hi * 8);
    SBAR();
    finishSM(pA0, pA1, alA, l_reg, pa0, pa1, pa2, pa3); SBAR();
    pv_tile<0, SK>(o, vb0, pa0, pa1, pa2, pa3, true);
    if (even) { BIAS(pB0, pB1, 1); MASKT(pB0, pB1, NT - 1); partialSM(pB0, pB1, m_reg, mnB, alB); __syncthreads(); RESC(alB);
        finishSM(pB0, pB1, alB, l_reg, pa0, pa1, pa2, pa3); SBAR(); pv_tile<1, SK>(o, vb0, pa0, pa1, pa2, pa3, true); }
    SBAR(); SEAM_K0();
    if (hi == 0) li_l[r32] = l_reg; asm volatile("s_waitcnt lgkmcnt(0)" ::: "memory");
    if (hi == 0) *(float2*)(cur.ML + (wid * QBLK + r32) * 2) = make_float2(m_reg, l_reg);
    float rli[16];
#pragma unroll
    for (int r = 0; r < 16; ++r) { const float lv = li_l[crow(r, hi)]; rli[r] = lv > 0.f ? __builtin_amdgcn_rcpf(lv) : 0.f; }
    bf16* Ow = cur.O + (size_t)(wid * QBLK) * D;
#pragma unroll
    for (int r = 0; r < 16; ++r) { const int orow = crow(r, hi);
#pragma unroll
        for (int d0 = 0; d0 < 4; ++d0) { const float v = o[d0][r] * rli[r];
            const float vn = __shfl_xor(v, 1);
            if ((r32 & 1) == 0) *(unsigned*)(Ow + (size_t)orow * D + d0 * 32 + r32) = cvtpk(v, vn); } }
    __syncthreads();
#undef RESC
#undef KBASE
#undef BIAS
#undef MASKT
#undef SEAM_K0
#undef HALF_STEP
}
#undef ROW
#undef VMW
#undef VMWN
#undef SLOAD_H
#undef SWRITE_HK
#undef SWRITE_HV
#undef SWRITE_H
}
constexpr int NWAVES = 8, NTHREADS = 512;
constexpr int DM = 2048, SEQ = 8192, NMETA = 16, LTOT = SEQ + NMETA, NHEAD = 8, HDIM = 128, INCOLS = 5128, NIN = 5120;
constexpr int NEXP = 32, TOPK = 4, CKW = 31;
constexpr int MIN_ROWS = 8448;
constexpr int SKV = 8256;
constexpr int MAXT = 160, PROWS = MAXT * 256;
constexpr float NORM_EPS = 1e-5f;
constexpr float INV_SCALE = 11.313708498984761f;
constexpr size_t MiB = 1u << 20;
constexpr size_t WS_CTL = 0, CTL_ZERO_BYTES = 1 * MiB;
constexpr size_t WS_WIN = 1 * MiB, WS_WOUT = 21 * MiB, WS_WGU = 32 * MiB, WS_WDN = 544 * MiB, WS_HN = 800 * MiB, WS_Q = 834 * MiB, WS_K = 850 * MiB, WS_V = 867 * MiB,
                 WS_U = 884 * MiB, WS_MIXED = 901 * MiB, WS_H = 933 * MiB, WS_HN2 = 997 * MiB, WS_XG = 1029 * MiB, WS_ACT = 1189 * MiB, WS_Y = 1349 * MiB,
                 WS_OPART = 1509 * MiB, WS_ML = 1573 * MiB, WS_LOGF = 1575 * MiB, WS_CS = 1576 * MiB, WS_ROUTE = 1577 * MiB, WS_END = 1579 * MiB;
static_assert(WS_WIN + (size_t)NIN * DM * 2 <= WS_WOUT && WS_WOUT + (size_t)DM * DM * 2 <= WS_WGU && WS_WGU + (size_t)NEXP * 4096 * DM * 2 <= WS_WDN && WS_WDN + (size_t)NEXP * DM * DM * 2 <= WS_HN, "ws map 1");
static_assert(WS_HN + (size_t)MIN_ROWS * DM * 2 <= WS_Q && WS_Q + (size_t)NHEAD * SEQ * HDIM * 2 <= WS_K && WS_K + (size_t)NHEAD * SKV * HDIM * 2 <= WS_V && WS_V + (size_t)NHEAD * SKV * HDIM * 2 <= WS_U, "ws map 2");
static_assert(WS_U + (size_t)LTOT * 1024 * 2 <= WS_MIXED && WS_MIXED + (size_t)SEQ * DM * 2 <= WS_H && WS_H + (size_t)SEQ * DM * 4 <= WS_HN2 && WS_HN2 + (size_t)SEQ * DM * 2 <= WS_XG, "ws map 3");
static_assert(WS_XG + (size_t)PROWS * DM * 2 <= WS_ACT && WS_ACT + (size_t)PROWS * DM * 2 <= WS_Y && WS_Y + (size_t)PROWS * DM * 2 <= WS_OPART && WS_OPART + (size_t)1024 * 256 * 128 * 2 <= WS_ML, "ws map 4");
static_assert(WS_ML + (size_t)1024 * 512 * 4 <= WS_LOGF && WS_LOGF + (size_t)LTOT * 8 * 4 <= WS_CS && WS_CS + (size_t)NHEAD * SKV * 4 <= WS_ROUTE && WS_ROUTE + (size_t)4 * SEQ * 4 * 4 <= WS_END, "ws map 5");
constexpr int CW_BAR = 4096, CW_QUEUE = 8192, CW_CNT = 8256, CW_TEXP = 8320  , CW_NT = 8512  ;
constexpr int RING_BYTES = 135168, MISC_OFF = RING_BYTES, LDS_BYTES = RING_BYTES + 1024;

#define GAS __attribute__((address_space(1)))
#define LAS __attribute__((address_space(3)))
typedef unsigned short bf16;
typedef unsigned v4u __attribute__((ext_vector_type(4)));
typedef unsigned v2u __attribute__((ext_vector_type(2)));
typedef float f32x4 __attribute__((ext_vector_type(4)));
typedef float f32x16 __attribute__((ext_vector_type(16)));
typedef GAS unsigned gu32;
#define RLX_AGENT __ATOMIC_RELAXED, __HIP_MEMORY_SCOPE_AGENT
__device__ __forceinline__ unsigned pk2(float lo, float hi) { unsigned r; asm volatile("v_cvt_pk_bf16_f32 %0, %1, %2" : "=v"(r) : "v"(lo), "v"(hi)); return r; }
__device__ __forceinline__ float bf_lo(unsigned w) { return __uint_as_float(w << 16); }
__device__ __forceinline__ float bf_hi(unsigned w) { return __uint_as_float(w & 0xffff0000u); }
__device__ __forceinline__ float wave_sum(float v) {
#pragma unroll
    for (int o = 1; o < 64; o <<= 1) v += __shfl_xor(v, o);
    return v;
}
#define XB_TMO      128
#define XB_XCNT(j)  (256  + 64 * (j))
#define XB_XSUB(j)  (1280 + 64 * (j))
#define XB_XGEN(j)  (2304 + 64 * (j))
#define XB_TOP      3328
#define XB_TOPGEN   3392
#define XCD_BAR_WORDS 3456
#define XB_SPIN_CAP (1u << 18)

__device__ __forceinline__ unsigned xb_ld(unsigned* p)              { return __hip_atomic_load(p, __ATOMIC_RELAXED, __HIP_MEMORY_SCOPE_AGENT); }
__device__ __forceinline__ unsigned xb_add(unsigned* p, unsigned v) { return __hip_atomic_fetch_add(p, v, __ATOMIC_RELAXED, __HIP_MEMORY_SCOPE_AGENT); }
__device__ __forceinline__ unsigned xb_xcc_id() { return (unsigned)__builtin_amdgcn_s_getreg((3 << 11) | 20) & 0xFu; }
#define XB_SPIN(cond, bar) do { unsigned _sp = 0; while (cond) { __builtin_amdgcn_s_sleep(1); \
    if ((++_sp & 255u) == 0u) { if (xb_ld(&(bar)[XB_TMO])) break; if (_sp > XB_SPIN_CAP) { atomicAdd(&(bar)[XB_TMO], 1u); break; } } } } while (0)

struct XcdBarrier {
    unsigned* bar; unsigned x;
    volatile LAS unsigned* st;
};

__device__ __forceinline__ XcdBarrier xcd_barrier_post(unsigned* bar, volatile LAS unsigned* st) {
    XcdBarrier b; b.bar = bar; b.x = xb_xcc_id(); b.st = st;
    if (threadIdx.x == 0) (void)xb_add(&bar[XB_XCNT(b.x)], 1u);
    return b;
}
__device__ __forceinline__ void xcd_barrier_complete(unsigned* bar, unsigned x, unsigned& nloc, unsigned& nx) {
    const unsigned G = gridDim.x * gridDim.y * gridDim.z;
    unsigned sum, cnt, mine, sp = 0u;
    for (;;) {
        sum = 0u; cnt = 0u; mine = 0u;
#pragma unroll
        for (unsigned j = 0; j < 16; ++j) { const unsigned c = xb_ld(&bar[XB_XCNT(j)]); sum += c; cnt += (c > 0u) ? 1u : 0u; mine = (j == x) ? c : mine; }
        if (sum == G) break;
        __builtin_amdgcn_s_sleep(1);
        if ((++sp & 255u) == 0u) { if (xb_ld(&bar[XB_TMO])) break; if (sp > XB_SPIN_CAP) { atomicAdd(&bar[XB_TMO], 1u); break; } }
    }
    nloc = mine > 0u ? mine : 1u; nx = cnt > 0u ? cnt : 1u;
}

__device__ __forceinline__ void xcd_barrier(const XcdBarrier& b) {
    asm volatile("s_waitcnt vmcnt(0)" ::: "memory");
    __syncthreads();
    if (threadIdx.x == 0) {
        unsigned* bar = b.bar;
        __builtin_amdgcn_s_waitcnt(0);
        unsigned nloc = b.st[0], nx = b.st[1];
        if (nloc == 0u) { xcd_barrier_complete(bar, b.x, nloc, nx); b.st[0] = nloc; b.st[1] = nx; }
        const unsigned old = xb_add(&bar[XB_XSUB(b.x)], 1u);
        const unsigned gen = old / nloc;
        if (old + 1u == (gen + 1u) * nloc) {
            __builtin_amdgcn_fence(__ATOMIC_RELEASE, "agent");
            asm volatile("s_waitcnt vmcnt(0)" ::: "memory");
            const unsigned og = xb_add(&bar[XB_TOP], 1u);
            const unsigned tg = og / nx;
            if (og + 1u == (tg + 1u) * nx) xb_add(&bar[XB_TOPGEN], 1u);
            else XB_SPIN(xb_ld(&bar[XB_TOPGEN]) == tg, bar);
            __builtin_amdgcn_fence(__ATOMIC_ACQUIRE, "agent");
            xb_add(&bar[XB_XGEN(b.x)], 1u);
            asm volatile("s_waitcnt vmcnt(0)" ::: "memory");
        } else {
            XB_SPIN(xb_ld(&bar[XB_XGEN(b.x)]) == gen, bar);
            __builtin_amdgcn_fence(__ATOMIC_ACQUIRE, "agent");
            asm volatile("s_waitcnt vmcnt(0)" ::: "memory");
        }
    }
    __syncthreads();
}
struct Args { const float* in[19]; float* out; unsigned char* ws; };
enum { I_X = 0, I_META, I_G1, I_WIN, I_BF, I_BGLU, I_CW, I_CB, I_GNG, I_GNB, I_WOUT, I_G2, I_RW, I_RB, I_WGU, I_BGU, I_WDN, I_BDN, I_GF };

struct CvJob { const float* src; bf16* dst; int ld; };
constexpr int CV_GU = NEXP * 32 * 16, CV_DN = NEXP * 16 * 16, CV_IN = 40 * 16, CV_OUT = 16 * 16, CV_JOBS = CV_GU + CV_DN + CV_IN + CV_OUT;
__device__ __forceinline__ CvJob cv_decode(int job, const Args& a) {
    CvJob j;
    if (job < CV_GU) { const int e = job >> 9, r = job & 511, kb = r >> 5, nb = r & 31, col0 = (nb & 1) * 2048 + 128 * (nb >> 1);
        j.src = a.in[I_WGU] + (size_t)e * DM * 4096 + (size_t)(kb * 128) * 4096 + col0; j.ld = 4096; j.dst = (bf16*)(a.ws + WS_WGU) + ((size_t)e * 4096 + nb * 128) * DM + kb * 128; }
    else if (job < CV_GU + CV_DN) { const int q = job - CV_GU, e = q >> 8, r = q & 255, kb = r >> 4, nb = r & 15;
        j.src = a.in[I_WDN] + (size_t)e * DM * DM + (size_t)(kb * 128) * DM + nb * 128; j.ld = DM; j.dst = (bf16*)(a.ws + WS_WDN) + ((size_t)e * DM + nb * 128) * DM + kb * 128; }
    else if (job < CV_GU + CV_DN + CV_IN) { const int q = job - CV_GU - CV_DN, kb = q / 40, nb = q - kb * 40;
        const int col0 = nb < 24 ? 128 * nb : ((((nb - 24) & 1) ? 4104 : 3080) + 128 * ((nb - 24) >> 1));
        j.src = a.in[I_WIN] + (size_t)(kb * 128) * INCOLS + col0; j.ld = INCOLS; j.dst = (bf16*)(a.ws + WS_WIN) + (size_t)(nb * 128) * DM + kb * 128; }
    else { const int q = job - CV_GU - CV_DN - CV_IN, kb = q >> 4, nb = q & 15;
        j.src = a.in[I_WOUT] + (size_t)(kb * 128) * DM + nb * 128; j.ld = DM; j.dst = (bf16*)(a.ws + WS_WOUT) + (size_t)(nb * 128) * DM + kb * 128; }
    return j;
}
__device__ __forceinline__ void cv_load(const CvJob& j, f32x4 (&v)[8], int tid) {
    const int c4 = tid & 31, kr = tid >> 5;
#pragma unroll
    for (int p = 0; p < 2; ++p)
#pragma unroll
        for (int r = 0; r < 4; ++r) v[p * 4 + r] = *(const f32x4*)(j.src + (size_t)(64 * p + 4 * kr + r) * j.ld + 4 * c4);
}
__device__ __forceinline__ void p0_prologue(const Args& a, unsigned char* lds, int tid, int lane, int wave, int bid, int G) {
    {
        float* wfT = (float*)(lds + 65536);
        for (int idx = tid; idx < 8 * DM; idx += NTHREADS) { const int k = idx >> 3, hh = idx & 7; wfT[hh * DM + k] = a.in[I_WIN][(size_t)k * INCOLS + 3072 + hh]; }
        __syncthreads();
        bf16* HN = (bf16*)(a.ws + WS_HN); float* LOGF = (float*)(a.ws + WS_LOGF);
        for (int row = bid * NWAVES + wave; row < MIN_ROWS; row += G * NWAVES) {
            bf16* orow = HN + (size_t)row * DM;
            if (row >= LTOT) {
#pragma unroll
                for (int j = 0; j < 4; ++j) ((v4u*)orow)[lane + 64 * j] = (v4u){0u, 0u, 0u, 0u};
                continue; }
            const float* xr = row < SEQ ? a.in[I_X] + (size_t)row * DM : a.in[I_META] + (size_t)(row - SEQ) * DM;
            f32x4 v[8]; float ss = 0.f;
#pragma unroll
            for (int j = 0; j < 8; ++j) { v[j] = ((const f32x4*)xr)[lane + 64 * j]; ss += (v[j][0] * v[j][0] + v[j][1] * v[j][1]) + (v[j][2] * v[j][2] + v[j][3] * v[j][3]); }
            ss = wave_sum(ss);
            const float rstd = 1.0f / sqrtf(ss * (1.0f / DM) + NORM_EPS);
            float fa[8];
#pragma unroll
            for (int hh = 0; hh < 8; ++hh) fa[hh] = 0.f;
#pragma unroll
            for (int j = 0; j < 8; ++j) { const f32x4 gv = ((const f32x4*)a.in[I_G1])[lane + 64 * j]; const f32x4 y = v[j] * rstd * gv;
                ((v2u*)orow)[lane + 64 * j] = (v2u){pk2(y[0], y[1]), pk2(y[2], y[3])};
#pragma unroll
                for (int hh = 0; hh < 8; ++hh) { const f32x4 wv = *(const f32x4*)(wfT + hh * DM + 256 * j + 4 * lane); fa[hh] += (y[0] * wv[0] + y[1] * wv[1]) + (y[2] * wv[2] + y[3] * wv[3]); } }
#pragma unroll
            for (int hh = 0; hh < 8; ++hh) fa[hh] = wave_sum(fa[hh]);
            if (lane < 8) {
                float z = fa[0];
#pragma unroll
                for (int hh = 1; hh < 8; ++hh) z = lane == hh ? fa[hh] : z;
                z += a.in[I_BF][lane];
                const float lf = fminf(z, 0.f) - log1pf(expf(-fabsf(z)));
                const int pos = row < SEQ ? NMETA + row : row - SEQ;
                LOGF[pos * 8 + lane] = lf; }
        }
        if (bid == 0) {
            bf16* Kb = (bf16*)(a.ws + WS_K); bf16* Vb = (bf16*)(a.ws + WS_V);
            for (int idx = tid; idx < NHEAD * 768; idx += NTHREADS) { const int head = idx / 768, o = idx - head * 768;
                ((v4u*)(Kb + (size_t)head * SKV * HDIM))[o] = (v4u){0u, 0u, 0u, 0u}; ((v4u*)(Vb + (size_t)head * SKV * HDIM))[o] = (v4u){0u, 0u, 0u, 0u}; } }
        __syncthreads();
    }
    {
        const int c4 = tid & 31, kr = tid >> 5;
        int job = bid, buf = 0; CvJob jc = cv_decode(job < CV_JOBS ? job : 0, a); f32x4 cur[8], nxt[8];
        if (job < CV_JOBS) cv_load(jc, cur, tid);
        while (job < CV_JOBS) {
            const int jn_i = job + G; const bool hn = jn_i < CV_JOBS; CvJob jn = cv_decode(hn ? jn_i : job, a);
            if (hn) cv_load(jn, nxt, tid);
            unsigned char* Lb = lds + buf * 32768;
#pragma unroll
            for (int p = 0; p < 2; ++p)
#pragma unroll
                for (int j = 0; j < 4; ++j) { const unsigned lo = pk2(cur[4 * p + 0][j], cur[4 * p + 1][j]), hi = pk2(cur[4 * p + 2][j], cur[4 * p + 3][j]);
                    const int n = 4 * c4 + j, unit = 16 * p + kr, f = (c4 & 15) << 1;
                    *(v2u*)(Lb + n * 256 + ((unit ^ f) << 3)) = (v2u){lo, hi}; }
            __syncthreads();
#pragma unroll
            for (int i = 0; i < 4; ++i) { const int n = 32 * i + (tid >> 4), chunk = tid & 15, f = ((n >> 2) & 15) << 1;
                const v4u w = *(const v4u*)(Lb + n * 256 + (((2 * chunk) ^ f) << 3));
                *(v4u*)(jc.dst + (size_t)n * DM + chunk * 8) = w; }
            buf ^= 1; job = jn_i; jc = jn;
#pragma unroll
            for (int i = 0; i < 8; ++i) cur[i] = nxt[i];
        }
        __syncthreads();
    }
}

__device__ __forceinline__ void p1_cumsum(const Args& a, unsigned char* lds, int tid, int lane, int wave, int head) {
    const float* LOGF = (const float*)(a.ws + WS_LOGF); float* CS = (float*)(a.ws + WS_CS) + (size_t)head * SKV;
    float* wsum = (float*)lds;
    float loc[17]; float s = 0.f;
#pragma unroll
    for (int i = 0; i < 17; ++i) { const int p = 17 * tid + i; const float v = p < LTOT ? LOGF[p * 8 + head] : 0.f; s += v; loc[i] = s; }
    float incl = s;
#pragma unroll
    for (int o = 1; o < 64; o <<= 1) { const float n = __shfl_up(incl, o); if (lane >= o) incl += n; }
    if (lane == 63) wsum[wave] = incl;
    __syncthreads();
    float woff = 0.f;
    for (int w = 0; w < wave; ++w) woff += wsum[w];
    const float excl = woff + incl - s;
#pragma unroll
    for (int i = 0; i < 17; ++i) { const int p = 17 * tid + i; if (p < LTOT) CS[48 + p] = (excl + loc[i]) * INV_SCALE; }
    if (tid < 48) CS[tid] = __builtin_inff();
    __syncthreads();
}

constexpr int N_ATT_ENT = 80, N_ATT_ITEMS = N_ATT_ENT * NHEAD, CONV_TOK = 32, N_CONV_ITEMS = SEQ / CONV_TOK, N_P2_ITEMS = N_ATT_ITEMS + N_CONV_ITEMS;
__device__ const unsigned short ATT_TAB[N_ATT_ENT] = {
    1151, 855, 559, 263, 1055, 1087, 1119, 1150, 791, 823, 527, 1054, 1086, 1118, 1149, 790, 822, 854, 558, 1053, 1085, 1117, 1148, 821, 853, 526, 1052, 1084, 1116, 1147, 789, 852, 557, 262, 1051, 1083,
    1115, 1146, 788, 820, 525, 1050, 1082, 1114, 1145, 787, 819, 851, 556, 1049, 1081, 1113, 1144, 818, 850, 524, 1048, 1080, 1112, 786, 849, 555, 261, 785, 817, 523, 784, 816, 848, 554, 522, 553, 260, 521,
    552, 520, 259, 258, 257, 256};
__device__ __forceinline__ fox::FoxRef att_decode(int L, const Args& a) {
    const int ent = L >> 3, head = L & 7; const unsigned t = ATT_TAB[ent]; const int qb = t & 31, part = (t >> 5) & 7, np = t >> 8, NT = 4 * qb + 5;
    fox::FoxRef r;
    r.Q = (const fox::bf16*)(a.ws + WS_Q) + ((size_t)head * SEQ + (size_t)qb * 256) * HDIM;
    r.K = (const fox::bf16*)(a.ws + WS_K) + (size_t)head * SKV * HDIM; r.V = (const fox::bf16*)(a.ws + WS_V) + (size_t)head * SKV * HDIM;
    r.C = (const float*)(a.ws + WS_CS) + (size_t)head * SKV;
    r.P0 = 64 + 256 * qb; r.j_lo = part * NT / np; r.j_hi = (part + 1) * NT / np;
    const int slot = (head * 32 + qb) * 4 + part; r.O = (fox::bf16*)(a.ws + WS_OPART) + (size_t)slot * 256 * HDIM; r.ML = (float*)(a.ws + WS_ML) + (size_t)slot * 512;
    return r;
}
__device__ __forceinline__ void conv_item(const Args& a, unsigned char* lds, int tid, int it) {
    const int i0 = it * CONV_TOK, pos0 = NMETA + i0;
    const bf16* U = (const bf16*)(a.ws + WS_U); bf16* MIX = (bf16*)(a.ws + WS_MIXED);
    for (int idx = tid; idx < 62 * 128; idx += NTHREADS) { const int row = idx >> 7, ch = idx & 127, p = pos0 - 30 + row;
        v4u v = (v4u){0u, 0u, 0u, 0u}; if (p >= 0) v = *(const v4u*)(U + (size_t)p * 1024 + ch * 8);
        *(v4u*)(lds + row * 2048 + ch * 16) = v; }
    const int c = 2 * tid;
    float cw0[CKW], cw1[CKW];
#pragma unroll
    for (int w = 0; w < CKW; ++w) { const float2 t = *(const float2*)(a.in[I_CW] + w * 1024 + c); cw0[w] = t.x; cw1[w] = t.y; }
    const float2 cb = *(const float2*)(a.in[I_CB] + c), gg = *(const float2*)(a.in[I_GNG] + c), gb = *(const float2*)(a.in[I_GNB] + c);
    __syncthreads();
    for (int tk = 0; tk < CONV_TOK; ++tk) {
        float a0 = cb.x, a1 = cb.y;
#pragma unroll
        for (int w = 0; w < CKW; ++w) { const unsigned pk = *(const unsigned*)(lds + (tk + w) * 2048 + c * 2); a0 += bf_lo(pk) * cw0[w]; a1 += bf_hi(pk) * cw1[w]; }
        const float mu = wave_sum(a0 + a1) * (1.0f / 128.0f), d0 = a0 - mu, d1 = a1 - mu;
        const float var = wave_sum(d0 * d0 + d1 * d1) * (1.0f / 128.0f), rs = 1.0f / sqrtf(var + NORM_EPS);
        const float y0 = d0 * rs * gg.x + gb.x, y1 = d1 * rs * gg.y + gb.y;
        const float s0 = y0 / (1.0f + expf(-y0)), s1 = y1 / (1.0f + expf(-y1));
        *(unsigned*)(MIX + (size_t)(i0 + tk) * DM + 1024 + c) = pk2(s0, s1);
    }
    __syncthreads();
}
__device__ __forceinline__ void p2_attn_conv(const Args& a, unsigned char* lds, volatile LAS unsigned* MISC, unsigned* ctl, int tid) {
    unsigned* qctr = ctl + CW_QUEUE;
    if (tid == 0) { MISC[0] = __hip_atomic_fetch_add(qctr, 1u, RLX_AGENT); MISC[1] = __hip_atomic_fetch_add(qctr, 1u, RLX_AGENT); }
    __syncthreads();
    int ia = __builtin_amdgcn_readfirstlane((int)MISC[0]), ib = __builtin_amdgcn_readfirstlane((int)MISC[1]);
    __syncthreads();
    if (ia < N_ATT_ITEMS) {
        fox::FoxRef cur = att_decode(ia, a); fox::FoxSeam S;
        fox::fox_prime(cur, (char*)lds, S);
        for (int k = 0;; ++k) {
            if (tid == 0) MISC[2 + (k & 1)] = __hip_atomic_fetch_add(qctr, 1u, RLX_AGENT);
            const bool last = ib >= N_ATT_ITEMS;
            const fox::FoxRef nxt = last ? cur : att_decode(ib, a);
            fox::fox_block(cur, nxt, (char*)lds, S);
            ia = ib; ib = __builtin_amdgcn_readfirstlane((int)MISC[2 + (k & 1)]);
            if (last) break;
            cur = nxt;
        }
    }
    __syncthreads();
    while (ia < N_P2_ITEMS) {
        if (tid == 0) MISC[4] = __hip_atomic_fetch_add(qctr, 1u, RLX_AGENT);
        conv_item(a, lds, tid, ia - N_ATT_ITEMS);
        ia = ib; ib = __builtin_amdgcn_readfirstlane((int)MISC[4]);
        __syncthreads();
    }
}

__device__ __forceinline__ void p3_combine(const Args& a, int lane, int gw, int NGW) {
    const float C2 = 1.4426950408889634f * fox::SCALE;
    const bf16* OP = (const bf16*)(a.ws + WS_OPART); const float* ML = (const float*)(a.ws + WS_ML); bf16* MIX = (bf16*)(a.ws + WS_MIXED);
    for (int r = gw; r < 256 * 256; r += NGW) {
        const int blk = r >> 8, row = r & 255, head = blk >> 5, qb = blk & 31, np = (qb >> 3) + 1, slot = blk * 4;
        float mp[4], lp[4]; float M = -3.0e38f;
#pragma unroll
        for (int p = 0; p < 4; ++p) { mp[p] = 0.f; lp[p] = 0.f; if (p < np) { const float2 t = *(const float2*)(ML + (size_t)(slot + p) * 512 + row * 2); mp[p] = t.x; lp[p] = t.y; if (t.y > 0.f) M = fmaxf(M, t.x); } }
        float a0 = 0.f, a1 = 0.f, den = 0.f;
#pragma unroll
        for (int p = 0; p < 4; ++p) if (p < np && lp[p] > 0.f) { const float w = __builtin_amdgcn_exp2f((mp[p] - M) * C2) * lp[p];
            const unsigned pk = *(const unsigned*)(OP + ((size_t)(slot + p) * 256 + row) * HDIM + 2 * lane); a0 += w * bf_lo(pk); a1 += w * bf_hi(pk); den += w; }
        const float inv = den > 0.f ? 1.0f / den : 0.f;
        *(unsigned*)(MIX + (size_t)(qb * 256 + row) * DM + head * HDIM + 2 * lane) = pk2(a0 * inv, a1 * inv);
    }
}

__device__ __forceinline__ void p5_router(const Args& a, unsigned char* lds, unsigned* ctl, int tid, int lane, int wave, int bid, int G) {
    const float* Hh = (const float*)(a.ws + WS_H); bf16* HN2 = (bf16*)(a.ws + WS_HN2);
    int* TE = (int*)(a.ws + WS_ROUTE); int* TS = TE + SEQ * 4; float* TG = (float*)(TS + SEQ * 4);
    float* part = (float*)lds; float* ssq = part + 8 * 32 * 33; float* logit = ssq + 8 * 32; float* rstd_l = logit + 32 * 33;
    const float* g2 = a.in[I_G2]; const float* rw = a.in[I_RW];
    for (int grp = bid; grp < SEQ / 32; grp += G) {
        const int t0 = grp * 32, i = lane & 31, kk = lane >> 5, kb = wave * 256;
        f32x16 acc = {}; float ss = 0.f;
        const float* hrow = Hh + (size_t)(t0 + i) * DM + kb + 4 * kk;
#pragma unroll 4
        for (int c = 0; c < 32; ++c) {
            const f32x4 hv = *(const f32x4*)(hrow + 8 * c);
            const int k0 = kb + 8 * c + 4 * kk;
            const f32x4 gv = *(const f32x4*)(g2 + k0);
            float b[4];
#pragma unroll
            for (int q = 0; q < 4; ++q) b[q] = rw[(size_t)(k0 + q) * NEXP + i] * gv[q];
#pragma unroll
            for (int q = 0; q < 4; ++q) { acc = __builtin_amdgcn_mfma_f32_32x32x2f32(hv[q], b[q], acc, 0, 0, 0); ss += hv[q] * hv[q]; }
        }
        ss += __shfl_xor(ss, 32);
        if (kk == 0) ssq[wave * 32 + i] = ss;
#pragma unroll
        for (int r = 0; r < 16; ++r) { const int row = (r & 3) + 8 * (r >> 2) + 4 * kk; part[(wave * 32 + row) * 33 + i] = acc[r]; }
        __syncthreads();
        if (tid < 32) { float s = 0.f;
#pragma unroll
            for (int w = 0; w < 8; ++w) s += ssq[w * 32 + tid];
            rstd_l[tid] = 1.0f / sqrtf(s * (1.0f / DM) + NORM_EPS); }
        __syncthreads();
        { const int tk = tid >> 4, e0 = 2 * (tid & 15); const float rs = rstd_l[tk];
#pragma unroll
          for (int d = 0; d < 2; ++d) { float s = 0.f;
#pragma unroll
              for (int w = 0; w < 8; ++w) s += part[(w * 32 + tk) * 33 + e0 + d];
              logit[tk * 33 + e0 + d] = s * rs + a.in[I_RB][e0 + d]; } }
        __syncthreads();
        if (tid < 32) {
            unsigned taken = 0u; float tv[4]; int ti[4];
#pragma unroll
            for (int k = 0; k < 4; ++k) { float best = -3.0e38f; int bi = 0;
                for (int e = 0; e < NEXP; ++e) { const float v = logit[tid * 33 + e]; if (!((taken >> e) & 1u) && v > best) { best = v; bi = e; } }
                taken |= 1u << bi; tv[k] = best; ti[k] = bi; }
            float w[4], sum = 0.f;
#pragma unroll
            for (int k = 0; k < 4; ++k) { w[k] = expf(tv[k] - tv[0]); sum += w[k]; }
            const float inv = 1.0f / sum;
#pragma unroll
            for (int k = 0; k < 4; ++k) { const unsigned slot = __hip_atomic_fetch_add(ctl + CW_CNT + ti[k], 1u, RLX_AGENT);
                TE[(t0 + tid) * 4 + k] = ti[k]; TS[(t0 + tid) * 4 + k] = (int)slot; TG[(t0 + tid) * 4 + k] = w[k] * inv; }
        }
#pragma unroll 1
        for (int r = 0; r < 4; ++r) { const int tk = wave * 4 + r; const float rs = rstd_l[tk]; const float* hr = Hh + (size_t)(t0 + tk) * DM; bf16* orow = HN2 + (size_t)(t0 + tk) * DM;
#pragma unroll
            for (int j = 0; j < 8; ++j) { const f32x4 v = ((const f32x4*)hr)[lane + 64 * j], gv = ((const f32x4*)g2)[lane + 64 * j]; const f32x4 y = v * rs * gv;
                ((v2u*)orow)[lane + 64 * j] = (v2u){pk2(y[0], y[1]), pk2(y[2], y[3])}; } }
        __syncthreads();
    }
}

__device__ __forceinline__ void p6_gather(const Args& a, unsigned char* lds, unsigned* ctl, int tid, int lane, int wave, int bid, int G) {
    int* tst = (int*)lds;
    if (tid < NEXP) { int s = 0; for (int e = 0; e < tid; ++e) s += ((int)ctl[CW_CNT + e] + 255) >> 8; tst[tid] = s;
        if (bid == 0) { const int nt = ((int)ctl[CW_CNT + tid] + 255) >> 8; for (int i = 0; i < nt; ++i) ctl[CW_TEXP + s + i] = (unsigned)tid; if (tid == NEXP - 1) ctl[CW_NT] = (unsigned)(s + nt); } }
    __syncthreads();
    const int* TE = (const int*)(a.ws + WS_ROUTE); const int* TS = TE + SEQ * 4; int* TR = (int*)(a.ws + WS_ROUTE) + 3 * SEQ * 4;
    const bf16* HN2 = (const bf16*)(a.ws + WS_HN2); bf16* XG = (bf16*)(a.ws + WS_XG);
    for (int t = bid * NWAVES + wave; t < SEQ; t += G * NWAVES) {
        v4u v[4];
#pragma unroll
        for (int j = 0; j < 4; ++j) v[j] = ((const v4u*)(HN2 + (size_t)t * DM))[lane + 64 * j];
#pragma unroll
        for (int k = 0; k < 4; ++k) { const int e = TE[t * 4 + k], row = tst[e] * 256 + TS[t * 4 + k];
            if (lane == 0) TR[t * 4 + k] = row;
#pragma unroll
            for (int j = 0; j < 4; ++j) ((v4u*)(XG + (size_t)row * DM))[lane + 64 * j] = v[j]; }
    }
    __syncthreads();
}

__device__ __forceinline__ void p9_final(const Args& a, int lane, int gw, int NGW) {
    const float* Hh = (const float*)(a.ws + WS_H); const bf16* Y = (const bf16*)(a.ws + WS_Y);
    const float* TG = (const float*)(a.ws + WS_ROUTE) + 2 * SEQ * 4; const int* TR = (const int*)(a.ws + WS_ROUTE) + 3 * SEQ * 4;
    for (int t = gw; t < SEQ; t += NGW) {
        f32x4 v[8];
#pragma unroll
        for (int j = 0; j < 8; ++j) v[j] = ((const f32x4*)(Hh + (size_t)t * DM))[lane + 64 * j];
#pragma unroll
        for (int k = 0; k < 4; ++k) { const float g = TG[t * 4 + k]; const bf16* yr = Y + (size_t)TR[t * 4 + k] * DM;
#pragma unroll
            for (int j = 0; j < 8; ++j) { const v2u pk = ((const v2u*)yr)[lane + 64 * j]; v[j][0] += g * bf_lo(pk.x); v[j][1] += g * bf_hi(pk.x); v[j][2] += g * bf_lo(pk.y); v[j][3] += g * bf_hi(pk.y); } }
        float ss = 0.f;
#pragma unroll
        for (int j = 0; j < 8; ++j) ss += (v[j][0] * v[j][0] + v[j][1] * v[j][1]) + (v[j][2] * v[j][2] + v[j][3] * v[j][3]);
        ss = wave_sum(ss);
        const float rstd = 1.0f / sqrtf(ss * (1.0f / DM) + NORM_EPS);
#pragma unroll
        for (int j = 0; j < 8; ++j) { const f32x4 gv = ((const f32x4*)a.in[I_GF])[lane + 64 * j]; ((f32x4*)(a.out + (size_t)t * DM))[lane + 64 * j] = v[j] * rstd * gv; }
    }
}

#ifndef MK_PER_PHASE
#define MK_PER_PHASE 1
#endif
constexpr int N_PHASES = 10;
template <int LO, int HI> __global__ void __launch_bounds__(NTHREADS, 2) hymba_fwd(Args a) {
    extern __shared__ __attribute__((aligned(16))) unsigned char lds[];
    const int tid = threadIdx.x, lane = tid & 63, wave = __builtin_amdgcn_readfirstlane(tid >> 6), bid = blockIdx.x, G = gridDim.x;
    volatile LAS unsigned* MISC = (volatile LAS unsigned*)((LAS unsigned char*)lds + MISC_OFF);
    unsigned* ctl = (unsigned*)(a.ws + WS_CTL);
    for (int u = tid; u < (LDS_BYTES - MISC_OFF) / 4; u += NTHREADS) MISC[u] = 0u;
    __syncthreads();
    XcdBarrier bar; bar.bar = ctl + CW_BAR; bar.x = 0; bar.st = nullptr;
    if (HI - LO > 1) bar = xcd_barrier_post(ctl + CW_BAR, MISC + 8);
#ifndef PH_MASK
#define PH_MASK 0x3ff
#endif
#define IN(k) ((((PH_MASK) >> (k)) & 1) && LO <= (k) && (k) < HI)
#define SEAM(k) do { if (IN(k) && IN((k) + 1)) xcd_barrier(bar); } while (0)
    const int gw = bid * NWAVES + wave, NGW = G * NWAVES;

    if (IN(0)) { p0_prologue(a, lds, tid, lane, wave, bid, G); } SEAM(0);
    if (IN(1)) {
        if (bid < NHEAD) p1_cumsum(a, lds, tid, lane, wave, bid);
        pg8::Gemm g{(const pg8::bf16_t*)(a.ws + WS_HN), (const pg8::bf16_t*)(a.ws + WS_WIN), MIN_ROWS, NIN, DM}; pg8::StaticOrder S; S.init(MIN_ROWS, NIN, G, bid);
        pg8::EpiIn E{(pg8::bf16_t*)(a.ws + WS_Q), WS_K - WS_Q, WS_V - WS_Q, (pg8::bf16_t*)(a.ws + WS_U), a.in[I_BGLU]};
        pg8::gemm_phase<pg8::EpiIn, pg8::StaticOrder, true, true>((PG8_LAS unsigned char*)lds, g, S, E);
    } SEAM(1);
    if (IN(2)) { p2_attn_conv(a, lds, MISC, ctl, tid); } SEAM(2);
    if (IN(3)) { p3_combine(a, lane, gw, NGW); } SEAM(3);
    if (IN(4)) {
        pg8::Gemm g{(const pg8::bf16_t*)(a.ws + WS_MIXED), (const pg8::bf16_t*)(a.ws + WS_WOUT), SEQ, DM, DM}; pg8::StaticOrder S; S.init(SEQ, DM, G, bid);
        pg8::EpiOut E{a.in[I_X], (float*)(a.ws + WS_H)};
        pg8::gemm_phase<pg8::EpiOut, pg8::StaticOrder, true, true>((PG8_LAS unsigned char*)lds, g, S, E);
    } SEAM(4);
    if (IN(5)) { p5_router(a, lds, ctl, tid, lane, wave, bid, G); } SEAM(5);
    if (IN(6)) { p6_gather(a, lds, ctl, tid, lane, wave, bid, G); } SEAM(6);
    if (IN(7)) {
        const int T = (int)__hip_atomic_load(ctl + CW_NT, RLX_AGENT);
        pg8::Gemm g{(const pg8::bf16_t*)(a.ws + WS_XG), (const pg8::bf16_t*)(a.ws + WS_WGU), PROWS, NEXP * 4096, DM}; pg8::GroupedOrder S; S.init((const int*)(ctl + CW_TEXP), T, 16, G, bid);
        pg8::EpiGU E{(pg8::bf16_t*)(a.ws + WS_ACT), a.in[I_BGU]};
        pg8::gemm_phase<pg8::EpiGU, pg8::GroupedOrder, true, true>((PG8_LAS unsigned char*)lds, g, S, E);
    } SEAM(7);
    if (IN(8)) {
        const int T = (int)__hip_atomic_load(ctl + CW_NT, RLX_AGENT);
        pg8::Gemm g{(const pg8::bf16_t*)(a.ws + WS_ACT), (const pg8::bf16_t*)(a.ws + WS_WDN), PROWS, NEXP * DM, DM}; pg8::GroupedOrder S; S.init((const int*)(ctl + CW_TEXP), T, 8, G, bid);
        pg8::EpiDN E{(pg8::bf16_t*)(a.ws + WS_Y), a.in[I_BDN]};
        pg8::gemm_phase<pg8::EpiDN, pg8::GroupedOrder, true, true>((PG8_LAS unsigned char*)lds, g, S, E);
    } SEAM(8);
    if (IN(9)) { p9_final(a, lane, gw, NGW); }
#undef IN
#undef SEAM
}

template <int LO, int HI> static bool launch_range(const Args& a, int grid, hipStream_t stream) {
    static bool attr = false;
    if (!attr) { attr = true; if (hipFuncSetAttribute((const void*)hymba_fwd<LO, HI>, hipFuncAttributeMaxDynamicSharedMemorySize, LDS_BYTES) != hipSuccess) { fprintf(stderr, "kernel_launch: hipFuncSetAttribute failed\n"); return false; } }
    hipLaunchKernelGGL((hymba_fwd<LO, HI>), dim3(grid), dim3(NTHREADS), LDS_BYTES, stream, a);
    return hipPeekAtLastError() == hipSuccess;
}
extern "C" void kernel_launch(void* const* d_in, const int* in_sizes, int n_in, void* d_out, int out_size, void* d_ws, size_t ws_size, hipStream_t stream) {
    static int grid = 0;
    if (grid == 0) {
        if (n_in != 19 || out_size != SEQ * DM || ws_size < WS_END) { fprintf(stderr, "kernel_launch: unexpected shapes (n_in %d out %d ws %zu)\n", n_in, out_size, ws_size); grid = -1; return; }
        int dev = 0, cus = 0;
        if (hipGetDevice(&dev) != hipSuccess || hipDeviceGetAttribute(&cus, hipDeviceAttributeMultiprocessorCount, dev) != hipSuccess) { grid = -1; return; }
        grid = cus;
    }
    if (grid < 0) return;
    (void)in_sizes;
    if (hipMemsetAsync((char*)d_ws + WS_CTL, 0, CTL_ZERO_BYTES, stream) != hipSuccess) return;
    Args a{};
    for (int i = 0; i < 19; ++i) a.in[i] = (const float*)d_in[i];
    a.out = (float*)d_out; a.ws = (unsigned char*)d_ws;
#if MK_PER_PHASE
    launch_range<0, 1>(a, grid, stream); launch_range<1, 2>(a, grid, stream); launch_range<2, 3>(a, grid, stream); launch_range<3, 4>(a, grid, stream); launch_range<4, 5>(a, grid, stream);
    launch_range<5, 6>(a, grid, stream); launch_range<6, 7>(a, grid, stream); launch_range<7, 8>(a, grid, stream); launch_range<8, 9>(a, grid, stream); launch_range<9, 10>(a, grid, stream);
#else
    launch_range<0, N_PHASES>(a, grid, stream);
#endif
}
```

```cpp
#include <hip/hip_runtime.h>
#include <hip/hip_bf16.h>
#include <cstdio>
#include <cstdint>
namespace pg8 {
#define PG8_LAS __attribute__((address_space(3)))
typedef unsigned short bf16_t;
typedef short bf16x8 __attribute__((ext_vector_type(8)));
typedef float f32x4 __attribute__((ext_vector_type(4)));
typedef unsigned u32x4 __attribute__((ext_vector_type(4)));
constexpr int BM = 256, BK = 64, HALF = 128, HTB = HALF * BK * 2  , STAGE_BYTES = 8 * HTB, NXCD = 8, WGM = 8;

__host__ __device__ __forceinline__ int lds_byte(int r, int c) { const int st = (r >> 4) * 2 + (c >> 5), rr = r & 15, cc = c & 31, ob = rr * 64 + cc * 2; return st * 1024 + (ob ^ (((ob >> 9) & 1) << 5)); }
__host__ __device__ __forceinline__ void stage_rc(int b, int& R, int& C) { const int st = b / 1024, sb = b % 1024, swz = sb ^ (((sb >> 9) & 1) << 5); R = (st >> 1) * 16 + swz / 64; C = (st & 1) * 32 + (swz % 64) / 2; }
__host__ __device__ __forceinline__ int perm32(int rho) { const int n = rho >> 4, i = rho & 15; return 8 * (i >> 2) + 4 * n + (i & 3); }

struct Unit { int pm, pn; };
struct Gemm { const bf16_t* A; const bf16_t* Bt; int M, N, K; };

struct StaticOrder {
    int nM, nN, nwg, G, c;
    __host__ __device__ void init(int M, int N, int G_, int c_) { nM = M / BM; nN = N / BM; nwg = nM * nN; G = G_; c = c_; }
    __host__ __device__ bool next(int i, Unit& u) const {
        const long L = (long)i * G + c; if (L >= nwg) return false;
        int wgid = (int)L; { const int q = nwg / NXCD, r = nwg % NXCD, xcd = wgid % NXCD, off = wgid / NXCD; wgid = (xcd < r ? xcd * (q + 1) : r * (q + 1) + (xcd - r) * q) + off; }
        const int nig = WGM * nN, gid = wgid / nig, fm = gid * WGM, gsz = (nM - fm) < WGM ? (nM - fm) : WGM;
        u.pm = fm + ((wgid % nig) % gsz); u.pn = (wgid % nig) / gsz; return true;
    }
    __device__ __forceinline__ void a_ready(const Unit&) const {}
    __device__ __forceinline__ void done(const Unit&) const {}
};

__device__ __forceinline__ unsigned cvt_pk_bf16(float lo, float hi) { unsigned r; asm volatile("v_cvt_pk_bf16_f32 %0, %1, %2" : "=v"(r) : "v"(lo), "v"(hi)); return r; }
typedef float f32x2 __attribute__((ext_vector_type(2)));
__device__ __forceinline__ f32x2 gelu_pk(f32x2 v) {
    const f32x2 av = __builtin_elementwise_abs(v), d = av * 0.2316418882f + 1.0f;
    f32x2 t; t.x = __builtin_amdgcn_rcpf(d.x); t.y = __builtin_amdgcn_rcpf(d.y);
    f32x2 q = t * 0.5307027145f + (-0.7265760135f); q = q * t + 0.7107068705f; q = q * t + (-0.142248368f); q = q * t + 0.127414796f; q = q * t;
    const f32x2 s = (v * v) * (-0.72134752044f);
    f32x2 e; e.x = __builtin_amdgcn_exp2f(s.x); e.y = __builtin_amdgcn_exp2f(s.y);
    const f32x2 m = v * (q * e), r = v - m;
    f32x2 o; o.x = v.x < 0.f ? m.x : r.x; o.y = v.y < 0.f ? m.y : r.y; return o;
}


__device__ __forceinline__ float sigmoidf_fast(float x) { return __builtin_amdgcn_rcpf(1.0f + __builtin_amdgcn_exp2f(-1.4426950408889634f * x)); }
__device__ __forceinline__ u32x4 pack8_bf16(const f32x4 v0, const f32x4 v1) { u32x4 w; w.x = cvt_pk_bf16(v0[0], v0[1]); w.y = cvt_pk_bf16(v0[2], v0[3]); w.z = cvt_pk_bf16(v1[0], v1[1]); w.w = cvt_pk_bf16(v1[2], v1[3]); return w; }

struct EpiIn {
    static constexpr bool PERM = true, AFTER_DRAIN = false;
    bf16_t* Q; size_t koff, voff; bf16_t* U; const float* bglu;
    __device__ __forceinline__ void operator()(const f32x4 (&acc)[2][2][4][2], const Unit& u, int wr, int wc, int fr, int fq) const {
        const int pn = u.pn, pm = u.pm, dcol = wc * 32 + 8 * fq;
        if (pn < 12) {
            const int which = pn >> 2;
            if (which == 0 && pm >= 32) return;
            const size_t boff = which == 0 ? 0 : (which == 1 ? koff : voff);
            bf16_t* base = (bf16_t*)((unsigned char*)Q + boff);
            const int rph = which == 0 ? 8192 : 8256;
#pragma unroll
            for (int ai = 0; ai < 2; ++ai)
#pragma unroll
                for (int m = 0; m < 4; ++m) {
                    const int rl = ai * HALF + wr * 64 + m * 16 + fr;
                    const bool ok = pm < 32 || rl < 16;
                    const int idx = pm < 32 ? pm * BM + rl + (which ? 64 : 0) : 48 + rl;
#pragma unroll
                    for (int bj = 0; bj < 2; ++bj) { const int head = 2 * (pn & 3) + bj;
                        if (ok) *(u32x4*)(base + ((size_t)head * rph + idx) * 128 + dcol) = pack8_bf16(acc[ai][bj][m][0], acc[ai][bj][m][1]); }
                }
        } else {
            const int c0 = 128 * (pn - 12) + dcol;
            f32x4 ba[2], bg[2];
#pragma unroll
            for (int n = 0; n < 2; ++n) { ba[n] = *(const f32x4*)(bglu + c0 + 4 * n); bg[n] = *(const f32x4*)(bglu + 1024 + c0 + 4 * n); }
#pragma unroll
            for (int ai = 0; ai < 2; ++ai)
#pragma unroll
                for (int m = 0; m < 4; ++m) {
                    const int rl = ai * HALF + wr * 64 + m * 16 + fr;
                    const bool ok = pm < 32 || rl < 16;
                    const int pos = pm < 32 ? 16 + pm * BM + rl : rl;
                    f32x4 o[2];
#pragma unroll
                    for (int n = 0; n < 2; ++n) { const f32x4 a = acc[ai][0][m][n] + ba[n], g = acc[ai][1][m][n] + bg[n];
#pragma unroll
                        for (int j = 0; j < 4; ++j) o[n][j] = a[j] * sigmoidf_fast(g[j]); }
                    if (ok) *(u32x4*)(U + (size_t)pos * 1024 + c0) = pack8_bf16(o[0], o[1]);
                }
        }
    }
};
struct EpiOut {
    static constexpr bool PERM = false, AFTER_DRAIN = false;
    const float* X; float* Hh;
    __device__ __forceinline__ void operator()(const f32x4 (&acc)[2][2][4][2], const Unit& u, int wr, int wc, int fr, int fq) const {
        const int row0 = u.pm * BM + wr * 64 + fr, col0 = u.pn * BM + wc * 32 + 4 * fq;
#pragma unroll
        for (int ai = 0; ai < 2; ++ai)
#pragma unroll
            for (int m = 0; m < 4; ++m) { const size_t off = (size_t)(row0 + ai * HALF + m * 16) * 2048 + col0;
#pragma unroll
                for (int bj = 0; bj < 2; ++bj)
#pragma unroll
                    for (int n = 0; n < 2; ++n) { const f32x4 xv = *(const f32x4*)(X + off + bj * HALF + n * 16); *(f32x4*)(Hh + off + bj * HALF + n * 16) = xv + acc[ai][bj][m][n]; }
                asm volatile("" ::: "memory"); }
    }
};
struct EpiGU {
    static constexpr bool PERM = true, AFTER_DRAIN = false;
    bf16_t* ACT; const float* bgu;
    __device__ __forceinline__ void operator()(const f32x4 (&acc)[2][2][4][2], const Unit& u, int wr, int wc, int fr, int fq) const {
        const int e = u.pn >> 4, c0 = 128 * (u.pn & 15) + wc * 32 + 8 * fq;
        f32x4 bg[2], bu[2];
#pragma unroll
        for (int n = 0; n < 2; ++n) { bg[n] = *(const f32x4*)(bgu + (size_t)e * 4096 + c0 + 4 * n); bu[n] = *(const f32x4*)(bgu + (size_t)e * 4096 + 2048 + c0 + 4 * n); }
#pragma unroll
        for (int ai = 0; ai < 2; ++ai)
#pragma unroll
            for (int m = 0; m < 4; ++m) {
                const int row = u.pm * BM + ai * HALF + wr * 64 + m * 16 + fr;
                f32x4 o[2];
#pragma unroll
                for (int n = 0; n < 2; ++n) { const f32x4 g = acc[ai][0][m][n] + bg[n], up = acc[ai][1][m][n] + bu[n];
#pragma unroll
                    for (int j = 0; j < 4; ++j) { const float gg = fminf(g[j], 7.0f), uu = fminf(fmaxf(up[j], -7.0f), 7.0f); o[n][j] = gg * sigmoidf_fast(1.702f * gg) * (uu + 1.0f); } }
                *(u32x4*)(ACT + (size_t)row * 2048 + c0) = pack8_bf16(o[0], o[1]);
            }
    }
};
struct EpiDN {
    static constexpr bool PERM = true, AFTER_DRAIN = false;
    bf16_t* Y; const float* bdn;
    __device__ __forceinline__ void operator()(const f32x4 (&acc)[2][2][4][2], const Unit& u, int wr, int wc, int fr, int fq) const {
        const int e = u.pn >> 3, c0 = 256 * (u.pn & 7) + wc * 32 + 8 * fq;
        f32x4 bv[2][2];
#pragma unroll
        for (int bj = 0; bj < 2; ++bj)
#pragma unroll
            for (int n = 0; n < 2; ++n) bv[bj][n] = *(const f32x4*)(bdn + (size_t)e * 2048 + c0 + bj * HALF + 4 * n);
#pragma unroll
        for (int ai = 0; ai < 2; ++ai)
#pragma unroll
            for (int m = 0; m < 4; ++m) {
                const int row = u.pm * BM + ai * HALF + wr * 64 + m * 16 + fr;
#pragma unroll
                for (int bj = 0; bj < 2; ++bj) *(u32x4*)(Y + (size_t)row * 2048 + c0 + bj * HALF) = pack8_bf16(acc[ai][bj][m][0] + bv[bj][0], acc[ai][bj][m][1] + bv[bj][1]);
            }
    }
};
struct GroupedOrder {
    const int* texp; int NPN, nwg, G, c;
    __device__ void init(const int* texp_, int T, int NPN_, int G_, int c_) { texp = texp_; NPN = NPN_; nwg = T * NPN_; G = G_; c = c_; }
    __device__ bool next(int i, Unit& u) const {
        const long L = (long)i * G + c; if (L >= nwg) return false;
        int wgid = (int)L; { const int q = nwg / NXCD, r = nwg % NXCD, xcd = wgid % NXCD, off = wgid / NXCD; wgid = (xcd < r ? xcd * (q + 1) : r * (q + 1) + (xcd - r) * q) + off; }
        const int mt = wgid / NPN, t = wgid - mt * NPN;
        const int e = __builtin_amdgcn_readfirstlane(__hip_atomic_load(texp + mt, __ATOMIC_RELAXED, __HIP_MEMORY_SCOPE_AGENT));
        u.pm = mt; u.pn = e * NPN + t; return true;
    }
    __device__ __forceinline__ void a_ready(const Unit&) const {}
    __device__ __forceinline__ void done(const Unit&) const {}
};
template <class Epi, class Sched, bool ALIGN_EPI = false, bool SP2 = false>
__device__ __forceinline__ void gemm_phase(PG8_LAS unsigned char* lds, const Gemm g, const Sched& S, const Epi& E) {
    int tid_o = threadIdx.x; asm volatile("" : "+v"(tid_o));
    const int tid = tid_o, wid = __builtin_amdgcn_readfirstlane(tid >> 6), lane = tid & 63, wr = wid >> 2, wc = wid & 3, fr = lane & 15, fq = lane >> 4;
    const int K = g.K, nt = K / BK;
    unsigned voffA[2], voffB[2];
#pragma unroll
    for (int i = 0; i < 2; ++i) { int R, C; stage_rc(tid * 16 + i * 8192, R, C); const int Rb = Epi::PERM ? ((R & ~31) + perm32(R & 31)) : R;
        voffA[i] = (unsigned)(R * K + C) * 2u; voffB[i] = (unsigned)(Rb * K + C) * 2u; }
    const size_t kstep = (size_t)(BK * 2);
    const size_t hstep = (size_t)HALF * K * 2;
    const size_t tstep = 2 * hstep;
    const unsigned ldsw = (unsigned)wid * 1024u;
    const int aoff = lds_byte(wr * 64 + fr, fq * 8), boff = lds_byte(wc * 32 + fr, fq * 8);
#define PG8_SA(b, h) (((b) * 2 + (h)) * HTB)
#define PG8_SB(b, h) ((4 + (b) * 2 + (h)) * HTB)
#define PG8_STAGE(bufoff, gbase, voff) do { _Pragma("unroll") for (int _i = 0; _i < 2; ++_i) \
        __builtin_amdgcn_global_load_lds((const unsigned*)((const char*)(gbase) + (voff)[_i]), (PG8_LAS unsigned*)(lds + (bufoff) + ldsw + _i * 8192), 16, 0, 0); } while (0)
#define PG8_LDA(dst, b, h) do { _Pragma("unroll") for (int m = 0; m < 4; ++m) _Pragma("unroll") for (int k = 0; k < 2; ++k) dst[m][k] = *(const PG8_LAS bf16x8*)(lds + PG8_SA(b, h) + aoff + m * 2048 + k * 1024); } while (0)
#define PG8_LDB(dst, b, h) do { _Pragma("unroll") for (int n = 0; n < 2; ++n) _Pragma("unroll") for (int k = 0; k < 2; ++k) dst[n][k] = *(const PG8_LAS bf16x8*)(lds + PG8_SB(b, h) + boff + n * 2048 + k * 1024); } while (0)
#define PG8_MMA(ai, bj, At, Bt) do { __builtin_amdgcn_s_setprio(1); _Pragma("unroll") for (int m = 0; m < 4; ++m) _Pragma("unroll") for (int n = 0; n < 2; ++n) _Pragma("unroll") for (int k = 0; k < 2; ++k) \
        acc[ai][bj][m][n] = __builtin_amdgcn_mfma_f32_16x16x32_bf16(Bt[n][k], At[m][k], acc[ai][bj][m][n], 0, 0, 0); __builtin_amdgcn_s_setprio(0); } while (0)
#define PG8_WAIT_V(n) asm volatile("s_waitcnt vmcnt(" #n ")" ::: "memory")
#define PG8_WAIT_L(n) asm volatile("s_waitcnt lgkmcnt(" #n ")" ::: "memory")
#define PG8_BAR __builtin_amdgcn_s_barrier()
#define PG8_SCHED __builtin_amdgcn_sched_barrier(0)
    Unit cur, nxt; int ui = 0;
    if (!S.next(0, cur)) return;
    f32x4 acc[2][2][4][2];
#pragma unroll
    for (int a = 0; a < 2; ++a)
#pragma unroll
        for (int b = 0; b < 2; ++b)
#pragma unroll
            for (int m = 0; m < 4; ++m)
#pragma unroll
                for (int n = 0; n < 2; ++n) acc[a][b][m][n] = (f32x4){0.f, 0.f, 0.f, 0.f};
    bf16x8 At[4][2], B0[2][2], B1[2][2];
    const char* cA = (const char*)g.A + (size_t)cur.pm * tstep; const char* cB = (const char*)g.Bt + (size_t)cur.pn * tstep;
    S.a_ready(cur);
    if constexpr (SP2) {
        PG8_STAGE(PG8_SB(0, 0), cB, voffB); PG8_STAGE(PG8_SB(0, 1), cB + hstep, voffB); PG8_STAGE(PG8_SA(0, 0), cA, voffA); PG8_STAGE(PG8_SA(0, 1), cA + hstep, voffA);
        if (wr == 1) PG8_BAR;
        PG8_WAIT_V(2); PG8_BAR;
        PG8_STAGE(PG8_SB(1, 0), cB + kstep, voffB); PG8_STAGE(PG8_SA(1, 0), cA + kstep, voffA); PG8_STAGE(PG8_SB(1, 1), cB + hstep + kstep, voffB);
        PG8_WAIT_V(6); PG8_BAR;
    } else {
        PG8_STAGE(PG8_SB(0, 0), cB, voffB); PG8_STAGE(PG8_SA(0, 0), cA, voffA); PG8_STAGE(PG8_SB(0, 1), cB + hstep, voffB); PG8_STAGE(PG8_SA(0, 1), cA + hstep, voffA);
        if (wr == 1) PG8_BAR;
        PG8_WAIT_V(4); PG8_BAR;
        PG8_STAGE(PG8_SB(1, 0), cB + kstep, voffB); PG8_STAGE(PG8_SA(1, 0), cA + kstep, voffA); PG8_STAGE(PG8_SB(1, 1), cB + hstep + kstep, voffB);
        PG8_WAIT_V(6); PG8_BAR;
    }
    for (;;) {
        const bool has_next = S.next(ui + 1, nxt);
        const char* nA = has_next ? (const char*)g.A + (size_t)nxt.pm * tstep : cA; const char* nB = has_next ? (const char*)g.Bt + (size_t)nxt.pn * tstep : cB;
        for (int t = 0; t < nt; t += 2) {
            const bool last = (t == nt - 2);
            const char* a1 = cA + (size_t)(t + 1) * kstep;
            const char* a2 = last ? nA : cA + (size_t)(t + 2) * kstep; const char* b2 = last ? nB : cB + (size_t)(t + 2) * kstep;
            const char* a3 = a2 + kstep; const char* b3 = b2 + kstep;
            if (last && has_next) S.a_ready(nxt);
            if constexpr (SP2) {
            PG8_LDB(B0, 0, 0); PG8_LDB(B1, 0, 1); PG8_SCHED; PG8_LDA(At, 0, 0); PG8_STAGE(PG8_SA(1, 1), a1 + hstep, voffA);
            PG8_WAIT_V(8); PG8_WAIT_L(0); PG8_BAR; PG8_MMA(0, 0, At, B0); PG8_MMA(0, 1, At, B1); PG8_BAR; PG8_SCHED;
            PG8_LDA(At, 0, 1); PG8_STAGE(PG8_SB(0, 0), b2, voffB); PG8_STAGE(PG8_SB(0, 1), b2 + hstep, voffB); PG8_STAGE(PG8_SA(0, 0), a2, voffA);
            PG8_WAIT_V(8); PG8_WAIT_L(0); PG8_BAR; PG8_MMA(1, 0, At, B0); PG8_MMA(1, 1, At, B1); PG8_BAR; PG8_SCHED;
            PG8_LDB(B0, 1, 0); PG8_LDB(B1, 1, 1); PG8_SCHED; PG8_LDA(At, 1, 0); PG8_STAGE(PG8_SA(0, 1), a2 + hstep, voffA);
            PG8_WAIT_V(8); PG8_WAIT_L(0); PG8_BAR; PG8_MMA(0, 0, At, B0); PG8_MMA(0, 1, At, B1); PG8_BAR; PG8_SCHED;
            PG8_LDA(At, 1, 1); PG8_STAGE(PG8_SB(1, 0), b3, voffB); PG8_STAGE(PG8_SB(1, 1), b3 + hstep, voffB); PG8_STAGE(PG8_SA(1, 0), a3, voffA);
            PG8_WAIT_V(8); PG8_WAIT_L(0); PG8_BAR; PG8_MMA(1, 0, At, B0); PG8_MMA(1, 1, At, B1); PG8_BAR; PG8_SCHED;
            } else {
            PG8_LDB(B0, 0, 0); PG8_SCHED; PG8_LDA(At, 0, 0); PG8_STAGE(PG8_SA(1, 1), a1 + hstep, voffA);
            PG8_WAIT_L(8); PG8_BAR; PG8_WAIT_L(0); PG8_MMA(0, 0, At, B0); PG8_BAR; PG8_SCHED;
            PG8_LDB(B1, 0, 1); PG8_STAGE(PG8_SB(0, 0), b2, voffB);
            PG8_BAR; PG8_WAIT_L(0); PG8_MMA(0, 1, At, B1); PG8_BAR;
            PG8_LDA(At, 0, 1); PG8_STAGE(PG8_SA(0, 0), a2, voffA);
            PG8_BAR; PG8_WAIT_L(0); PG8_MMA(1, 0, At, B0); PG8_BAR; PG8_SCHED;
            PG8_STAGE(PG8_SB(0, 1), b2 + hstep, voffB);
            PG8_WAIT_V(6); PG8_BAR; PG8_MMA(1, 1, At, B1); PG8_BAR;
            PG8_LDB(B0, 1, 0); PG8_SCHED; PG8_LDA(At, 1, 0); PG8_STAGE(PG8_SA(0, 1), a2 + hstep, voffA);
            PG8_WAIT_L(8); PG8_BAR; PG8_WAIT_L(0); PG8_MMA(0, 0, At, B0); PG8_BAR; PG8_SCHED;
            PG8_LDB(B1, 1, 1); PG8_STAGE(PG8_SB(1, 0), b3, voffB);
            PG8_BAR; PG8_WAIT_L(0); PG8_MMA(0, 1, At, B1); PG8_BAR;
            PG8_LDA(At, 1, 1); PG8_STAGE(PG8_SA(1, 0), a3, voffA);
            PG8_BAR; PG8_WAIT_L(0); PG8_MMA(1, 0, At, B0); PG8_BAR; PG8_SCHED;
            PG8_STAGE(PG8_SB(1, 1), b3 + hstep, voffB);
            PG8_WAIT_V(6); PG8_BAR; PG8_MMA(1, 1, At, B1); PG8_BAR;
            }
        }
        if constexpr (ALIGN_EPI) { if (wr == 0) PG8_BAR; }
        if constexpr (!Epi::AFTER_DRAIN) { E(acc, cur, wr, wc, fr, fq); S.done(cur); }
        if (!has_next) break;
#pragma unroll
        for (int a = 0; a < 2; ++a)
#pragma unroll
            for (int b = 0; b < 2; ++b)
#pragma unroll
                for (int m = 0; m < 4; ++m)
#pragma unroll
                    for (int n = 0; n < 2; ++n) acc[a][b][m][n] = (f32x4){0.f, 0.f, 0.f, 0.f};
        cur = nxt; cA = nA; cB = nB; ++ui;
        if constexpr (ALIGN_EPI) { if (wr == 1) PG8_BAR; }
    }
    PG8_WAIT_V(0);
    if constexpr (!ALIGN_EPI) { if (wr == 0) PG8_BAR; }
    PG8_BAR;
    if constexpr (Epi::AFTER_DRAIN) { E.fused(acc, cur, wr, wc, fr, fq, lds, wid, lane); S.done(cur); }
#undef PG8_SA
#undef PG8_SB
#undef PG8_STAGE
#undef PG8_LDA
#undef PG8_LDB
#undef PG8_MMA
#undef PG8_WAIT_V
#undef PG8_WAIT_L
#undef PG8_BAR
#undef PG8_SCHED
}
}
namespace fox {
constexpr float THR = 8.f; constexpr int D = 128;
constexpr float SCALE = 0.08838834764831845f;
constexpr int NW = 8, QBLK = 32, KVBLK = 64, QB = NW * QBLK;
constexpr int SHM_V = KVBLK * D * 2, SHM_K = KVBLK * D * 2;
using bf16 = __hip_bfloat16;
typedef short bf16x8 __attribute__((ext_vector_type(8)));
typedef short s16x4 __attribute__((ext_vector_type(4)));
typedef float f32x16 __attribute__((ext_vector_type(16)));
typedef float f32x4 __attribute__((ext_vector_type(4)));
typedef unsigned u32x4 __attribute__((ext_vector_type(4)));
template <class A, class Bt> struct same_t { static constexpr bool v = false; };
template <class A> struct same_t<A, A> { static constexpr bool v = true; };

#define KSWZ(row, colB) ((row) * 256 + ((colB) ^ (((row) & 7) << 4)))
#define SBAR() __builtin_amdgcn_sched_barrier(0)
__device__ __forceinline__ int v_st(int k, int c) { const int kk = (k & ~0xC) | ((k & 4) << 1) | ((k & 8) >> 1); return ((kk >> 3) * 4 + (c >> 5)) * 512 + ((kk & 7) * 32 + (c & 31)) * 2; }
__device__ __forceinline__ int v_rd_base(int lane) { return ((lane & 3) << 3) | (((lane >> 2) & 3) << 6) | (((lane >> 4) & 1) << 5) | (((lane >> 5) & 1) << 8); }
constexpr int v_rd_off(int d0, int ks, int half) { return d0 * 512 + ks * 4096 + half * 2048; }
__device__ __forceinline__ int crow(int r, int hi) { return (r & 3) + 8 * (r >> 2) + 4 * hi; }
__device__ __forceinline__ unsigned cvtpk(float lo, float hi) {
    unsigned r; asm volatile("v_cvt_pk_bf16_f32 %0, %1, %2" : "=v"(r) : "v"(lo), "v"(hi)); return r;
}
__device__ __forceinline__ bf16x8 pack8(f32x4 a, f32x4 b) {
    u32x4 w = {cvtpk(a[0], a[1]), cvtpk(a[2], a[3]), cvtpk(b[0], b[1]), cvtpk(b[2], b[3])};
    return *reinterpret_cast<bf16x8*>(&w);
}
template <class T> __device__ __forceinline__ bf16x8 load8(const T* p) {
    if constexpr (same_t<T, float>::v) { return pack8(*(const f32x4*)p, *(const f32x4*)(p + 4)); }
    else { return *reinterpret_cast<const bf16x8*>(p); }
}
__device__ __forceinline__ void mask_tile(f32x16& p0, f32x16& p1, int dq, unsigned W) {
    const float NEG = -__builtin_inff();
#pragma unroll
    for (int r = 0; r < 16; ++r) {
        const int c = (r & 3) + 8 * (r >> 2);
        if ((unsigned)(dq - c) >= W) p0[r] = NEG;
        if ((unsigned)(dq - c - 32) >= W) p1[r] = NEG;
    }
}
__device__ __forceinline__ void partialSM(f32x16& p0, f32x16& p1, float& m_reg, float& mn, float& alpha) {
    float pmax = p0[0]; for (int r = 1; r < 16; ++r) pmax = fmaxf(pmax, p0[r]); for (int r = 0; r < 16; ++r) pmax = fmaxf(pmax, p1[r]);
    { auto rr = __builtin_amdgcn_permlane32_swap(__float_as_uint(pmax), __float_as_uint(pmax), false, false);
      pmax = fmaxf(__uint_as_float(rr[0]), __uint_as_float(rr[1])); }
    constexpr float C2 = 1.4426950408889634f * SCALE;
    if (__builtin_expect(__all((pmax - m_reg) * SCALE <= THR), 1)) { mn = m_reg; alpha = 1.f; }
    else { mn = fmaxf(m_reg, pmax); alpha = __builtin_amdgcn_exp2f((m_reg - mn) * C2); m_reg = mn; }
    const float mnL = -mn * C2;
    for (int r = 0; r < 16; ++r) p0[r] = fmaf(p0[r], C2, mnL); for (int r = 0; r < 16; ++r) p1[r] = fmaf(p1[r], C2, mnL);
    for (int r = 0; r < 16; ++r) p0[r] = __builtin_amdgcn_exp2f(p0[r]);
}
__device__ __forceinline__ void finishSM(f32x16& p0, f32x16& p1, float alpha, float& l_reg, bf16x8& pa0, bf16x8& pa1, bf16x8& pa2, bf16x8& pa3) {
    for (int r = 0; r < 16; ++r) p1[r] = __builtin_amdgcn_exp2f(p1[r]);
    float ps = 0; for (int r = 0; r < 16; ++r) ps += p0[r]; for (int r = 0; r < 16; ++r) ps += p1[r];
    { auto rr = __builtin_amdgcn_permlane32_swap(__float_as_uint(ps), __float_as_uint(ps), false, false);
      ps = __uint_as_float(rr[0]) + __uint_as_float(rr[1]); }
    l_reg = l_reg * alpha + ps;
#define PK4(P, B_, OUT) do { unsigned a0 = cvtpk(P[B_+0], P[B_+1]), a1 = cvtpk(P[B_+2], P[B_+3]);                          \
        unsigned b0 = cvtpk(P[B_+4], P[B_+5]), b1 = cvtpk(P[B_+6], P[B_+7]);                                             \
        auto r0 = __builtin_amdgcn_permlane32_swap(a0, b0, false, false); auto r1 = __builtin_amdgcn_permlane32_swap(a1, b1, false, false); \
        u32x4 w = {r0[0], r1[0], r0[1], r1[1]}; OUT = *reinterpret_cast<bf16x8*>(&w); } while (0)
    PK4(p0, 0, pa0); PK4(p0, 8, pa1); PK4(p1, 0, pa2); PK4(p1, 8, pa3);
#undef PK4
}
template <int KB, bool SK>
__device__ __forceinline__ void qkt(f32x16& p0, f32x16& p1, const char* K_lds, int r32, int hi, const char* Qw, bool act) {
    if (SK && !act) { const float NEG = -__builtin_inff();
#pragma unroll
        for (int r = 0; r < 16; ++r) { p0[r] = NEG; p1[r] = NEG; } return; }
    p0 = f32x16{}; p1 = f32x16{};
    const char* kb[4]; const char* qb4[4];
#pragma unroll
    for (int dd = 0; dd < 4; ++dd) { kb[dd] = K_lds + KB * SHM_K + KSWZ(r32, (dd * 16 + hi * 8) * 2); qb4[dd] = Qw + KSWZ(r32, (dd * 16 + hi * 8) * 2); }
#pragma unroll
    for (int d0 = 0; d0 < 8; ++d0) { const char* a = kb[d0 & 3] + (d0 >> 2) * 128;
        bf16x8 b0 = *reinterpret_cast<const bf16x8*>(a);
        bf16x8 b1 = *reinterpret_cast<const bf16x8*>(a + 32 * 256);
        bf16x8 qf = *reinterpret_cast<const bf16x8*>(qb4[d0 & 3] + (d0 >> 2) * 128);
        p0 = __builtin_amdgcn_mfma_f32_32x32x16_bf16(b0, qf, p0, 0, 0, 0);
        p1 = __builtin_amdgcn_mfma_f32_32x32x16_bf16(b1, qf, p1, 0, 0, 0); }
}
template <int VB, bool SK>
__device__ __forceinline__ void pv_tile(f32x16* o, int vb0, bf16x8 pa0, bf16x8 pa1, bf16x8 pa2, bf16x8 pa3, bool act) {
    if (SK && !act) return;
#define TRRD(dst, off) asm volatile("ds_read_b64_tr_b16 %0, %1 offset:%2" : "=&v"(dst) : "v"(vb0), "i"(off) : "memory")
#define PV_D0(d0) do { s16x4 l0, l1, l2, l3, h0, h1, h2, h3; constexpr int b_ = VB * SHM_V + v_rd_off(d0, 0, 0);     \
        TRRD(l0, b_); TRRD(h0, b_ + 2048); TRRD(l1, b_ + 4096); TRRD(h1, b_ + 6144); TRRD(l2, b_ + 8192); TRRD(h2, b_ + 10240); TRRD(l3, b_ + 12288); TRRD(h3, b_ + 14336); \
        asm volatile("s_waitcnt lgkmcnt(0)" ::: "memory"); SBAR();                 \
        o[d0] = __builtin_amdgcn_mfma_f32_32x32x16_bf16(pa0, (bf16x8){l0[0], l0[1], l0[2], l0[3], h0[0], h0[1], h0[2], h0[3]}, o[d0], 0, 0, 0);   \
        o[d0] = __builtin_amdgcn_mfma_f32_32x32x16_bf16(pa1, (bf16x8){l1[0], l1[1], l1[2], l1[3], h1[0], h1[1], h1[2], h1[3]}, o[d0], 0, 0, 0);   \
        o[d0] = __builtin_amdgcn_mfma_f32_32x32x16_bf16(pa2, (bf16x8){l2[0], l2[1], l2[2], l2[3], h2[0], h2[1], h2[2], h2[3]}, o[d0], 0, 0, 0);   \
        o[d0] = __builtin_amdgcn_mfma_f32_32x32x16_bf16(pa3, (bf16x8){l3[0], l3[1], l3[2], l3[3], h3[0], h3[1], h3[2], h3[3]}, o[d0], 0, 0, 0); } while (0)
    PV_D0(0); PV_D0(1); PV_D0(2); PV_D0(3);
#undef PV_D0
#undef TRRD
}
constexpr int LDS_CK = 2 * SHM_V + 2 * SHM_K + NW * 64 * 4, LDS_Q = LDS_CK + 2 * 64 * 4, LDS_BYTES_FOX = LDS_Q + NW * QBLK * D * 2;
struct FoxRef { const bf16* Q; const bf16* K; const bf16* V; const float* C; bf16* O; float* ML; int P0, j_lo, j_hi; };
struct FoxSeam { bf16x8 qr[8]; bf16x8 st_v0, st_v1, st_k0, st_k1; float st_c; };
#define ROW(p, k0, rr) ((p) + (size_t)((k0) + (rr)) * D + sc)
#define VMW() asm volatile("s_waitcnt vmcnt(0)" ::: "memory")
#define VMWN(n) asm volatile("s_waitcnt vmcnt(%0)" :: "i"(n) : "memory")
#define SLOAD_H(Kp, Vp, Cp, k0) do { S.st_v0 = load8<bf16>(ROW(Vp, k0, sr)); S.st_v1 = load8<bf16>(ROW(Vp, k0, 32 + sr));              \
                         S.st_k0 = load8<bf16>(ROW(Kp, k0, sr)); S.st_k1 = load8<bf16>(ROW(Kp, k0, 32 + sr)); S.st_c = (Cp)[(k0) + (tid & 63)]; } while (0)
#define SWRITE_HK(bf) do { *(bf16x8*)(K_lds + (bf) * SHM_K + kws) = S.st_k0; *(bf16x8*)(K_lds + (bf) * SHM_K + kws + 32 * 256) = S.st_k1; \
                           if (tid < 64) ck_lds[(bf) * 64 + tid] = S.st_c; } while (0)
#define SWRITE_HV(bf) do { *(bf16x8*)(V_lds + (bf) * SHM_V + vst0) = S.st_v0; *(bf16x8*)(V_lds + (bf) * SHM_V + vst1) = S.st_v1; } while (0)
#define SWRITE_H(bf) do { SWRITE_HV(bf); SWRITE_HK(bf); } while (0)
__device__ __forceinline__ void fox_prime(const FoxRef& cur, char* lds, FoxSeam& S) {
    const int tid = threadIdx.x, wid = __builtin_amdgcn_readfirstlane(tid >> 6), lane = tid & 63, r32 = lane & 31, hi = lane >> 5;
    const int sr = tid >> 4, sc = (tid & 15) * 8, kws = KSWZ(sr, sc * 2); char* K_lds = lds + 2 * SHM_V; float* ck_lds = (float*)(lds + LDS_CK);
    const int kb0 = cur.j_lo * KVBLK;
    for (int d0 = 0; d0 < 8; ++d0) S.qr[d0] = load8<bf16>(cur.Q + (size_t)(wid * QBLK + r32) * D + d0 * 16 + hi * 8);
    SLOAD_H(cur.K, cur.V, cur.C, kb0); VMW(); SWRITE_HK(0);
    __syncthreads();
}
__device__ __forceinline__ void fox_block(const FoxRef& cur, const FoxRef& nxt, char* lds, FoxSeam& S) {
    constexpr bool SK = false; constexpr unsigned W = 0x7fffffffu;
    int tid_o = threadIdx.x; asm volatile("" : "+v"(tid_o));
    const int tid = tid_o, wid = __builtin_amdgcn_readfirstlane(tid >> 6), lane = tid & 63, r32 = lane & 31, hi = lane >> 5;
    const int j_lo = cur.j_lo, j_hi = cur.j_hi;
    const int NT = j_hi - j_lo;
    const int kbn = nxt.j_lo * KVBLK;
    const int qlo = cur.P0 + wid * QBLK, qm = qlo + r32 - 4 * hi;
    char* V_lds = lds; char* K_lds = lds + 2 * SHM_V;
    float* ws = (float*)(lds + 2 * SHM_V + 2 * SHM_K) + wid * 64; float* li_l = ws, * al_l = ws + 32;
    float* ck_lds = (float*)(lds + LDS_CK);
    float m_reg = -1e30f, l_reg = 0; f32x16 o[4] = {};
    const int sr = tid >> 4, sc = (tid & 15) * 8, vst0 = v_st(sr, sc), vst1 = v_st(32 + sr, sc), kws = KSWZ(sr, sc * 2);
    const int vb0 = (int)(uintptr_t)V_lds + v_rd_base(lane);
    const bf16* Kh = cur.K; const bf16* Vh = cur.V; const float* Ch = cur.C;
#define RESC(a) do { if (__any((a) < 1.f)) { if (hi == 0) al_l[r32] = (a); asm volatile("s_waitcnt lgkmcnt(0)" ::: "memory");              \
                     for (int d_ = 0; d_ < 4; ++d_) for (int r = 0; r < 16; ++r) o[d_][r] *= al_l[crow(r, hi)]; } } while (0)
#define KBASE(t) ((j_lo + (t)) * KVBLK)
#define BIAS(P0_, P1_, KB_) do { const float* cb_ = ck_lds + (KB_) * 64 + 4 * hi;                                                  \
        _Pragma("unroll") for (int g_ = 0; g_ < 4; ++g_) { const f32x4 c0_ = *(const f32x4*)(cb_ + 8 * g_), c1_ = *(const f32x4*)(cb_ + 32 + 8 * g_); \
            _Pragma("unroll") for (int j_ = 0; j_ < 4; ++j_) { P0_[4 * g_ + j_] -= c0_[j_]; P1_[4 * g_ + j_] -= c1_[j_]; } } } while (0)
#define MASKT(P0_, P1_, t) do { const int kb_ = KBASE(t); if (kb_ + KVBLK - 1 > qlo) mask_tile(P0_, P1_, qm - kb_, W); } while (0)
    constexpr int NQL = 8;
#define SEAM_K0() do { VMWN(NQL); SWRITE_HK(0); SBAR(); } while (0)
    f32x16 pA0, pA1, pB0, pB1; float mnA, mnB, alA, alB; bf16x8 pa0, pa1, pa2, pa3;
    char* Qw = lds + LDS_Q + wid * (QBLK * D * 2);
#pragma unroll
    for (int d0 = 0; d0 < 8; ++d0) *(bf16x8*)(Qw + KSWZ(r32, ((d0 & 3) * 16 + hi * 8) * 2) + (d0 >> 2) * 128) = S.qr[d0];
    SWRITE_HV(0); SBAR();
    if (NT > 1) { SLOAD_H(Kh, Vh, Ch, KBASE(1)); }
    SBAR(); qkt<0, SK>(pA0, pA1, K_lds, r32, hi, Qw, true);
    BIAS(pA0, pA1, 0); MASKT(pA0, pA1, 0); partialSM(pA0, pA1, m_reg, mnA, alA);
    if (NT > 1) { VMW(); SWRITE_H(1); }
    __syncthreads();
#define HALF_STEP(PX0, PX1, mnX, alX, PY0, PY1, alY, t, KB, VB, SB) do {                                                      \
        SBAR(); qkt<KB, SK>(PX0, PX1, K_lds, r32, hi, Qw, true);                                                            \
        finishSM(PY0, PY1, alY, l_reg, pa0, pa1, pa2, pa3); SBAR();                                                           \
        if ((t) + 1 < NT) { SLOAD_H(Kh, Vh, Ch, KBASE((t) + 1)); SBAR(); }                                                    \
        pv_tile<VB, SK>(o, vb0, pa0, pa1, pa2, pa3, true); BIAS(PX0, PX1, KB); MASKT(PX0, PX1, (t)); partialSM(PX0, PX1, m_reg, mnX, alX); \
        __syncthreads();                                                                                                      \
        if ((t) + 1 < NT) { VMW(); SWRITE_H(SB); }                                                                            \
        RESC(alX); __syncthreads(); } while (0)
    for (int t = 1; t + 1 < NT; t += 2) {
        HALF_STEP(pB0, pB1, mnB, alB, pA0, pA1, alA, t, 1, 0, 0);
        HALF_STEP(pA0, pA1, mnA, alA, pB0, pB1, alB, t + 1, 0, 1, 1);
    }
    const bool even = (NT & 1) == 0;
    if (even) { SBAR(); qkt<1, SK>(pB0, pB1, K_lds, r32, hi, Qw, true); SBAR(); }
    SLOAD_H(nxt.K, nxt.V, nxt.C, kbn); SBAR();
#pragma unroll
    for (int d0 = 0; d0 < 8; ++d0) S.qr[d0] = load8<bf16>(nxt.Q + (size_t)(wid * QBLK + r32) * D + d0 * 16 + hi * 8);
    SBAR();
    finishSM(pA0, pA1, alA, l_reg, pa0, pa1, pa2, pa3); SBAR();
    pv_tile<0, SK>(o, vb0, pa0, pa1, pa2, pa3, true);
    if (even) { BIAS(pB0, pB1, 1); MASKT(pB0, pB1, NT - 1); partialSM(pB0, pB1, m_reg, mnB, alB); __syncthreads(); RESC(alB);
        finishSM(pB0, pB1, alB, l_reg, pa0, pa1, pa2, pa3); SBAR(); pv_tile<1, SK>(o, vb0, pa0, pa1, pa2, pa3, true); }
    SBAR(); SEAM_K0();
    if (hi == 0) li_l[r32] = l_reg; asm volatile("s_waitcnt lgkmcnt(0)" ::: "memory");
    if (hi == 0) *(float2*)(cur.ML + (wid * QBLK + r32) * 2) = make_float2(m_reg, l_reg);
    float rli[16];
#pragma unroll
    for (int r = 0; r < 16; ++r) { const float lv = li_l[crow(r, hi)]; rli[r] = lv > 0.f ? __builtin_amdgcn_rcpf(lv) : 0.f; }
    bf16* Ow = cur.O + (size_t)(wid * QBLK) * D;
#pragma unroll
    for (int r = 0; r < 16; ++r) { const int orow = crow(r, hi);
#pragma unroll
        for (int d0 = 0; d0 < 4; ++d0) { const float v = o[d0][r] * rli[r];
            const float vn = __shfl_xor(v, 1);
            if ((r32 & 1) == 0) *(unsigned*)(Ow + (size_t)orow * D + d0 * 32 + r32) = cvtpk(v, vn); } }
    __syncthreads();
#undef RESC
#undef KBASE
#undef BIAS
#undef MASKT
#undef SEAM_K0
#undef HALF_STEP
}
#undef ROW
#undef VMW
#undef VMWN
#undef SLOAD_H
#undef SWRITE_HK
#undef SWRITE_HV
#undef SWRITE_H
}
constexpr int NWAVES = 8, NTHREADS = 512;
constexpr int DM = 2048, SEQ = 8192, NMETA = 16, LTOT = SEQ + NMETA, NHEAD = 8, HDIM = 128, INCOLS = 5128, NIN = 5120;
constexpr int NEXP = 32, TOPK = 4, CKW = 31;
constexpr int MIN_ROWS = 8448;
constexpr int SKV = 8256;
constexpr int MAXT = 160, PROWS = MAXT * 256;
constexpr float NORM_EPS = 1e-5f;
constexpr float INV_SCALE = 11.313708498984761f;
constexpr size_t MiB = 1u << 20;
constexpr size_t WS_CTL = 0, CTL_ZERO_BYTES = 1 * MiB;
constexpr size_t WS_WIN = 1 * MiB, WS_WOUT = 21 * MiB, WS_WGU = 32 * MiB, WS_WDN = 544 * MiB, WS_HN = 800 * MiB, WS_Q = 834 * MiB, WS_K = 850 * MiB, WS_V = 867 * MiB,
                 WS_U = 884 * MiB, WS_MIXED = 901 * MiB, WS_H = 933 * MiB, WS_HN2 = 997 * MiB, WS_XG = 1029 * MiB, WS_ACT = 1189 * MiB, WS_Y = 1349 * MiB,
                 WS_OPART = 1509 * MiB, WS_ML = 1573 * MiB, WS_LOGF = 1575 * MiB, WS_CS = 1576 * MiB, WS_ROUTE = 1577 * MiB, WS_END = 1579 * MiB;
static_assert(WS_WIN + (size_t)NIN * DM * 2 <= WS_WOUT && WS_WOUT + (size_t)DM * DM * 2 <= WS_WGU && WS_WGU + (size_t)NEXP * 4096 * DM * 2 <= WS_WDN && WS_WDN + (size_t)NEXP * DM * DM * 2 <= WS_HN, "ws map 1");
static_assert(WS_HN + (size_t)MIN_ROWS * DM * 2 <= WS_Q && WS_Q + (size_t)NHEAD * SEQ * HDIM * 2 <= WS_K && WS_K + (size_t)NHEAD * SKV * HDIM * 2 <= WS_V && WS_V + (size_t)NHEAD * SKV * HDIM * 2 <= WS_U, "ws map 2");
static_assert(WS_U + (size_t)LTOT * 1024 * 2 <= WS_MIXED && WS_MIXED + (size_t)SEQ * DM * 2 <= WS_H && WS_H + (size_t)SEQ * DM * 4 <= WS_HN2 && WS_HN2 + (size_t)SEQ * DM * 2 <= WS_XG, "ws map 3");
static_assert(WS_XG + (size_t)PROWS * DM * 2 <= WS_ACT && WS_ACT + (size_t)PROWS * DM * 2 <= WS_Y && WS_Y + (size_t)PROWS * DM * 2 <= WS_OPART && WS_OPART + (size_t)1024 * 256 * 128 * 2 <= WS_ML, "ws map 4");
static_assert(WS_ML + (size_t)1024 * 512 * 4 <= WS_LOGF && WS_LOGF + (size_t)LTOT * 8 * 4 <= WS_CS && WS_CS + (size_t)NHEAD * SKV * 4 <= WS_ROUTE && WS_ROUTE + (size_t)4 * SEQ * 4 * 4 <= WS_END, "ws map 5");
constexpr int CW_BAR = 4096, CW_QUEUE = 8192, CW_CNT = 8256, CW_TEXP = 8320  , CW_NT = 8512  ;
constexpr int RING_BYTES = 135168, MISC_OFF = RING_BYTES, LDS_BYTES = RING_BYTES + 1024;

#define GAS __attribute__((address_space(1)))
#define LAS __attribute__((address_space(3)))
typedef unsigned short bf16;
typedef unsigned v4u __attribute__((ext_vector_type(4)));
typedef unsigned v2u __attribute__((ext_vector_type(2)));
typedef float f32x4 __attribute__((ext_vector_type(4)));
typedef float f32x16 __attribute__((ext_vector_type(16)));
typedef GAS unsigned gu32;
#define RLX_AGENT __ATOMIC_RELAXED, __HIP_MEMORY_SCOPE_AGENT
__device__ __forceinline__ unsigned pk2(float lo, float hi) { unsigned r; asm volatile("v_cvt_pk_bf16_f32 %0, %1, %2" : "=v"(r) : "v"(lo), "v"(hi)); return r; }
__device__ __forceinline__ float bf_lo(unsigned w) { return __uint_as_float(w << 16); }
__device__ __forceinline__ float bf_hi(unsigned w) { return __uint_as_float(w & 0xffff0000u); }
__device__ __forceinline__ float wave_sum(float v) {
#pragma unroll
    for (int o = 1; o < 64; o <<= 1) v += __shfl_xor(v, o);
    return v;
}
#define XB_TMO      128
#define XB_XCNT(j)  (256  + 64 * (j))
#define XB_XSUB(j)  (1280 + 64 * (j))
#define XB_XGEN(j)  (2304 + 64 * (j))
#define XB_TOP      3328
#define XB_TOPGEN   3392
#define XCD_BAR_WORDS 3456
#define XB_SPIN_CAP (1u << 18)

__device__ __forceinline__ unsigned xb_ld(unsigned* p)              { return __hip_atomic_load(p, __ATOMIC_RELAXED, __HIP_MEMORY_SCOPE_AGENT); }
__device__ __forceinline__ unsigned xb_add(unsigned* p, unsigned v) { return __hip_atomic_fetch_add(p, v, __ATOMIC_RELAXED, __HIP_MEMORY_SCOPE_AGENT); }
__device__ __forceinline__ unsigned xb_xcc_id() { return (unsigned)__builtin_amdgcn_s_getreg((3 << 11) | 20) & 0xFu; }
#define XB_SPIN(cond, bar) do { unsigned _sp = 0; while (cond) { __builtin_amdgcn_s_sleep(1); \
    if ((++_sp & 255u) == 0u) { if (xb_ld(&(bar)[XB_TMO])) break; if (_sp > XB_SPIN_CAP) { atomicAdd(&(bar)[XB_TMO], 1u); break; } } } } while (0)

struct XcdBarrier {
    unsigned* bar; unsigned x;
    volatile LAS unsigned* st;
};

__device__ __forceinline__ XcdBarrier xcd_barrier_post(unsigned* bar, volatile LAS unsigned* st) {
    XcdBarrier b; b.bar = bar; b.x = xb_xcc_id(); b.st = st;
    if (threadIdx.x == 0) (void)xb_add(&bar[XB_XCNT(b.x)], 1u);
    return b;
}
__device__ __forceinline__ void xcd_barrier_complete(unsigned* bar, unsigned x, unsigned& nloc, unsigned& nx) {
    const unsigned G = gridDim.x * gridDim.y * gridDim.z;
    unsigned sum, cnt, mine, sp = 0u;
    for (;;) {
        sum = 0u; cnt = 0u; mine = 0u;
#pragma unroll
        for (unsigned j = 0; j < 16; ++j) { const unsigned c = xb_ld(&bar[XB_XCNT(j)]); sum += c; cnt += (c > 0u) ? 1u : 0u; mine = (j == x) ? c : mine; }
        if (sum == G) break;
        __builtin_amdgcn_s_sleep(1);
        if ((++sp & 255u) == 0u) { if (xb_ld(&bar[XB_TMO])) break; if (sp > XB_SPIN_CAP) { atomicAdd(&bar[XB_TMO], 1u); break; } }
    }
    nloc = mine > 0u ? mine : 1u; nx = cnt > 0u ? cnt : 1u;
}

__device__ __forceinline__ void xcd_barrier(const XcdBarrier& b) {
    asm volatile("s_waitcnt vmcnt(0)" ::: "memory");
    __syncthreads();
    if (threadIdx.x == 0) {
        unsigned* bar = b.bar;
        __builtin_amdgcn_s_waitcnt(0);
        unsigned nloc = b.st[0], nx = b.st[1];
        if (nloc == 0u) { xcd_barrier_complete(bar, b.x, nloc, nx); b.st[0] = nloc; b.st[1] = nx; }
        const unsigned old = xb_add(&bar[XB_XSUB(b.x)], 1u);
        const unsigned gen = old / nloc;
        if (old + 1u == (gen + 1u) * nloc) {
            __builtin_amdgcn_fence(__ATOMIC_RELEASE, "agent");
            asm volatile("s_waitcnt vmcnt(0)" ::: "memory");
            const unsigned og = xb_add(&bar[XB_TOP], 1u);
            const unsigned tg = og / nx;
            if (og + 1u == (tg + 1u) * nx) xb_add(&bar[XB_TOPGEN], 1u);
            else XB_SPIN(xb_ld(&bar[XB_TOPGEN]) == tg, bar);
            __builtin_amdgcn_fence(__ATOMIC_ACQUIRE, "agent");
            xb_add(&bar[XB_XGEN(b.x)], 1u);
            asm volatile("s_waitcnt vmcnt(0)" ::: "memory");
        } else {
            XB_SPIN(xb_ld(&bar[XB_XGEN(b.x)]) == gen, bar);
            __builtin_amdgcn_fence(__ATOMIC_ACQUIRE, "agent");
            asm volatile("s_waitcnt vmcnt(0)" ::: "memory");
        }
    }
    __syncthreads();
}
struct Args { const float* in[19]; float* out; unsigned char* ws; };
enum { I_X = 0, I_META, I_G1, I_WIN, I_BF, I_BGLU, I_CW, I_CB, I_GNG, I_GNB, I_WOUT, I_G2, I_RW, I_RB, I_WGU, I_BGU, I_WDN, I_BDN, I_GF };

struct CvJob { const float* src; bf16* dst; int ld; };
constexpr int CV_GU = NEXP * 32 * 16, CV_DN = NEXP * 16 * 16, CV_IN = 40 * 16, CV_OUT = 16 * 16, CV_JOBS = CV_GU + CV_DN + CV_IN + CV_OUT;
__device__ __forceinline__ CvJob cv_decode(int job, const Args& a) {
    CvJob j;
    if (job < CV_GU) { const int e = job >> 9, r = job & 511, kb = r >> 5, nb = r & 31, col0 = (nb & 1) * 2048 + 128 * (nb >> 1);
        j.src = a.in[I_WGU] + (size_t)e * DM * 4096 + (size_t)(kb * 128) * 4096 + col0; j.ld = 4096; j.dst = (bf16*)(a.ws + WS_WGU) + ((size_t)e * 4096 + nb * 128) * DM + kb * 128; }
    else if (job < CV_GU + CV_DN) { const int q = job - CV_GU, e = q >> 8, r = q & 255, kb = r >> 4, nb = r & 15;
        j.src = a.in[I_WDN] + (size_t)e * DM * DM + (size_t)(kb * 128) * DM + nb * 128; j.ld = DM; j.dst = (bf16*)(a.ws + WS_WDN) + ((size_t)e * DM + nb * 128) * DM + kb * 128; }
    else if (job < CV_GU + CV_DN + CV_IN) { const int q = job - CV_GU - CV_DN, kb = q / 40, nb = q - kb * 40;
        const int col0 = nb < 24 ? 128 * nb : ((((nb - 24) & 1) ? 4104 : 3080) + 128 * ((nb - 24) >> 1));
        j.src = a.in[I_WIN] + (size_t)(kb * 128) * INCOLS + col0; j.ld = INCOLS; j.dst = (bf16*)(a.ws + WS_WIN) + (size_t)(nb * 128) * DM + kb * 128; }
    else { const int q = job - CV_GU - CV_DN - CV_IN, kb = q >> 4, nb = q & 15;
        j.src = a.in[I_WOUT] + (size_t)(kb * 128) * DM + nb * 128; j.ld = DM; j.dst = (bf16*)(a.ws + WS_WOUT) + (size_t)(nb * 128) * DM + kb * 128; }
    return j;
}
__device__ __forceinline__ void cv_load(const CvJob& j, f32x4 (&v)[8], int tid) {
    const int c4 = tid & 31, kr = tid >> 5;
#pragma unroll
    for (int p = 0; p < 2; ++p)
#pragma unroll
        for (int r = 0; r < 4; ++r) v[p * 4 + r] = *(const f32x4*)(j.src + (size_t)(64 * p + 4 * kr + r) * j.ld + 4 * c4);
}
__device__ __forceinline__ void p0_prologue(const Args& a, unsigned char* lds, int tid, int lane, int wave, int bid, int G) {
    {
        float* wfT = (float*)(lds + 65536);
        for (int idx = tid; idx < 8 * DM; idx += NTHREADS) { const int k = idx >> 3, hh = idx & 7; wfT[hh * DM + k] = a.in[I_WIN][(size_t)k * INCOLS + 3072 + hh]; }
        __syncthreads();
        bf16* HN = (bf16*)(a.ws + WS_HN); float* LOGF = (float*)(a.ws + WS_LOGF);
        for (int row = bid * NWAVES + wave; row < MIN_ROWS; row += G * NWAVES) {
            bf16* orow = HN + (size_t)row * DM;
            if (row >= LTOT) {
#pragma unroll
                for (int j = 0; j < 4; ++j) ((v4u*)orow)[lane + 64 * j] = (v4u){0u, 0u, 0u, 0u};
                continue; }
            const float* xr = row < SEQ ? a.in[I_X] + (size_t)row * DM : a.in[I_META] + (size_t)(row - SEQ) * DM;
            f32x4 v[8]; float ss = 0.f;
#pragma unroll
            for (int j = 0; j < 8; ++j) { v[j] = ((const f32x4*)xr)[lane + 64 * j]; ss += (v[j][0] * v[j][0] + v[j][1] * v[j][1]) + (v[j][2] * v[j][2] + v[j][3] * v[j][3]); }
            ss = wave_sum(ss);
            const float rstd = 1.0f / sqrtf(ss * (1.0f / DM) + NORM_EPS);
            float fa[8];
#pragma unroll
            for (int hh = 0; hh < 8; ++hh) fa[hh] = 0.f;
#pragma unroll
            for (int j = 0; j < 8; ++j) { const f32x4 gv = ((const f32x4*)a.in[I_G1])[lane + 64 * j]; const f32x4 y = v[j] * rstd * gv;
                ((v2u*)orow)[lane + 64 * j] = (v2u){pk2(y[0], y[1]), pk2(y[2], y[3])};
#pragma unroll
                for (int hh = 0; hh < 8; ++hh) { const f32x4 wv = *(const f32x4*)(wfT + hh * DM + 256 * j + 4 * lane); fa[hh] += (y[0] * wv[0] + y[1] * wv[1]) + (y[2] * wv[2] + y[3] * wv[3]); } }
#pragma unroll
            for (int hh = 0; hh < 8; ++hh) fa[hh] = wave_sum(fa[hh]);
            if (lane < 8) {
                float z = fa[0];
#pragma unroll
                for (int hh = 1; hh < 8; ++hh) z = lane == hh ? fa[hh] : z;
                z += a.in[I_BF][lane];
                const float lf = fminf(z, 0.f) - log1pf(expf(-fabsf(z)));
                const int pos = row < SEQ ? NMETA + row : row - SEQ;
                LOGF[pos * 8 + lane] = lf; }
        }
        if (bid == 0) {
            bf16* Kb = (bf16*)(a.ws + WS_K); bf16* Vb = (bf16*)(a.ws + WS_V);
            for (int idx = tid; idx < NHEAD * 768; idx += NTHREADS) { const int head = idx / 768, o = idx - head * 768;
                ((v4u*)(Kb + (size_t)head * SKV * HDIM))[o] = (v4u){0u, 0u, 0u, 0u}; ((v4u*)(Vb + (size_t)head * SKV * HDIM))[o] = (v4u){0u, 0u, 0u, 0u}; } }
        __syncthreads();
    }
    {
        const int c4 = tid & 31, kr = tid >> 5;
        int job = bid, buf = 0; CvJob jc = cv_decode(job < CV_JOBS ? job : 0, a); f32x4 cur[8], nxt[8];
        if (job < CV_JOBS) cv_load(jc, cur, tid);
        while (job < CV_JOBS) {
            const int jn_i = job + G; const bool hn = jn_i < CV_JOBS; CvJob jn = cv_decode(hn ? jn_i : job, a);
            if (hn) cv_load(jn, nxt, tid);
            unsigned char* Lb = lds + buf * 32768;
#pragma unroll
            for (int p = 0; p < 2; ++p)
#pragma unroll
                for (int j = 0; j < 4; ++j) { const unsigned lo = pk2(cur[4 * p + 0][j], cur[4 * p + 1][j]), hi = pk2(cur[4 * p + 2][j], cur[4 * p + 3][j]);
                    const int n = 4 * c4 + j, unit = 16 * p + kr, f = (c4 & 15) << 1;
                    *(v2u*)(Lb + n * 256 + ((unit ^ f) << 3)) = (v2u){lo, hi}; }
            __syncthreads();
#pragma unroll
            for (int i = 0; i < 4; ++i) { const int n = 32 * i + (tid >> 4), chunk = tid & 15, f = ((n >> 2) & 15) << 1;
                const v4u w = *(const v4u*)(Lb + n * 256 + (((2 * chunk) ^ f) << 3));
                *(v4u*)(jc.dst + (size_t)n * DM + chunk * 8) = w; }
            buf ^= 1; job = jn_i; jc = jn;
#pragma unroll
            for (int i = 0; i < 8; ++i) cur[i] = nxt[i];
        }
        __syncthreads();
    }
}

__device__ __forceinline__ void p1_cumsum(const Args& a, unsigned char* lds, int tid, int lane, int wave, int head) {
    const float* LOGF = (const float*)(a.ws + WS_LOGF); float* CS = (float*)(a.ws + WS_CS) + (size_t)head * SKV;
    float* wsum = (float*)lds;
    float loc[17]; float s = 0.f;
#pragma unroll
    for (int i = 0; i < 17; ++i) { const int p = 17 * tid + i; const float v = p < LTOT ? LOGF[p * 8 + head] : 0.f; s += v; loc[i] = s; }
    float incl = s;
#pragma unroll
    for (int o = 1; o < 64; o <<= 1) { const float n = __shfl_up(incl, o); if (lane >= o) incl += n; }
    if (lane == 63) wsum[wave] = incl;
    __syncthreads();
    float woff = 0.f;
    for (int w = 0; w < wave; ++w) woff += wsum[w];
    const float excl = woff + incl - s;
#pragma unroll
    for (int i = 0; i < 17; ++i) { const int p = 17 * tid + i; if (p < LTOT) CS[48 + p] = (excl + loc[i]) * INV_SCALE; }
    if (tid < 48) CS[tid] = __builtin_inff();
    __syncthreads();
}

constexpr int N_ATT_ENT = 80, N_ATT_ITEMS = N_ATT_ENT * NHEAD, CONV_TOK = 32, N_CONV_ITEMS = SEQ / CONV_TOK, N_P2_ITEMS = N_ATT_ITEMS + N_CONV_ITEMS;
__device__ const unsigned short ATT_TAB[N_ATT_ENT] = {
    1151, 855, 559, 263, 1055, 1087, 1119, 1150, 791, 823, 527, 1054, 1086, 1118, 1149, 790, 822, 854, 558, 1053, 1085, 1117, 1148, 821, 853, 526, 1052, 1084, 1116, 1147, 789, 852, 557, 262, 1051, 1083,
    1115, 1146, 788, 820, 525, 1050, 1082, 1114, 1145, 787, 819, 851, 556, 1049, 1081, 1113, 1144, 818, 850, 524, 1048, 1080, 1112, 786, 849, 555, 261, 785, 817, 523, 784, 816, 848, 554, 522, 553, 260, 521,
    552, 520, 259, 258, 257, 256};
__device__ __forceinline__ fox::FoxRef att_decode(int L, const Args& a) {
    const int ent = L >> 3, head = L & 7; const unsigned t = ATT_TAB[ent]; const int qb = t & 31, part = (t >> 5) & 7, np = t >> 8, NT = 4 * qb + 5;
    fox::FoxRef r;
    r.Q = (const fox::bf16*)(a.ws + WS_Q) + ((size_t)head * SEQ + (size_t)qb * 256) * HDIM;
    r.K = (const fox::bf16*)(a.ws + WS_K) + (size_t)head * SKV * HDIM; r.V = (const fox::bf16*)(a.ws + WS_V) + (size_t)head * SKV * HDIM;
    r.C = (const float*)(a.ws + WS_CS) + (size_t)head * SKV;
    r.P0 = 64 + 256 * qb; r.j_lo = part * NT / np; r.j_hi = (part + 1) * NT / np;
    const int slot = (head * 32 + qb) * 4 + part; r.O = (fox::bf16*)(a.ws + WS_OPART) + (size_t)slot * 256 * HDIM; r.ML = (float*)(a.ws + WS_ML) + (size_t)slot * 512;
    return r;
}
__device__ __forceinline__ void conv_item(const Args& a, unsigned char* lds, int tid, int it) {
    const int i0 = it * CONV_TOK, pos0 = NMETA + i0;
    const bf16* U = (const bf16*)(a.ws + WS_U); bf16* MIX = (bf16*)(a.ws + WS_MIXED);
    for (int idx = tid; idx < 62 * 128; idx += NTHREADS) { const int row = idx >> 7, ch = idx & 127, p = pos0 - 30 + row;
        v4u v = (v4u){0u, 0u, 0u, 0u}; if (p >= 0) v = *(const v4u*)(U + (size_t)p * 1024 + ch * 8);
        *(v4u*)(lds + row * 2048 + ch * 16) = v; }
    const int c = 2 * tid;
    float cw0[CKW], cw1[CKW];
#pragma unroll
    for (int w = 0; w < CKW; ++w) { const float2 t = *(const float2*)(a.in[I_CW] + w * 1024 + c); cw0[w] = t.x; cw1[w] = t.y; }
    const float2 cb = *(const float2*)(a.in[I_CB] + c), gg = *(const float2*)(a.in[I_GNG] + c), gb = *(const float2*)(a.in[I_GNB] + c);
    __syncthreads();
    for (int tk = 0; tk < CONV_TOK; ++tk) {
        float a0 = cb.x, a1 = cb.y;
#pragma unroll
        for (int w = 0; w < CKW; ++w) { const unsigned pk = *(const unsigned*)(lds + (tk + w) * 2048 + c * 2); a0 += bf_lo(pk) * cw0[w]; a1 += bf_hi(pk) * cw1[w]; }
        const float mu = wave_sum(a0 + a1) * (1.0f / 128.0f), d0 = a0 - mu, d1 = a1 - mu;
        const float var = wave_sum(d0 * d0 + d1 * d1) * (1.0f / 128.0f), rs = 1.0f / sqrtf(var + NORM_EPS);
        const float y0 = d0 * rs * gg.x + gb.x, y1 = d1 * rs * gg.y + gb.y;
        const float s0 = y0 / (1.0f + expf(-y0)), s1 = y1 / (1.0f + expf(-y1));
        *(unsigned*)(MIX + (size_t)(i0 + tk) * DM + 1024 + c) = pk2(s0, s1);
    }
    __syncthreads();
}
__device__ __forceinline__ void p2_attn_conv(const Args& a, unsigned char* lds, volatile LAS unsigned* MISC, unsigned* ctl, int tid) {
    unsigned* qctr = ctl + CW_QUEUE;
    if (tid == 0) { MISC[0] = __hip_atomic_fetch_add(qctr, 1u, RLX_AGENT); MISC[1] = __hip_atomic_fetch_add(qctr, 1u, RLX_AGENT); }
    __syncthreads();
    int ia = __builtin_amdgcn_readfirstlane((int)MISC[0]), ib = __builtin_amdgcn_readfirstlane((int)MISC[1]);
    __syncthreads();
    if (ia < N_ATT_ITEMS) {
        fox::FoxRef cur = att_decode(ia, a); fox::FoxSeam S;
        fox::fox_prime(cur, (char*)lds, S);
        for (int k = 0;; ++k) {
            if (tid == 0) MISC[2 + (k & 1)] = __hip_atomic_fetch_add(qctr, 1u, RLX_AGENT);
            const bool last = ib >= N_ATT_ITEMS;
            const fox::FoxRef nxt = last ? cur : att_decode(ib, a);
            fox::fox_block(cur, nxt, (char*)lds, S);
            ia = ib; ib = __builtin_amdgcn_readfirstlane((int)MISC[2 + (k & 1)]);
            if (last) break;
            cur = nxt;
        }
    }
    __syncthreads();
    while (ia < N_P2_ITEMS) {
        if (tid == 0) MISC[4] = __hip_atomic_fetch_add(qctr, 1u, RLX_AGENT);
        conv_item(a, lds, tid, ia - N_ATT_ITEMS);
        ia = ib; ib = __builtin_amdgcn_readfirstlane((int)MISC[4]);
        __syncthreads();
    }
}

__device__ __forceinline__ void p3_combine(const Args& a, int lane, int gw, int NGW) {
    const float C2 = 1.4426950408889634f * fox::SCALE;
    const bf16* OP = (const bf16*)(a.ws + WS_OPART); const float* ML = (const float*)(a.ws + WS_ML); bf16* MIX = (bf16*)(a.ws + WS_MIXED);
    for (int r = gw; r < 256 * 256; r += NGW) {
        const int blk = r >> 8, row = r & 255, head = blk >> 5, qb = blk & 31, np = (qb >> 3) + 1, slot = blk * 4;
        float mp[4], lp[4]; float M = -3.0e38f;
#pragma unroll
        for (int p = 0; p < 4; ++p) { mp[p] = 0.f; lp[p] = 0.f; if (p < np) { const float2 t = *(const float2*)(ML + (size_t)(slot + p) * 512 + row * 2); mp[p] = t.x; lp[p] = t.y; if (t.y > 0.f) M = fmaxf(M, t.x); } }
        float a0 = 0.f, a1 = 0.f, den = 0.f;
#pragma unroll
        for (int p = 0; p < 4; ++p) if (p < np && lp[p] > 0.f) { const float w = __builtin_amdgcn_exp2f((mp[p] - M) * C2) * lp[p];
            const unsigned pk = *(const unsigned*)(OP + ((size_t)(slot + p) * 256 + row) * HDIM + 2 * lane); a0 += w * bf_lo(pk); a1 += w * bf_hi(pk); den += w; }
        const float inv = den > 0.f ? 1.0f / den : 0.f;
        *(unsigned*)(MIX + (size_t)(qb * 256 + row) * DM + head * HDIM + 2 * lane) = pk2(a0 * inv, a1 * inv);
    }
}

__device__ __forceinline__ void p5_router(const Args& a, unsigned char* lds, unsigned* ctl, int tid, int lane, int wave, int bid, int G) {
    const float* Hh = (const float*)(a.ws + WS_H); bf16* HN2 = (bf16*)(a.ws + WS_HN2);
    int* TE = (int*)(a.ws + WS_ROUTE); int* TS = TE + SEQ * 4; float* TG = (float*)(TS + SEQ * 4);
    float* part = (float*)lds; float* ssq = part + 8 * 32 * 33; float* logit = ssq + 8 * 32; float* rstd_l = logit + 32 * 33;
    const float* g2 = a.in[I_G2]; const float* rw = a.in[I_RW];
    for (int grp = bid; grp < SEQ / 32; grp += G) {
        const int t0 = grp * 32, i = lane & 31, kk = lane >> 5, kb = wave * 256;
        f32x16 acc = {}; float ss = 0.f;
        const float* hrow = Hh + (size_t)(t0 + i) * DM + kb + 4 * kk;
#pragma unroll 4
        for (int c = 0; c < 32; ++c) {
            const f32x4 hv = *(const f32x4*)(hrow + 8 * c);
            const int k0 = kb + 8 * c + 4 * kk;
            const f32x4 gv = *(const f32x4*)(g2 + k0);
            float b[4];
#pragma unroll
            for (int q = 0; q < 4; ++q) b[q] = rw[(size_t)(k0 + q) * NEXP + i] * gv[q];
#pragma unroll
            for (int q = 0; q < 4; ++q) { acc = __builtin_amdgcn_mfma_f32_32x32x2f32(hv[q], b[q], acc, 0, 0, 0); ss += hv[q] * hv[q]; }
        }
        ss += __shfl_xor(ss, 32);
        if (kk == 0) ssq[wave * 32 + i] = ss;
#pragma unroll
        for (int r = 0; r < 16; ++r) { const int row = (r & 3) + 8 * (r >> 2) + 4 * kk; part[(wave * 32 + row) * 33 + i] = acc[r]; }
        __syncthreads();
        if (tid < 32) { float s = 0.f;
#pragma unroll
            for (int w = 0; w < 8; ++w) s += ssq[w * 32 + tid];
            rstd_l[tid] = 1.0f / sqrtf(s * (1.0f / DM) + NORM_EPS); }
        __syncthreads();
        { const int tk = tid >> 4, e0 = 2 * (tid & 15); const float rs = rstd_l[tk];
#pragma unroll
          for (int d = 0; d < 2; ++d) { float s = 0.f;
#pragma unroll
              for (int w = 0; w < 8; ++w) s += part[(w * 32 + tk) * 33 + e0 + d];
              logit[tk * 33 + e0 + d] = s * rs + a.in[I_RB][e0 + d]; } }
        __syncthreads();
        if (tid < 32) {
            unsigned taken = 0u; float tv[4]; int ti[4];
#pragma unroll
            for (int k = 0; k < 4; ++k) { float best = -3.0e38f; int bi = 0;
                for (int e = 0; e < NEXP; ++e) { const float v = logit[tid * 33 + e]; if (!((taken >> e) & 1u) && v > best) { best = v; bi = e; } }
                taken |= 1u << bi; tv[k] = best; ti[k] = bi; }
            float w[4], sum = 0.f;
#pragma unroll
            for (int k = 0; k < 4; ++k) { w[k] = expf(tv[k] - tv[0]); sum += w[k]; }
            const float inv = 1.0f / sum;
#pragma unroll
            for (int k = 0; k < 4; ++k) { const unsigned slot = __hip_atomic_fetch_add(ctl + CW_CNT + ti[k], 1u, RLX_AGENT);
                TE[(t0 + tid) * 4 + k] = ti[k]; TS[(t0 + tid) * 4 + k] = (int)slot; TG[(t0 + tid) * 4 + k] = w[k] * inv; }
        }
#pragma unroll 1
        for (int r = 0; r < 4; ++r) { const int tk = wave * 4 + r; const float rs = rstd_l[tk]; const float* hr = Hh + (size_t)(t0 + tk) * DM; bf16* orow = HN2 + (size_t)(t0 + tk) * DM;
#pragma unroll
            for (int j = 0; j < 8; ++j) { const f32x4 v = ((const f32x4*)hr)[lane + 64 * j], gv = ((const f32x4*)g2)[lane + 64 * j]; const f32x4 y = v * rs * gv;
                ((v2u*)orow)[lane + 64 * j] = (v2u){pk2(y[0], y[1]), pk2(y[2], y[3])}; } }
        __syncthreads();
    }
}

__device__ __forceinline__ void p6_gather(const Args& a, unsigned char* lds, unsigned* ctl, int tid, int lane, int wave, int bid, int G) {
    int* tst = (int*)lds;
    if (tid < NEXP) { int s = 0; for (int e = 0; e < tid; ++e) s += ((int)ctl[CW_CNT + e] + 255) >> 8; tst[tid] = s;
        if (bid == 0) { const int nt = ((int)ctl[CW_CNT + tid] + 255) >> 8; for (int i = 0; i < nt; ++i) ctl[CW_TEXP + s + i] = (unsigned)tid; if (tid == NEXP - 1) ctl[CW_NT] = (unsigned)(s + nt); } }
    __syncthreads();
    const int* TE = (const int*)(a.ws + WS_ROUTE); const int* TS = TE + SEQ * 4; int* TR = (int*)(a.ws + WS_ROUTE) + 3 * SEQ * 4;
    const bf16* HN2 = (const bf16*)(a.ws + WS_HN2); bf16* XG = (bf16*)(a.ws + WS_XG);
    for (int t = bid * NWAVES + wave; t < SEQ; t += G * NWAVES) {
        v4u v[4];
#pragma unroll
        for (int j = 0; j < 4; ++j) v[j] = ((const v4u*)(HN2 + (size_t)t * DM))[lane + 64 * j];
#pragma unroll
        for (int k = 0; k < 4; ++k) { const int e = TE[t * 4 + k], row = tst[e] * 256 + TS[t * 4 + k];
            if (lane == 0) TR[t * 4 + k] = row;
#pragma unroll
            for (int j = 0; j < 4; ++j) ((v4u*)(XG + (size_t)row * DM))[lane + 64 * j] = v[j]; }
    }
    __syncthreads();
}

__device__ __forceinline__ void p9_final(const Args& a, int lane, int gw, int NGW) {
    const float* Hh = (const float*)(a.ws + WS_H); const bf16* Y = (const bf16*)(a.ws + WS_Y);
    const float* TG = (const float*)(a.ws + WS_ROUTE) + 2 * SEQ * 4; const int* TR = (const int*)(a.ws + WS_ROUTE) + 3 * SEQ * 4;
    for (int t = gw; t < SEQ; t += NGW) {
        f32x4 v[8];
#pragma unroll
        for (int j = 0; j < 8; ++j) v[j] = ((const f32x4*)(Hh + (size_t)t * DM))[lane + 64 * j];
#pragma unroll
        for (int k = 0; k < 4; ++k) { const float g = TG[t * 4 + k]; const bf16* yr = Y + (size_t)TR[t * 4 + k] * DM;
#pragma unroll
            for (int j = 0; j < 8; ++j) { const v2u pk = ((const v2u*)yr)[lane + 64 * j]; v[j][0] += g * bf_lo(pk.x); v[j][1] += g * bf_hi(pk.x); v[j][2] += g * bf_lo(pk.y); v[j][3] += g * bf_hi(pk.y); } }
        float ss = 0.f;
#pragma unroll
        for (int j = 0; j < 8; ++j) ss += (v[j][0] * v[j][0] + v[j][1] * v[j][1]) + (v[j][2] * v[j][2] + v[j][3] * v[j][3]);
        ss = wave_sum(ss);
        const float rstd = 1.0f / sqrtf(ss * (1.0f / DM) + NORM_EPS);
#pragma unroll
        for (int j = 0; j < 8; ++j) { const f32x4 gv = ((const f32x4*)a.in[I_GF])[lane + 64 * j]; ((f32x4*)(a.out + (size_t)t * DM))[lane + 64 * j] = v[j] * rstd * gv; }
    }
}

#ifndef MK_PER_PHASE
#define MK_PER_PHASE 0
#endif
constexpr int N_PHASES = 10;
template <int LO, int HI> __global__ void __launch_bounds__(NTHREADS, 2) hymba_fwd(Args a_in) {
    extern __shared__ __attribute__((aligned(16))) unsigned char lds[];
    const int tid0 = threadIdx.x, bid = blockIdx.x, G = gridDim.x;
    volatile LAS unsigned* MISC = (volatile LAS unsigned*)((LAS unsigned char*)lds + MISC_OFF);
    unsigned* ctl = (unsigned*)(a_in.ws + WS_CTL);
#if defined(__HIP_DEVICE_COMPILE__)
#define PHASE_ARGS() const __attribute__((address_space(4))) Args* ap_ = (const __attribute__((address_space(4))) Args*)__builtin_amdgcn_kernarg_segment_ptr(); asm volatile("" : "+s"(ap_)); const Args a = *ap_; int tid = threadIdx.x; asm volatile("" : "+v"(tid)); const int lane = tid & 63, wave = __builtin_amdgcn_readfirstlane(tid >> 6), gw = bid * NWAVES + wave, NGW = G * NWAVES; (void)lane; (void)gw; (void)NGW
#else
#define PHASE_ARGS() const Args& a = a_in; const int tid = threadIdx.x, lane = tid & 63, wave = tid >> 6, gw = bid * NWAVES + wave, NGW = G * NWAVES; (void)lane; (void)gw; (void)NGW
#endif
    for (int u = tid0; u < (LDS_BYTES - MISC_OFF) / 4; u += NTHREADS) MISC[u] = 0u;
    __syncthreads();
    XcdBarrier bar; bar.bar = ctl + CW_BAR; bar.x = 0; bar.st = nullptr;
    if (HI - LO > 1) bar = xcd_barrier_post(ctl + CW_BAR, MISC + 8);
#ifndef PH_MASK
#define PH_MASK 0x3ff
#endif
#define IN(k) ((((PH_MASK) >> (k)) & 1) && LO <= (k) && (k) < HI)
#define SEAM(k) do { if (IN(k) && IN((k) + 1)) xcd_barrier(bar); } while (0)

    if (IN(0)) { PHASE_ARGS(); p0_prologue(a, lds, tid, lane, wave, bid, G); } SEAM(0);
    if (IN(1)) { PHASE_ARGS();
        if (bid < NHEAD) p1_cumsum(a, lds, tid, lane, wave, bid);
        pg8::Gemm g{(const pg8::bf16_t*)(a.ws + WS_HN), (const pg8::bf16_t*)(a.ws + WS_WIN), MIN_ROWS, NIN, DM}; pg8::StaticOrder S; S.init(MIN_ROWS, NIN, G, bid);
        pg8::EpiIn E{(pg8::bf16_t*)(a.ws + WS_Q), WS_K - WS_Q, WS_V - WS_Q, (pg8::bf16_t*)(a.ws + WS_U), a.in[I_BGLU]};
        pg8::gemm_phase<pg8::EpiIn, pg8::StaticOrder, true, true>((PG8_LAS unsigned char*)lds, g, S, E);
    } SEAM(1);
    if (IN(2)) { PHASE_ARGS(); p2_attn_conv(a, lds, MISC, ctl, tid); } SEAM(2);
    if (IN(3)) { PHASE_ARGS(); p3_combine(a, lane, gw, NGW); } SEAM(3);
    if (IN(4)) { PHASE_ARGS();
        pg8::Gemm g{(const pg8::bf16_t*)(a.ws + WS_MIXED), (const pg8::bf16_t*)(a.ws + WS_WOUT), SEQ, DM, DM}; pg8::StaticOrder S; S.init(SEQ, DM, G, bid);
        pg8::EpiOut E{a.in[I_X], (float*)(a.ws + WS_H)};
        pg8::gemm_phase<pg8::EpiOut, pg8::StaticOrder, true, true>((PG8_LAS unsigned char*)lds, g, S, E);
    } SEAM(4);
    if (IN(5)) { PHASE_ARGS(); p5_router(a, lds, ctl, tid, lane, wave, bid, G); } SEAM(5);
    if (IN(6)) { PHASE_ARGS(); p6_gather(a, lds, ctl, tid, lane, wave, bid, G); } SEAM(6);
    if (IN(7)) { PHASE_ARGS();
        const int T = (int)__hip_atomic_load(ctl + CW_NT, RLX_AGENT);
        pg8::Gemm g{(const pg8::bf16_t*)(a.ws + WS_XG), (const pg8::bf16_t*)(a.ws + WS_WGU), PROWS, NEXP * 4096, DM}; pg8::GroupedOrder S; S.init((const int*)(ctl + CW_TEXP), T, 16, G, bid);
        pg8::EpiGU E{(pg8::bf16_t*)(a.ws + WS_ACT), a.in[I_BGU]};
        pg8::gemm_phase<pg8::EpiGU, pg8::GroupedOrder, true, true>((PG8_LAS unsigned char*)lds, g, S, E);
    } SEAM(7);
    if (IN(8)) { PHASE_ARGS();
        const int T = (int)__hip_atomic_load(ctl + CW_NT, RLX_AGENT);
        pg8::Gemm g{(const pg8::bf16_t*)(a.ws + WS_ACT), (const pg8::bf16_t*)(a.ws + WS_WDN), PROWS, NEXP * DM, DM}; pg8::GroupedOrder S; S.init((const int*)(ctl + CW_TEXP), T, 8, G, bid);
        pg8::EpiDN E{(pg8::bf16_t*)(a.ws + WS_Y), a.in[I_BDN]};
        pg8::gemm_phase<pg8::EpiDN, pg8::GroupedOrder, true, true>((PG8_LAS unsigned char*)lds, g, S, E);
    } SEAM(8);
    if (IN(9)) { PHASE_ARGS(); p9_final(a, lane, gw, NGW); }
#undef IN
#undef SEAM
}

template <int LO, int HI> static bool launch_range(const Args& a, int grid, hipStream_t stream) {
    static bool attr = false;
    if (!attr) { attr = true; if (hipFuncSetAttribute((const void*)hymba_fwd<LO, HI>, hipFuncAttributeMaxDynamicSharedMemorySize, LDS_BYTES) != hipSuccess) { fprintf(stderr, "kernel_launch: hipFuncSetAttribute failed\n"); return false; } }
    hipLaunchKernelGGL((hymba_fwd<LO, HI>), dim3(grid), dim3(NTHREADS), LDS_BYTES, stream, a);
    return hipPeekAtLastError() == hipSuccess;
}
extern "C" void kernel_launch(void* const* d_in, const int* in_sizes, int n_in, void* d_out, int out_size, void* d_ws, size_t ws_size, hipStream_t stream) {
    static int grid = 0;
    if (grid == 0) {
        if (n_in != 19 || out_size != SEQ * DM || ws_size < WS_END) { fprintf(stderr, "kernel_launch: unexpected shapes (n_in %d out %d ws %zu)\n", n_in, out_size, ws_size); grid = -1; return; }
        int dev = 0, cus = 0;
        if (hipGetDevice(&dev) != hipSuccess || hipDeviceGetAttribute(&cus, hipDeviceAttributeMultiprocessorCount, dev) != hipSuccess) { grid = -1; return; }
        grid = cus;
    }
    if (grid < 0) return;
    (void)in_sizes;
    if (hipMemsetAsync((char*)d_ws + WS_CTL, 0, CTL_ZERO_BYTES, stream) != hipSuccess) return;
    Args a{};
    for (int i = 0; i < 19; ++i) a.in[i] = (const float*)d_in[i];
    a.out = (float*)d_out; a.ws = (unsigned char*)d_ws;
#if MK_PER_PHASE
    launch_range<0, 1>(a, grid, stream); launch_range<1, 2>(a, grid, stream); launch_range<2, 3>(a, grid, stream); launch_range<3, 4>(a, grid, stream); launch_range<4, 5>(a, grid, stream);
    launch_range<5, 6>(a, grid, stream); launch_range<6, 7>(a, grid, stream); launch_range<7, 8>(a, grid, stream); launch_range<8, 9>(a, grid, stream); launch_range<9, 10>(a, grid, stream);
#else
    launch_range<0, N_PHASES>(a, grid, stream);
#endif
}
```

```cpp
#include <hip/hip_runtime.h>
#include <hip/hip_bf16.h>
#include <cstdio>
#include <cstdint>
namespace pg8 {
#define PG8_LAS __attribute__((address_space(3)))
typedef unsigned short bf16_t;
typedef short bf16x8 __attribute__((ext_vector_type(8)));
typedef float f32x4 __attribute__((ext_vector_type(4)));
typedef unsigned u32x4 __attribute__((ext_vector_type(4)));
constexpr int BM = 256, BK = 64, HALF = 128, HTB = HALF * BK * 2  , STAGE_BYTES = 8 * HTB, NXCD = 8, WGM = 8;

__host__ __device__ __forceinline__ int lds_byte(int r, int c) { const int st = (r >> 4) * 2 + (c >> 5), rr = r & 15, cc = c & 31, ob = rr * 64 + cc * 2; return st * 1024 + (ob ^ (((ob >> 9) & 1) << 5)); }
__host__ __device__ __forceinline__ void stage_rc(int b, int& R, int& C) { const int st = b / 1024, sb = b % 1024, swz = sb ^ (((sb >> 9) & 1) << 5); R = (st >> 1) * 16 + swz / 64; C = (st & 1) * 32 + (swz % 64) / 2; }
__host__ __device__ __forceinline__ int perm32(int rho) { const int n = rho >> 4, i = rho & 15; return 8 * (i >> 2) + 4 * n + (i & 3); }

struct Unit { int pm, pn; };
struct Gemm { const bf16_t* A; const bf16_t* Bt; int M, N, K; };

struct StaticOrder {
    int nM, nN, nwg, G, c;
    __host__ __device__ void init(int M, int N, int G_, int c_) { nM = M / BM; nN = N / BM; nwg = nM * nN; G = G_; c = c_; }
    __host__ __device__ bool next(int i, Unit& u) const {
        const long L = (long)i * G + c; if (L >= nwg) return false;
        int wgid = (int)L; { const int q = nwg / NXCD, r = nwg % NXCD, xcd = wgid % NXCD, off = wgid / NXCD; wgid = (xcd < r ? xcd * (q + 1) : r * (q + 1) + (xcd - r) * q) + off; }
        const int nig = WGM * nN, gid = wgid / nig, fm = gid * WGM, gsz = (nM - fm) < WGM ? (nM - fm) : WGM;
        u.pm = fm + ((wgid % nig) % gsz); u.pn = (wgid % nig) / gsz; return true;
    }
    __device__ __forceinline__ void a_ready(const Unit&) const {}
    __device__ __forceinline__ void done(const Unit&) const {}
};

__device__ __forceinline__ unsigned cvt_pk_bf16(float lo, float hi) { unsigned r; asm volatile("v_cvt_pk_bf16_f32 %0, %1, %2" : "=v"(r) : "v"(lo), "v"(hi)); return r; }
typedef float f32x2 __attribute__((ext_vector_type(2)));
__device__ __forceinline__ f32x2 gelu_pk(f32x2 v) {
    const f32x2 av = __builtin_elementwise_abs(v), d = av * 0.2316418882f + 1.0f;
    f32x2 t; t.x = __builtin_amdgcn_rcpf(d.x); t.y = __builtin_amdgcn_rcpf(d.y);
    f32x2 q = t * 0.5307027145f + (-0.7265760135f); q = q * t + 0.7107068705f; q = q * t + (-0.142248368f); q = q * t + 0.127414796f; q = q * t;
    const f32x2 s = (v * v) * (-0.72134752044f);
    f32x2 e; e.x = __builtin_amdgcn_exp2f(s.x); e.y = __builtin_amdgcn_exp2f(s.y);
    const f32x2 m = v * (q * e), r = v - m;
    f32x2 o; o.x = v.x < 0.f ? m.x : r.x; o.y = v.y < 0.f ? m.y : r.y; return o;
}


__device__ __forceinline__ float sigmoidf_fast(float x) { return __builtin_amdgcn_rcpf(1.0f + __builtin_amdgcn_exp2f(-1.4426950408889634f * x)); }
__device__ __forceinline__ u32x4 pack8_bf16(const f32x4 v0, const f32x4 v1) { u32x4 w; w.x = cvt_pk_bf16(v0[0], v0[1]); w.y = cvt_pk_bf16(v0[2], v0[3]); w.z = cvt_pk_bf16(v1[0], v1[1]); w.w = cvt_pk_bf16(v1[2], v1[3]); return w; }

struct EpiIn {
    static constexpr bool PERM = true, AFTER_DRAIN = false;
    bf16_t* Q; size_t koff, voff; bf16_t* U; const float* bglu; unsigned* nrm;
    __device__ __forceinline__ void operator()(const f32x4 (&acc)[2][2][4][2], const Unit& u, int wr, int wc, int fr, int fq) const {
        const int pn = u.pn, pm = u.pm, dcol = wc * 32 + 8 * fq;
        const int c0 = 128 * ((pn < 12 ? 12 : pn) - 12) + dcol;
        f32x4 ba[2], bg[2];
#pragma unroll
        for (int n = 0; n < 2; ++n) { ba[n] = *(const f32x4*)(bglu + c0 + 4 * n); bg[n] = *(const f32x4*)(bglu + 1024 + c0 + 4 * n); }
        asm volatile("" : "+v"(ba[0]), "+v"(ba[1]), "+v"(bg[0]), "+v"(bg[1]));
        if (pn < 12) {
            const int which = pn >> 2;
            if (which == 0 && pm >= 32) return;
            const size_t boff = which == 0 ? 0 : (which == 1 ? koff : voff);
            bf16_t* base = (bf16_t*)((unsigned char*)Q + boff);
            const int rph = which == 0 ? 8192 : 8256;
            float nmax[2] = {0.f, 0.f};
#pragma unroll
            for (int ai = 0; ai < 2; ++ai)
#pragma unroll
                for (int m = 0; m < 4; ++m) {
                    const int rl = ai * HALF + wr * 64 + m * 16 + fr;
                    const bool ok = pm < 32 || rl < 16;
                    const int idx = pm < 32 ? pm * BM + rl + (which ? 64 : 0) : 48 + rl;
#pragma unroll
                    for (int bj = 0; bj < 2; ++bj) { const int head = 2 * (pn & 3) + bj;
                        if (ok) *(u32x4*)(base + ((size_t)head * rph + idx) * 128 + dcol) = pack8_bf16(acc[ai][bj][m][0], acc[ai][bj][m][1]);
                        if (which < 2) { const f32x4 x0 = acc[ai][bj][m][0], x1 = acc[ai][bj][m][1];
                            float ss = (x0[0] * x0[0] + x0[1] * x0[1]) + (x0[2] * x0[2] + x0[3] * x0[3]) + (x1[0] * x1[0] + x1[1] * x1[1]) + (x1[2] * x1[2] + x1[3] * x1[3]);
                            ss += __shfl_xor(ss, 16); ss += __shfl_xor(ss, 32);
                            nmax[bj] = fmaxf(nmax[bj], ok ? ss : 0.f); } }
                }
            if (which < 2) {
#pragma unroll
                for (int bj = 0; bj < 2; ++bj) { float v = nmax[bj];
#pragma unroll
                    for (int o = 1; o < 16; o <<= 1) v = fmaxf(v, __shfl_xor(v, o));
                    if (fr == 0 && fq == 0) __hip_atomic_fetch_max(nrm + (which * 8 + 2 * (pn & 3) + bj) * 4 + wc, __float_as_uint(v), __ATOMIC_RELAXED, __HIP_MEMORY_SCOPE_AGENT); } }
        } else {
#pragma unroll
            for (int ai = 0; ai < 2; ++ai)
#pragma unroll
                for (int m = 0; m < 4; ++m) {
                    const int rl = ai * HALF + wr * 64 + m * 16 + fr;
                    const bool ok = pm < 32 || rl < 16;
                    const int pos = pm < 32 ? 16 + pm * BM + rl : rl;
                    f32x4 o[2];
#pragma unroll
                    for (int n = 0; n < 2; ++n) { const f32x4 a = acc[ai][0][m][n] + ba[n], g = acc[ai][1][m][n] + bg[n];
#pragma unroll
                        for (int j = 0; j < 4; ++j) o[n][j] = a[j] * sigmoidf_fast(g[j]); }
                    if (ok) *(u32x4*)(U + (size_t)pos * 1024 + c0) = pack8_bf16(o[0], o[1]);
                }
        }
    }
};
struct EpiOut {
    static constexpr bool PERM = false, AFTER_DRAIN = false;
    const float* X; float* Hh;
    __device__ __forceinline__ void operator()(const f32x4 (&acc)[2][2][4][2], const Unit& u, int wr, int wc, int fr, int fq) const {
        const int row0 = u.pm * BM + wr * 64 + fr, col0 = u.pn * BM + wc * 32 + 4 * fq;
#pragma unroll
        for (int ai = 0; ai < 2; ++ai)
#pragma unroll
            for (int m = 0; m < 4; ++m) { const size_t off = (size_t)(row0 + ai * HALF + m * 16) * 2048 + col0;
#pragma unroll
                for (int bj = 0; bj < 2; ++bj)
#pragma unroll
                    for (int n = 0; n < 2; ++n) { const f32x4 xv = *(const f32x4*)(X + off + bj * HALF + n * 16); *(f32x4*)(Hh + off + bj * HALF + n * 16) = xv + acc[ai][bj][m][n]; }
                asm volatile("" ::: "memory"); }
    }
};
struct EpiGU {
    static constexpr bool PERM = true, AFTER_DRAIN = false;
    unsigned char* ACT; const float* bgu; float wscale;
    __device__ __forceinline__ void operator()(const f32x4 (&acc)[2][2][4][2], const Unit& u, int wr, int wc, int fr, int fq) const {
        const int e = u.pn >> 4, c0 = 128 * (u.pn & 15) + wc * 32 + 8 * fq;
        f32x4 bg[2], bu[2];
#pragma unroll
        for (int n = 0; n < 2; ++n) { bg[n] = *(const f32x4*)(bgu + (size_t)e * 4096 + c0 + 4 * n); bu[n] = *(const f32x4*)(bgu + (size_t)e * 4096 + 2048 + c0 + 4 * n); }
#pragma unroll
        for (int ai = 0; ai < 2; ++ai)
#pragma unroll
            for (int m = 0; m < 4; ++m) {
                const int row = u.pm * BM + ai * HALF + wr * 64 + m * 16 + fr;
                int o8[2];
#pragma unroll
                for (int n = 0; n < 2; ++n) { const f32x4 g = acc[ai][0][m][n] * wscale + bg[n], up = acc[ai][1][m][n] * wscale + bu[n]; float o[4];
#pragma unroll
                    for (int j = 0; j < 4; ++j) { const float gg = fminf(g[j], 7.0f), uu = fminf(fmaxf(up[j], -7.0f), 7.0f); o[j] = gg * sigmoidf_fast(1.702f * gg) * (uu + 1.0f); }
                    int d = __builtin_amdgcn_cvt_pk_fp8_f32(o[0], o[1], 0, false); o8[n] = __builtin_amdgcn_cvt_pk_fp8_f32(o[2], o[3], d, true); }
                typedef unsigned u32x2_ __attribute__((ext_vector_type(2)));
                *(u32x2_*)(ACT + (size_t)row * 2048 + c0) = (u32x2_){(unsigned)o8[0], (unsigned)o8[1]};
            }
    }
};
struct EpiDN {
    static constexpr bool PERM = true, AFTER_DRAIN = false;
    unsigned char* Y; const float* bdn; float wscale;
    __device__ __forceinline__ void operator()(const f32x4 (&acc)[2][2][4][2], const Unit& u, int wr, int wc, int fr, int fq) const {
        const int e = u.pn >> 3, c0 = 256 * (u.pn & 7) + wc * 32 + 8 * fq;
        f32x4 bv[2][2];
#pragma unroll
        for (int bj = 0; bj < 2; ++bj)
#pragma unroll
            for (int n = 0; n < 2; ++n) bv[bj][n] = *(const f32x4*)(bdn + (size_t)e * 2048 + c0 + bj * HALF + 4 * n);
#pragma unroll
        for (int ai = 0; ai < 2; ++ai)
#pragma unroll
            for (int m = 0; m < 4; ++m) {
                const int row = u.pm * BM + ai * HALF + wr * 64 + m * 16 + fr;
#pragma unroll
                for (int bj = 0; bj < 2; ++bj) { int o8[2];
#pragma unroll
                    for (int n = 0; n < 2; ++n) { const f32x4 v = acc[ai][bj][m][n] * wscale + bv[bj][n]; const int d = __builtin_amdgcn_cvt_pk_fp8_f32(v[0], v[1], 0, false); o8[n] = __builtin_amdgcn_cvt_pk_fp8_f32(v[2], v[3], d, true); }
                    typedef unsigned u32x2_ __attribute__((ext_vector_type(2)));
                    *(u32x2_*)(Y + (size_t)row * 2048 + c0 + bj * HALF) = (u32x2_){(unsigned)o8[0], (unsigned)o8[1]}; }
            }
    }
};
struct GroupedOrder {
    const volatile PG8_LAS int* texp; int NPN, nwg, G, c;
    __device__ void init(const volatile PG8_LAS int* texp_, int T, int NPN_, int G_, int c_) { texp = texp_; NPN = NPN_; nwg = T * NPN_; G = G_; c = c_; }
    __device__ bool next(int i, Unit& u) const {
        const long L = (long)i * G + c; if (L >= nwg) return false;
        int wgid = (int)L; { const int q = nwg / NXCD, r = nwg % NXCD, xcd = wgid % NXCD, off = wgid / NXCD; wgid = (xcd < r ? xcd * (q + 1) : r * (q + 1) + (xcd - r) * q) + off; }
        const int mt = wgid / NPN, t = wgid - mt * NPN;
        const int e = __builtin_amdgcn_readfirstlane(texp[mt]);
        u.pm = mt; u.pn = e * NPN + t; return true;
    }
    __device__ __forceinline__ void a_ready(const Unit&) const {}
    __device__ __forceinline__ void done(const Unit&) const {}
};
template <class Epi, class Sched, bool ALIGN_EPI = false, bool SP2 = false, bool F8 = false>
__device__ __forceinline__ void gemm_phase(PG8_LAS unsigned char* lds, const Gemm g, const Sched& S, const Epi& E) {
    int tid_o = threadIdx.x; asm volatile("" : "+v"(tid_o));
    const int tid = tid_o, wid = __builtin_amdgcn_readfirstlane(tid >> 6), lane = tid & 63, wr = wid >> 2, wc = wid & 3, fr = lane & 15, fq = lane >> 4;
    const int K = F8 ? g.K / 2 : g.K, nt = K / BK;
    unsigned voffA[2], voffB[2];
#pragma unroll
    for (int i = 0; i < 2; ++i) { int R, C; stage_rc(tid * 16 + i * 8192, R, C); const int Rb = Epi::PERM ? ((R & ~31) + perm32(R & 31)) : R;
        voffA[i] = (unsigned)(R * K + C) * 2u; voffB[i] = (unsigned)(Rb * K + C) * 2u; }
    const size_t kstep = (size_t)(BK * 2);
    const size_t hstep = (size_t)HALF * K * 2;
    const size_t tstep = 2 * hstep;
    const unsigned ldsw = (unsigned)wid * 1024u;
    const int aoff = lds_byte(wr * 64 + fr, fq * 8), boff = lds_byte(wc * 32 + fr, fq * 8);
#define PG8_SA(b, h) (((b) * 2 + (h)) * HTB)
#define PG8_SB(b, h) ((4 + (b) * 2 + (h)) * HTB)
#define PG8_STAGE(bufoff, gbase, voff) do { _Pragma("unroll") for (int _i = 0; _i < 2; ++_i) \
        __builtin_amdgcn_global_load_lds((const unsigned*)((const char*)(gbase) + (voff)[_i]), (PG8_LAS unsigned*)(lds + (bufoff) + ldsw + _i * 8192), 16, 0, 0); } while (0)
#define PG8_RD16(off) (*(const PG8_LAS v4i_*)(lds + (off)))
#define PG8_LDA(dst, b, h) do { _Pragma("unroll") for (int m = 0; m < 4; ++m) { if constexpr (F8) { const v4i_ l_ = PG8_RD16(PG8_SA(b, h) + aoff + m * 2048), h_ = PG8_RD16(PG8_SA(b, h) + aoff + m * 2048 + 1024); dst##8[m] = __builtin_shufflevector(l_, h_, 0, 1, 2, 3, 4, 5, 6, 7); } \
        else { _Pragma("unroll") for (int k = 0; k < 2; ++k) dst[m][k] = *(const PG8_LAS bf16x8*)(lds + PG8_SA(b, h) + aoff + m * 2048 + k * 1024); } } } while (0)
#define PG8_LDB(dst, b, h) do { _Pragma("unroll") for (int n = 0; n < 2; ++n) { if constexpr (F8) { const v4i_ l_ = PG8_RD16(PG8_SB(b, h) + boff + n * 2048), h_ = PG8_RD16(PG8_SB(b, h) + boff + n * 2048 + 1024); dst##8[n] = __builtin_shufflevector(l_, h_, 0, 1, 2, 3, 4, 5, 6, 7); } \
        else { _Pragma("unroll") for (int k = 0; k < 2; ++k) dst[n][k] = *(const PG8_LAS bf16x8*)(lds + PG8_SB(b, h) + boff + n * 2048 + k * 1024); } } } while (0)
#define PG8_MMA(ai, bj, At, Bt) do { __builtin_amdgcn_s_setprio(1); _Pragma("unroll") for (int m = 0; m < 4; ++m) _Pragma("unroll") for (int n = 0; n < 2; ++n) { \
        if constexpr (F8) {   \
            asm("v_mfma_scale_f32_16x16x128_f8f6f4 %0, %1, %2, %0, %3, %3 op_sel_hi:[0,0,0]" : "+v"(acc[ai][bj][m][n]) : "v"(Bt##8[n]), "v"(At##8[m]), "v"(sc8_)); }   \
        else { _Pragma("unroll") for (int k = 0; k < 2; ++k) acc[ai][bj][m][n] = __builtin_amdgcn_mfma_f32_16x16x32_bf16(Bt[n][k], At[m][k], acc[ai][bj][m][n], 0, 0, 0); } } \
        __builtin_amdgcn_s_setprio(0); } while (0)
#define PG8_WAIT_V(n) asm volatile("s_waitcnt vmcnt(" #n ")" ::: "memory")
#define PG8_WAIT_L(n) asm volatile("s_waitcnt lgkmcnt(" #n ")" ::: "memory")
#define PG8_BAR __builtin_amdgcn_s_barrier()
#define PG8_SCHED __builtin_amdgcn_sched_barrier(0)
    Unit cur, nxt; int ui = 0;
    if (!S.next(0, cur)) return;
    f32x4 acc[2][2][4][2];
#pragma unroll
    for (int a = 0; a < 2; ++a)
#pragma unroll
        for (int b = 0; b < 2; ++b)
#pragma unroll
            for (int m = 0; m < 4; ++m)
#pragma unroll
                for (int n = 0; n < 2; ++n) acc[a][b][m][n] = (f32x4){0.f, 0.f, 0.f, 0.f};
    typedef int v8i_ __attribute__((ext_vector_type(8))); typedef int v4i_ __attribute__((ext_vector_type(4)));
    int sc8_ = 0x7f7f7f7f; asm volatile("" : "+v"(sc8_));
    bf16x8 At[4][2], B0[2][2], B1[2][2]; v8i_ At8[4], B08[2], B18[2];
    const char* cA = (const char*)g.A + (size_t)cur.pm * tstep; const char* cB = (const char*)g.Bt + (size_t)cur.pn * tstep;
    S.a_ready(cur);
    if constexpr (SP2) {
        PG8_STAGE(PG8_SB(0, 0), cB, voffB); PG8_STAGE(PG8_SB(0, 1), cB + hstep, voffB); PG8_STAGE(PG8_SA(0, 0), cA, voffA); PG8_STAGE(PG8_SA(0, 1), cA + hstep, voffA);
        if (wr == 1) PG8_BAR;
        PG8_WAIT_V(2); PG8_BAR;
        PG8_STAGE(PG8_SB(1, 0), cB + kstep, voffB); PG8_STAGE(PG8_SA(1, 0), cA + kstep, voffA); PG8_STAGE(PG8_SB(1, 1), cB + hstep + kstep, voffB);
        PG8_WAIT_V(6); PG8_BAR;
    } else {
        PG8_STAGE(PG8_SB(0, 0), cB, voffB); PG8_STAGE(PG8_SA(0, 0), cA, voffA); PG8_STAGE(PG8_SB(0, 1), cB + hstep, voffB); PG8_STAGE(PG8_SA(0, 1), cA + hstep, voffA);
        if (wr == 1) PG8_BAR;
        PG8_WAIT_V(4); PG8_BAR;
        PG8_STAGE(PG8_SB(1, 0), cB + kstep, voffB); PG8_STAGE(PG8_SA(1, 0), cA + kstep, voffA); PG8_STAGE(PG8_SB(1, 1), cB + hstep + kstep, voffB);
        PG8_WAIT_V(6); PG8_BAR;
    }
    for (;;) {
        const bool has_next = S.next(ui + 1, nxt);
        const char* nA = has_next ? (const char*)g.A + (size_t)nxt.pm * tstep : cA; const char* nB = has_next ? (const char*)g.Bt + (size_t)nxt.pn * tstep : cB;
        for (int t = 0; t < nt; t += 2) {
            const bool last = (t == nt - 2);
            const char* a1 = cA + (size_t)(t + 1) * kstep;
            const char* a2 = last ? nA : cA + (size_t)(t + 2) * kstep; const char* b2 = last ? nB : cB + (size_t)(t + 2) * kstep;
            const char* a3 = a2 + kstep; const char* b3 = b2 + kstep;
            if (last && has_next) S.a_ready(nxt);
            if constexpr (SP2) {
            PG8_LDB(B0, 0, 0); PG8_LDB(B1, 0, 1); PG8_SCHED; PG8_LDA(At, 0, 0); PG8_STAGE(PG8_SA(1, 1), a1 + hstep, voffA);
            PG8_WAIT_V(8); PG8_WAIT_L(0); PG8_BAR; PG8_MMA(0, 0, At, B0); PG8_MMA(0, 1, At, B1); PG8_BAR; PG8_SCHED;
            PG8_LDA(At, 0, 1); PG8_STAGE(PG8_SB(0, 0), b2, voffB); PG8_STAGE(PG8_SB(0, 1), b2 + hstep, voffB); PG8_STAGE(PG8_SA(0, 0), a2, voffA);
            PG8_WAIT_V(8); PG8_WAIT_L(0); PG8_BAR; PG8_MMA(1, 0, At, B0); PG8_MMA(1, 1, At, B1); PG8_BAR; PG8_SCHED;
            PG8_LDB(B0, 1, 0); PG8_LDB(B1, 1, 1); PG8_SCHED; PG8_LDA(At, 1, 0); PG8_STAGE(PG8_SA(0, 1), a2 + hstep, voffA);
            PG8_WAIT_V(8); PG8_WAIT_L(0); PG8_BAR; PG8_MMA(0, 0, At, B0); PG8_MMA(0, 1, At, B1); PG8_BAR; PG8_SCHED;
            PG8_LDA(At, 1, 1); PG8_STAGE(PG8_SB(1, 0), b3, voffB); PG8_STAGE(PG8_SB(1, 1), b3 + hstep, voffB); PG8_STAGE(PG8_SA(1, 0), a3, voffA);
            PG8_WAIT_V(8); PG8_WAIT_L(0); PG8_BAR; PG8_MMA(1, 0, At, B0); PG8_MMA(1, 1, At, B1); PG8_BAR; PG8_SCHED;
            } else {
            PG8_LDB(B0, 0, 0); PG8_SCHED; PG8_LDA(At, 0, 0); PG8_STAGE(PG8_SA(1, 1), a1 + hstep, voffA);
            PG8_WAIT_L(8); PG8_BAR; PG8_WAIT_L(0); PG8_MMA(0, 0, At, B0); PG8_BAR; PG8_SCHED;
            PG8_LDB(B1, 0, 1); PG8_STAGE(PG8_SB(0, 0), b2, voffB);
            PG8_BAR; PG8_WAIT_L(0); PG8_MMA(0, 1, At, B1); PG8_BAR;
            PG8_LDA(At, 0, 1); PG8_STAGE(PG8_SA(0, 0), a2, voffA);
            PG8_BAR; PG8_WAIT_L(0); PG8_MMA(1, 0, At, B0); PG8_BAR; PG8_SCHED;
            PG8_STAGE(PG8_SB(0, 1), b2 + hstep, voffB);
            PG8_WAIT_V(6); PG8_BAR; PG8_MMA(1, 1, At, B1); PG8_BAR;
            PG8_LDB(B0, 1, 0); PG8_SCHED; PG8_LDA(At, 1, 0); PG8_STAGE(PG8_SA(0, 1), a2 + hstep, voffA);
            PG8_WAIT_L(8); PG8_BAR; PG8_WAIT_L(0); PG8_MMA(0, 0, At, B0); PG8_BAR; PG8_SCHED;
            PG8_LDB(B1, 1, 1); PG8_STAGE(PG8_SB(1, 0), b3, voffB);
            PG8_BAR; PG8_WAIT_L(0); PG8_MMA(0, 1, At, B1); PG8_BAR;
            PG8_LDA(At, 1, 1); PG8_STAGE(PG8_SA(1, 0), a3, voffA);
            PG8_BAR; PG8_WAIT_L(0); PG8_MMA(1, 0, At, B0); PG8_BAR; PG8_SCHED;
            PG8_STAGE(PG8_SB(1, 1), b3 + hstep, voffB);
            PG8_WAIT_V(6); PG8_BAR; PG8_MMA(1, 1, At, B1); PG8_BAR;
            }
        }
        if constexpr (F8) asm volatile("s_nop 15\n\ts_nop 15" ::: "memory");
        if constexpr (ALIGN_EPI) { if (wr == 0) PG8_BAR; }
        if constexpr (!Epi::AFTER_DRAIN) { E(acc, cur, wr, wc, fr, fq); S.done(cur); }
        if (!has_next) break;
#pragma unroll
        for (int a = 0; a < 2; ++a)
#pragma unroll
            for (int b = 0; b < 2; ++b)
#pragma unroll
                for (int m = 0; m < 4; ++m)
#pragma unroll
                    for (int n = 0; n < 2; ++n) acc[a][b][m][n] = (f32x4){0.f, 0.f, 0.f, 0.f};
        cur = nxt; cA = nA; cB = nB; ++ui;
        if constexpr (ALIGN_EPI) { if (wr == 1) PG8_BAR; }
    }
    PG8_WAIT_V(0);
    if constexpr (!ALIGN_EPI) { if (wr == 0) PG8_BAR; }
    PG8_BAR;
    if constexpr (Epi::AFTER_DRAIN) { E.fused(acc, cur, wr, wc, fr, fq, lds, wid, lane); S.done(cur); }
#undef PG8_SA
#undef PG8_SB
#undef PG8_STAGE
#undef PG8_RD16
#undef PG8_LDA
#undef PG8_LDB
#undef PG8_MMA
#undef PG8_WAIT_V
#undef PG8_WAIT_L
#undef PG8_BAR
#undef PG8_SCHED
}
}
namespace fox {
constexpr float THR = 8.f; constexpr int D = 128;
constexpr float SCALE = 0.08838834764831845f;
constexpr int NW = 8, QBLK = 32, KVBLK = 64, QB = NW * QBLK;
constexpr int SHM_V = KVBLK * D * 2, SHM_K = KVBLK * D * 2;
using bf16 = __hip_bfloat16;
typedef short bf16x8 __attribute__((ext_vector_type(8)));
typedef short s16x4 __attribute__((ext_vector_type(4)));
typedef float f32x16 __attribute__((ext_vector_type(16)));
typedef float f32x4 __attribute__((ext_vector_type(4)));
typedef unsigned u32x4 __attribute__((ext_vector_type(4)));
template <class A, class Bt> struct same_t { static constexpr bool v = false; };
template <class A> struct same_t<A, A> { static constexpr bool v = true; };

#define KSWZ(row, colB) ((row) * 256 + ((colB) ^ (((row) & 7) << 4)))
#define SBAR() __builtin_amdgcn_sched_barrier(0)
__device__ __forceinline__ int v_st(int k, int c) { const int kk = (k & ~0xC) | ((k & 4) << 1) | ((k & 8) >> 1); return ((kk >> 3) * 4 + (c >> 5)) * 512 + ((kk & 7) * 32 + (c & 31)) * 2; }
__device__ __forceinline__ int v_rd_base(int lane) { return ((lane & 3) << 3) | (((lane >> 2) & 3) << 6) | (((lane >> 4) & 1) << 5) | (((lane >> 5) & 1) << 8); }
constexpr int v_rd_off(int d0, int ks, int half) { return d0 * 512 + ks * 4096 + half * 2048; }
__device__ __forceinline__ int crow(int r, int hi) { return (r & 3) + 8 * (r >> 2) + 4 * hi; }
__device__ __forceinline__ unsigned cvtpk(float lo, float hi) {
    unsigned r; asm volatile("v_cvt_pk_bf16_f32 %0, %1, %2" : "=v"(r) : "v"(lo), "v"(hi)); return r;
}
__device__ __forceinline__ bf16x8 pack8(f32x4 a, f32x4 b) {
    u32x4 w = {cvtpk(a[0], a[1]), cvtpk(a[2], a[3]), cvtpk(b[0], b[1]), cvtpk(b[2], b[3])};
    return *reinterpret_cast<bf16x8*>(&w);
}
template <class T> __device__ __forceinline__ bf16x8 load8(const T* p) {
    if constexpr (same_t<T, float>::v) { return pack8(*(const f32x4*)p, *(const f32x4*)(p + 4)); }
    else { return *reinterpret_cast<const bf16x8*>(p); }
}
__device__ __forceinline__ void mask_tile(f32x16& p0, f32x16& p1, int dq, unsigned W) {
    const float NEG = -__builtin_inff();
#pragma unroll
    for (int r = 0; r < 16; ++r) {
        const int c = (r & 3) + 8 * (r >> 2);
        if ((unsigned)(dq - c) >= W) p0[r] = NEG;
        if ((unsigned)(dq - c - 32) >= W) p1[r] = NEG;
    }
}
__device__ __forceinline__ void partialSM(f32x16& p0, f32x16& p1, float& m_reg, float& mn, float& alpha) {
    float pmax = p0[0]; for (int r = 1; r < 16; ++r) pmax = fmaxf(pmax, p0[r]); for (int r = 0; r < 16; ++r) pmax = fmaxf(pmax, p1[r]);
    { auto rr = __builtin_amdgcn_permlane32_swap(__float_as_uint(pmax), __float_as_uint(pmax), false, false);
      pmax = fmaxf(__uint_as_float(rr[0]), __uint_as_float(rr[1])); }
    constexpr float C2 = 1.4426950408889634f * SCALE;
    if (__builtin_expect(__all((pmax - m_reg) * SCALE <= THR), 1)) { mn = m_reg; alpha = 1.f; }
    else { mn = fmaxf(m_reg, pmax); alpha = __builtin_amdgcn_exp2f((m_reg - mn) * C2); m_reg = mn; }
    const float mnL = -mn * C2;
    for (int r = 0; r < 16; ++r) p0[r] = fmaf(p0[r], C2, mnL); for (int r = 0; r < 16; ++r) p1[r] = fmaf(p1[r], C2, mnL);
    for (int r = 0; r < 16; ++r) p0[r] = __builtin_amdgcn_exp2f(p0[r]);
}
__device__ __forceinline__ void finishSM(f32x16& p0, f32x16& p1, float alpha, float& l_reg, bf16x8& pa0, bf16x8& pa1, bf16x8& pa2, bf16x8& pa3) {
    for (int r = 0; r < 16; ++r) p1[r] = __builtin_amdgcn_exp2f(p1[r]);
    float ps = 0; for (int r = 0; r < 16; ++r) ps += p0[r]; for (int r = 0; r < 16; ++r) ps += p1[r];
    { auto rr = __builtin_amdgcn_permlane32_swap(__float_as_uint(ps), __float_as_uint(ps), false, false);
      ps = __uint_as_float(rr[0]) + __uint_as_float(rr[1]); }
    l_reg = l_reg * alpha + ps;
#define PK4(P, B_, OUT) do { unsigned a0 = cvtpk(P[B_+0], P[B_+1]), a1 = cvtpk(P[B_+2], P[B_+3]);                          \
        unsigned b0 = cvtpk(P[B_+4], P[B_+5]), b1 = cvtpk(P[B_+6], P[B_+7]);                                             \
        auto r0 = __builtin_amdgcn_permlane32_swap(a0, b0, false, false); auto r1 = __builtin_amdgcn_permlane32_swap(a1, b1, false, false); \
        u32x4 w = {r0[0], r1[0], r0[1], r1[1]}; OUT = *reinterpret_cast<bf16x8*>(&w); } while (0)
    PK4(p0, 0, pa0); PK4(p0, 8, pa1); PK4(p1, 0, pa2); PK4(p1, 8, pa3);
#undef PK4
}
template <int KB, bool SK>
__device__ __forceinline__ void qkt(f32x16& p0, f32x16& p1, const char* K_lds, int r32, int hi, const char* Qw, const float* cneg, bool act) {
    if (SK && !act) { const float NEG = -__builtin_inff();
#pragma unroll
        for (int r = 0; r < 16; ++r) { p0[r] = NEG; p1[r] = NEG; } return; }
    {
#pragma unroll
        for (int g = 0; g < 4; ++g) { const f32x4 c0 = *(const f32x4*)(cneg + 8 * g), c1 = *(const f32x4*)(cneg + 32 + 8 * g);
#pragma unroll
            for (int j = 0; j < 4; ++j) { p0[4 * g + j] = c0[j]; p1[4 * g + j] = c1[j]; } } }
    const char* kb[4]; const char* qb4[4];
#pragma unroll
    for (int dd = 0; dd < 4; ++dd) { kb[dd] = K_lds + KB * SHM_K + KSWZ(r32, (dd * 16 + hi * 8) * 2); qb4[dd] = Qw + KSWZ(r32, (dd * 16 + hi * 8) * 2); }
#pragma unroll
    for (int d0 = 0; d0 < 8; ++d0) { const char* a = kb[d0 & 3] + (d0 >> 2) * 128;
        bf16x8 b0 = *reinterpret_cast<const bf16x8*>(a);
        bf16x8 b1 = *reinterpret_cast<const bf16x8*>(a + 32 * 256);
        bf16x8 qf = *reinterpret_cast<const bf16x8*>(qb4[d0 & 3] + (d0 >> 2) * 128);
        p0 = __builtin_amdgcn_mfma_f32_32x32x16_bf16(b0, qf, p0, 0, 0, 0);
        p1 = __builtin_amdgcn_mfma_f32_32x32x16_bf16(b1, qf, p1, 0, 0, 0); }
}
template <int VB, bool SK>
__device__ __forceinline__ void pv_tile(f32x16* o, int vb0, bf16x8 pa0, bf16x8 pa1, bf16x8 pa2, bf16x8 pa3, bool act) {
    if (SK && !act) return;
#define TRRD(dst, off) asm volatile("ds_read_b64_tr_b16 %0, %1 offset:%2" : "=&v"(dst) : "v"(vb0), "i"(off) : "memory")
#define PV_D0(d0) do { s16x4 l0, l1, l2, l3, h0, h1, h2, h3; constexpr int b_ = VB * SHM_V + v_rd_off(d0, 0, 0);     \
        TRRD(l0, b_); TRRD(h0, b_ + 2048); TRRD(l1, b_ + 4096); TRRD(h1, b_ + 6144); TRRD(l2, b_ + 8192); TRRD(h2, b_ + 10240); TRRD(l3, b_ + 12288); TRRD(h3, b_ + 14336); \
        asm volatile("s_waitcnt lgkmcnt(0)" ::: "memory"); SBAR();                 \
        o[d0] = __builtin_amdgcn_mfma_f32_32x32x16_bf16(pa0, (bf16x8){l0[0], l0[1], l0[2], l0[3], h0[0], h0[1], h0[2], h0[3]}, o[d0], 0, 0, 0);   \
        o[d0] = __builtin_amdgcn_mfma_f32_32x32x16_bf16(pa1, (bf16x8){l1[0], l1[1], l1[2], l1[3], h1[0], h1[1], h1[2], h1[3]}, o[d0], 0, 0, 0);   \
        o[d0] = __builtin_amdgcn_mfma_f32_32x32x16_bf16(pa2, (bf16x8){l2[0], l2[1], l2[2], l2[3], h2[0], h2[1], h2[2], h2[3]}, o[d0], 0, 0, 0);   \
        o[d0] = __builtin_amdgcn_mfma_f32_32x32x16_bf16(pa3, (bf16x8){l3[0], l3[1], l3[2], l3[3], h3[0], h3[1], h3[2], h3[3]}, o[d0], 0, 0, 0); } while (0)
    PV_D0(0); PV_D0(1); PV_D0(2); PV_D0(3);
#undef PV_D0
#undef TRRD
}
constexpr int LDS_CK = 2 * SHM_V + 2 * SHM_K + NW * 64 * 4, LDS_Q = LDS_CK + 2 * 64 * 4, LDS_BYTES_FOX = LDS_Q + NW * QBLK * D * 2;
struct FoxRef { const bf16* Q; const bf16* K; const bf16* V; const float* C; bf16* O; float* ML; int P0, j_lo, j_hi, dummy; };
struct FoxSeam { int unused; };
#define VMW() asm volatile("s_waitcnt vmcnt(0)" ::: "memory")
#define FOX_LAS __attribute__((address_space(3)))
struct FoxDma { int kof, vof, qof; };
__device__ __forceinline__ FoxDma fox_dma_init(int wid, int lane) {
    FoxDma d; const int lr = lane >> 4, lc = lane & 15;
    d.kof = (wid * 8 + lr) * 256 + ((lc ^ lr) << 4);
    const int kk = wid * 8 + ((lane & 31) >> 2), k = (kk & ~0xC) | ((kk & 4) << 1) | ((kk & 8) >> 1);
    d.vof = k * 256 + ((lane >> 5) * 32 + (lane & 3) * 8) * 2;
    d.qof = (wid * QBLK + lr) * 256 + ((lc ^ lr) << 4);
    return d;
}
constexpr int NC_OFF = 8 * 8256;
#define FOX_G2L(gp, lp, n) __builtin_amdgcn_global_load_lds((const unsigned*)(gp), (FOX_LAS unsigned*)(lp), n, 0, 0)
#define FOX_DMA_K(Kp, Cp, kb_, kbuf) do { const char* kg_ = (const char*)(Kp) + (size_t)(kb_) * 256; unsigned ko_ = dm.kof, lo_ = lane * 4; asm volatile("" : "+v"(ko_), "+v"(lo_));       \
        FOX_G2L(kg_ + ko_, K_lds + (kbuf) * SHM_K + wid * 2048, 16); FOX_G2L(kg_ + ((ko_ ^ 64u) + 1024u), K_lds + (kbuf) * SHM_K + wid * 2048 + 1024, 16);                               \
        if (wid == 0) FOX_G2L((const char*)((Cp) + NC_OFF + (kb_)) + lo_, (char*)ck_lds + (kbuf) * 256, 4); } while (0)
#define FOX_DMA_V(Vp, kb_, vbuf) do { const char* vg_ = (const char*)(Vp) + (size_t)(kb_) * 256; unsigned vo_ = dm.vof; asm volatile("" : "+v"(vo_));                                     \
        FOX_G2L(vg_ + vo_, V_lds + (vbuf) * SHM_V + wid * 2048, 16); FOX_G2L(vg_ + (vo_ + 128u), V_lds + (vbuf) * SHM_V + wid * 2048 + 1024, 16); } while (0)
#define FOX_DMA_Q(Qp) do { const char* qg_ = (const char*)(Qp); unsigned qo_ = dm.qof; asm volatile("" : "+v"(qo_));                                                                      \
        _Pragma("unroll") for (int i_ = 0; i_ < 8; ++i_) FOX_G2L(qg_ + ((qo_ ^ (64u * (i_ & 1))) + 1024u * i_), Qw + 1024 * i_, 16); } while (0)
__device__ __forceinline__ void qkt_rt(f32x16& p0, f32x16& p1, const char* Kt, int r32, int hi, const char* Qw, const float* cneg) {
#pragma unroll
    for (int g = 0; g < 4; ++g) { const f32x4 c0 = *(const f32x4*)(cneg + 8 * g), c1 = *(const f32x4*)(cneg + 32 + 8 * g);
#pragma unroll
        for (int j = 0; j < 4; ++j) { p0[4 * g + j] = c0[j]; p1[4 * g + j] = c1[j]; } }
    const char* kb[4]; const char* qb4[4];
#pragma unroll
    for (int dd = 0; dd < 4; ++dd) { kb[dd] = Kt + KSWZ(r32, (dd * 16 + hi * 8) * 2); qb4[dd] = Qw + KSWZ(r32, (dd * 16 + hi * 8) * 2); }
#pragma unroll
    for (int d0 = 0; d0 < 8; ++d0) { const char* a = kb[d0 & 3] + (d0 >> 2) * 128;
        bf16x8 b0 = *reinterpret_cast<const bf16x8*>(a);
        bf16x8 b1 = *reinterpret_cast<const bf16x8*>(a + 32 * 256);
        bf16x8 qf = *reinterpret_cast<const bf16x8*>(qb4[d0 & 3] + (d0 >> 2) * 128);
        p0 = __builtin_amdgcn_mfma_f32_32x32x16_bf16(b0, qf, p0, 0, 0, 0);
        p1 = __builtin_amdgcn_mfma_f32_32x32x16_bf16(b1, qf, p1, 0, 0, 0); }
}
__device__ __forceinline__ void fox_prime(const FoxRef& cur, char* lds, FoxSeam& S) {
    const int tid = threadIdx.x, wid = __builtin_amdgcn_readfirstlane(tid >> 6), lane = tid & 63;
    char* K_lds = lds + 2 * SHM_V; float* ck_lds = (float*)(lds + LDS_CK); char* Qw = lds + LDS_Q + wid * (QBLK * D * 2);
    const FoxDma dm = fox_dma_init(wid, lane);
    FOX_DMA_K(cur.K, cur.C, cur.j_lo * KVBLK, 0); FOX_DMA_Q(cur.Q);
    S.unused = 0;
    VMW(); __syncthreads();
}
__device__ __forceinline__ void fox_block(const FoxRef& cur, const FoxRef& nxt, char* lds, FoxSeam& S) {
    constexpr unsigned W = 0x7fffffffu;
    int tid_o = threadIdx.x; asm volatile("" : "+v"(tid_o));
    const int tid = tid_o, wid = __builtin_amdgcn_readfirstlane(tid >> 6), lane = tid & 63, r32 = lane & 31, hi = lane >> 5, grp = wid >> 2;
    const int j_lo = cur.j_lo, NT = cur.j_hi - cur.j_lo;
    const int kbn = nxt.j_lo * KVBLK;
    const int qlo = cur.P0 + wid * QBLK, qm = qlo + r32 - 4 * hi;
    char* V_lds = lds; char* K_lds = lds + 2 * SHM_V;
    float* ws = (float*)(lds + 2 * SHM_V + 2 * SHM_K) + wid * 64; float* li_l = ws, * al_l = ws + 32;
    float* ck_lds = (float*)(lds + LDS_CK);
    char* Qw = lds + LDS_Q + wid * (QBLK * D * 2);
    float m_reg = -1e30f, l_reg = 0; f32x16 o[4] = {};
    const int vb0 = (int)(uintptr_t)V_lds + v_rd_base(lane);
    const bf16* Kh = cur.K; const bf16* Vh = cur.V; const float* Ch = cur.C;
    const FoxDma dm = fox_dma_init(wid, lane);
    f32x16 p0, p1; float mn, al; bf16x8 pa0, pa1, pa2, pa3;
#define KBASE(t) ((j_lo + (t)) * KVBLK)
#define DMA_STEP(s) do { FOX_DMA_V(Vh, KBASE(s), (s) & 1); if ((s) + 1 < NT) { FOX_DMA_K(Kh, Ch, KBASE((s) + 1), ((s) + 1) & 1); } SBAR(); } while (0)
#define DMA_SEAM() do { FOX_DMA_K(nxt.K, nxt.C, kbn, 0); FOX_DMA_Q(nxt.Q); SBAR(); } while (0)
#define QK(t) qkt_rt(p0, p1, K_lds + ((t) & 1) * SHM_K, r32, hi, Qw, ck_lds + ((t) & 1) * 64 + 4 * hi)
#define PV(t) pv_tile<0, false>(o, vb0 + ((t) & 1) * SHM_V, pa0, pa1, pa2, pa3, true)
#define SM(t) do { { const int kb_ = KBASE(t); if (kb_ + KVBLK - 1 > qlo) mask_tile(p0, p1, qm - kb_, W); }                                 \
        partialSM(p0, p1, m_reg, mn, al); finishSM(p0, p1, al, l_reg, pa0, pa1, pa2, pa3);                                                  \
        if (__any(al < 1.f)) { if (hi == 0) al_l[r32] = al; asm volatile("s_waitcnt lgkmcnt(0)" ::: "memory");                                \
            for (int d_ = 0; d_ < 4; ++d_) for (int r = 0; r < 16; ++r) o[d_][r] *= al_l[crow(r, hi)]; } } while (0)
#define BAR() do { SBAR(); __syncthreads(); SBAR(); } while (0)
#define EPILOGUE() do {                                                                                                                      \
    if (hi == 0) li_l[r32] = l_reg; asm volatile("s_waitcnt lgkmcnt(0)" ::: "memory");                                                        \
    if (hi == 0) *(float2*)(cur.ML + (wid * QBLK + r32) * 2) = make_float2(m_reg, l_reg);                                                     \
    float rli[16];                                                                                                                           \
    _Pragma("unroll") for (int r = 0; r < 16; ++r) { const float lv = li_l[crow(r, hi)]; rli[r] = lv > 0.f ? __builtin_amdgcn_rcpf(lv) : 0.f; } \
    bf16* Ow = cur.O + (size_t)(wid * QBLK) * D;                                                                                             \
    _Pragma("unroll") for (int r = 0; r < 16; ++r) { const int orow = crow(r, hi);                                                            \
        _Pragma("unroll") for (int d0 = 0; d0 < 4; ++d0) { const float v = o[d0][r] * rli[r];                                                 \
            const float vn = __shfl_xor(v, 1);                                                                                               \
            if ((r32 & 1) == 0) *(unsigned*)(Ow + (size_t)orow * D + d0 * 32 + r32) = cvtpk(v, vn); } } } while (0)
    if (grp == 0) {
        DMA_STEP(0); QK(0); BAR();
#pragma unroll 1
        for (int t = 0; t + 1 < NT; ++t) { SM(t); VMW(); BAR();   DMA_STEP(t + 1); QK(t + 1); PV(t); BAR(); }
        SM(NT - 1); VMW(); BAR();
        DMA_SEAM(); PV(NT - 1); BAR();
        EPILOGUE(); VMW(); BAR();
    } else {
        DMA_STEP(0); BAR();
        QK(0); VMW(); BAR();
#pragma unroll 1
        for (int t = 0; t + 1 < NT; ++t) { DMA_STEP(t + 1); SM(t); BAR();   QK(t + 1); PV(t); VMW(); BAR(); }
        DMA_SEAM(); SM(NT - 1); BAR();
        PV(NT - 1); VMW(); BAR();
        EPILOGUE();
    }
#undef DMA_STEP
#undef DMA_SEAM
#undef QK
#undef PV
#undef SM
#undef BAR
#undef EPILOGUE
#undef KBASE
}
#undef VMW
#undef FOX_G2L
#undef FOX_DMA_K
#undef FOX_DMA_V
#undef FOX_DMA_Q
}
constexpr int NWAVES = 8, NTHREADS = 512;
constexpr int DM = 2048, SEQ = 8192, NMETA = 16, LTOT = SEQ + NMETA, NHEAD = 8, HDIM = 128, INCOLS = 5128, NIN = 5120;
constexpr int NEXP = 32, TOPK = 4, CKW = 31;
constexpr int MIN_ROWS = 8448;
constexpr int SKV = 8256;
constexpr int MAXT = 160, PROWS = MAXT * 256;
constexpr float NORM_EPS = 1e-5f;
constexpr float INV_SCALE = 11.313708498984761f;
constexpr float W8_SCALE = 32.0f, W8_INV = 1.0f / 32.0f;
constexpr size_t MiB = 1u << 20;
constexpr size_t WS_CTL = 0, CTL_ZERO_BYTES = 1 * MiB;
constexpr size_t WS_WIN = 1 * MiB, WS_WOUT = 21 * MiB, WS_WGU = 32 * MiB, WS_WDN = 544 * MiB, WS_HN = 800 * MiB, WS_Q = 834 * MiB, WS_K = 850 * MiB, WS_V = 867 * MiB,
                 WS_U = 884 * MiB, WS_MIXED = 901 * MiB, WS_H = 933 * MiB, WS_HN2 = 997 * MiB, WS_XG = 1029 * MiB, WS_ACT = 1189 * MiB, WS_Y = 1349 * MiB,
                 WS_OPART = 1509 * MiB, WS_ML = 1573 * MiB, WS_LOGF = 1575 * MiB, WS_CS = 1576 * MiB, WS_ROUTE = 1577 * MiB, WS_END = 1579 * MiB;
static_assert(WS_WIN + (size_t)NIN * DM * 2 <= WS_WOUT && WS_WOUT + (size_t)DM * DM * 2 <= WS_WGU && WS_WGU + (size_t)NEXP * 4096 * DM * 2 <= WS_WDN && WS_WDN + (size_t)NEXP * DM * DM * 2 <= WS_HN, "ws map 1");
static_assert(WS_HN + (size_t)MIN_ROWS * DM * 2 <= WS_Q && WS_Q + (size_t)NHEAD * SEQ * HDIM * 2 <= WS_K && WS_K + (size_t)NHEAD * SKV * HDIM * 2 <= WS_V && WS_V + (size_t)NHEAD * SKV * HDIM * 2 <= WS_U, "ws map 2");
static_assert(WS_U + (size_t)LTOT * 1024 * 2 <= WS_MIXED && WS_MIXED + (size_t)SEQ * DM * 2 <= WS_H && WS_H + (size_t)SEQ * DM * 4 <= WS_HN2 && WS_HN2 + (size_t)SEQ * DM * 2 <= WS_XG, "ws map 3");
static_assert(WS_XG + (size_t)PROWS * DM * 2 <= WS_ACT && WS_ACT + (size_t)PROWS * DM * 2 <= WS_Y && WS_Y + (size_t)PROWS * DM * 2 <= WS_OPART && WS_OPART + (size_t)1024 * 256 * 128 * 2 <= WS_ML, "ws map 4");
static_assert(WS_ML + (size_t)1024 * 512 * 4 <= WS_LOGF && WS_LOGF + (size_t)LTOT * 8 * 4 <= WS_CS && WS_CS + (size_t)2 * NHEAD * SKV * 4 <= WS_ROUTE && WS_ROUTE + (size_t)4 * SEQ * 4 * 4 + 256 * 32 * 4 <= WS_END, "ws map 5");
constexpr int CW_BAR = 4096, CW_QUEUE = 8192  , CW_CNT = 8384, CW_TEXP = 8448  , CW_NT = 8640  , CW_NORM = 8704  ;
constexpr int RING_BYTES = 135168, MISC_OFF = RING_BYTES, LDS_BYTES = RING_BYTES + 1024;

#define GAS __attribute__((address_space(1)))
#define LAS __attribute__((address_space(3)))
typedef unsigned short bf16;
typedef unsigned v4u __attribute__((ext_vector_type(4)));
typedef unsigned v2u __attribute__((ext_vector_type(2)));
typedef float f32x4 __attribute__((ext_vector_type(4)));
typedef float f32x16 __attribute__((ext_vector_type(16)));
typedef GAS unsigned gu32;
#define RLX_AGENT __ATOMIC_RELAXED, __HIP_MEMORY_SCOPE_AGENT
__device__ __forceinline__ unsigned pk2(float lo, float hi) { unsigned r; asm volatile("v_cvt_pk_bf16_f32 %0, %1, %2" : "=v"(r) : "v"(lo), "v"(hi)); return r; }
__device__ __forceinline__ float bf_lo(unsigned w) { return __uint_as_float(w << 16); }
__device__ __forceinline__ float bf_hi(unsigned w) { return __uint_as_float(w & 0xffff0000u); }
__device__ __forceinline__ float wave_sum(float v) {
#pragma unroll
    for (int o = 1; o < 64; o <<= 1) v += __shfl_xor(v, o);
    return v;
}
#define XB_TMO      128
#define XB_XCNT(j)  (256  + 64 * (j))
#define XB_XSUB(j)  (1280 + 64 * (j))
#define XB_XGEN(j)  (2304 + 64 * (j))
#define XB_TOP      3328
#define XB_TOPGEN   3392
#define XCD_BAR_WORDS 3456
#define XB_SPIN_CAP (1u << 18)

__device__ __forceinline__ unsigned xb_ld(unsigned* p)              { return __hip_atomic_load(p, __ATOMIC_RELAXED, __HIP_MEMORY_SCOPE_AGENT); }
__device__ __forceinline__ unsigned xb_add(unsigned* p, unsigned v) { return __hip_atomic_fetch_add(p, v, __ATOMIC_RELAXED, __HIP_MEMORY_SCOPE_AGENT); }
__device__ __forceinline__ unsigned xb_xcc_id() { return (unsigned)__builtin_amdgcn_s_getreg((3 << 11) | 20) & 0xFu; }
#define XB_SPIN(cond, bar) do { unsigned _sp = 0; while (cond) { __builtin_amdgcn_s_sleep(1); \
    if ((++_sp & 255u) == 0u) { if (xb_ld(&(bar)[XB_TMO])) break; if (_sp > XB_SPIN_CAP) { atomicAdd(&(bar)[XB_TMO], 1u); break; } } } } while (0)

struct XcdBarrier {
    unsigned* bar; unsigned x;
    volatile LAS unsigned* st;
};

__device__ __forceinline__ XcdBarrier xcd_barrier_post(unsigned* bar, volatile LAS unsigned* st) {
    XcdBarrier b; b.bar = bar; b.x = xb_xcc_id(); b.st = st;
    if (threadIdx.x == 0) (void)xb_add(&bar[XB_XCNT(b.x)], 1u);
    return b;
}
__device__ __forceinline__ void xcd_barrier_complete(unsigned* bar, unsigned x, unsigned& nloc, unsigned& nx) {
    const unsigned G = gridDim.x * gridDim.y * gridDim.z;
    unsigned sum, cnt, mine, sp = 0u;
    for (;;) {
        sum = 0u; cnt = 0u; mine = 0u;
#pragma unroll
        for (unsigned j = 0; j < 16; ++j) { const unsigned c = xb_ld(&bar[XB_XCNT(j)]); sum += c; cnt += (c > 0u) ? 1u : 0u; mine = (j == x) ? c : mine; }
        if (sum == G) break;
        __builtin_amdgcn_s_sleep(1);
        if ((++sp & 255u) == 0u) { if (xb_ld(&bar[XB_TMO])) break; if (sp > XB_SPIN_CAP) { atomicAdd(&bar[XB_TMO], 1u); break; } }
    }
    nloc = mine > 0u ? mine : 1u; nx = cnt > 0u ? cnt : 1u;
}

__device__ __forceinline__ void xcd_barrier(const XcdBarrier& b) {
    asm volatile("s_waitcnt vmcnt(0)" ::: "memory");
    __syncthreads();
    if (threadIdx.x == 0) {
        unsigned* bar = b.bar;
        __builtin_amdgcn_s_waitcnt(0);
        unsigned nloc = b.st[0], nx = b.st[1];
        if (nloc == 0u) { xcd_barrier_complete(bar, b.x, nloc, nx); b.st[0] = nloc; b.st[1] = nx; }
        const unsigned old = xb_add(&bar[XB_XSUB(b.x)], 1u);
        const unsigned gen = old / nloc;
        if (old + 1u == (gen + 1u) * nloc) {
            __builtin_amdgcn_fence(__ATOMIC_RELEASE, "agent");
            asm volatile("s_waitcnt vmcnt(0)" ::: "memory");
            const unsigned og = xb_add(&bar[XB_TOP], 1u);
            const unsigned tg = og / nx;
            if (og + 1u == (tg + 1u) * nx) xb_add(&bar[XB_TOPGEN], 1u);
            else XB_SPIN(xb_ld(&bar[XB_TOPGEN]) == tg, bar);
            __builtin_amdgcn_fence(__ATOMIC_ACQUIRE, "agent");
            xb_add(&bar[XB_XGEN(b.x)], 1u);
            asm volatile("s_waitcnt vmcnt(0)" ::: "memory");
        } else {
            XB_SPIN(xb_ld(&bar[XB_XGEN(b.x)]) == gen, bar);
            __builtin_amdgcn_fence(__ATOMIC_ACQUIRE, "agent");
            asm volatile("s_waitcnt vmcnt(0)" ::: "memory");
        }
    }
    __syncthreads();
}
struct Args { const float* in[19]; float* out; unsigned char* ws; };
enum { I_X = 0, I_META, I_G1, I_WIN, I_BF, I_BGLU, I_CW, I_CB, I_GNG, I_GNB, I_WOUT, I_G2, I_RW, I_RB, I_WGU, I_BGU, I_WDN, I_BDN, I_GF };

struct CvJob { const float* src; bf16* dst; int ld; int f8; };
constexpr int CV_GU = NEXP * 32 * 16, CV_DN = NEXP * 16 * 16, CV_IN = 40 * 16, CV_OUT = 16 * 16, CV_JOBS = CV_GU + CV_DN + CV_IN + CV_OUT;
__device__ __forceinline__ CvJob cv_decode(int job, const Args& a) {
    CvJob j;
    if (job < CV_GU) { const int e = job >> 9, r = job & 511, kb = r >> 5, nb = r & 31, col0 = (nb & 1) * 2048 + 128 * (nb >> 1);
        j.src = a.in[I_WGU] + (size_t)e * DM * 4096 + (size_t)(kb * 128) * 4096 + col0; j.ld = 4096; j.f8 = 1; j.dst = (bf16*)((unsigned char*)(a.ws + WS_WGU) + ((size_t)e * 4096 + nb * 128) * DM + kb * 128); }
    else if (job < CV_GU + CV_DN) { const int q = job - CV_GU, e = q >> 8, r = q & 255, kb = r >> 4, nb = r & 15;
        j.src = a.in[I_WDN] + (size_t)e * DM * DM + (size_t)(kb * 128) * DM + nb * 128; j.ld = DM; j.f8 = 1; j.dst = (bf16*)((unsigned char*)(a.ws + WS_WDN) + ((size_t)e * DM + nb * 128) * DM + kb * 128); }
    else if (job < CV_GU + CV_DN + CV_IN) { const int q = job - CV_GU - CV_DN, kb = q / 40, nb = q - kb * 40;
        const int col0 = nb < 24 ? 128 * nb : ((((nb - 24) & 1) ? 4104 : 3080) + 128 * ((nb - 24) >> 1));
        j.src = a.in[I_WIN] + (size_t)(kb * 128) * INCOLS + col0; j.ld = INCOLS; j.f8 = 0; j.dst = (bf16*)(a.ws + WS_WIN) + (size_t)(nb * 128) * DM + kb * 128; }
    else { const int q = job - CV_GU - CV_DN - CV_IN, kb = q >> 4, nb = q & 15;
        j.src = a.in[I_WOUT] + (size_t)(kb * 128) * DM + nb * 128; j.ld = DM; j.f8 = 0; j.dst = (bf16*)(a.ws + WS_WOUT) + (size_t)(nb * 128) * DM + kb * 128; }
    return j;
}
__device__ __forceinline__ void cv_load(const CvJob& j, f32x4 (&v)[8], int tid) {
    const int c4 = tid & 31, kr = tid >> 5;
#pragma unroll
    for (int p = 0; p < 2; ++p)
#pragma unroll
        for (int r = 0; r < 4; ++r) v[p * 4 + r] = __builtin_nontemporal_load((const f32x4*)(j.src + (size_t)(64 * p + 4 * kr + r) * j.ld + 4 * c4));
    asm volatile("" ::: "memory"); __builtin_amdgcn_sched_barrier(0);
}
__device__ __forceinline__ void cv_tile(const CvJob& jc, const f32x4 (&cur)[8], unsigned char* Lb, int tid) {
    const int c4 = tid & 31, kr = tid >> 5;
    if (jc.f8) {
#pragma unroll
        for (int p = 0; p < 2; ++p)
#pragma unroll
            for (int j = 0; j < 4; ++j) { int d = __builtin_amdgcn_cvt_pk_fp8_f32(cur[4 * p + 0][j] * W8_SCALE, cur[4 * p + 1][j] * W8_SCALE, 0, false);
                d = __builtin_amdgcn_cvt_pk_fp8_f32(cur[4 * p + 2][j] * W8_SCALE, cur[4 * p + 3][j] * W8_SCALE, d, true);
                const int n = 4 * c4 + j, unit = 16 * p + kr;
                *(int*)(Lb + n * 128 + ((unit ^ c4) << 2)) = d; }
        __syncthreads();
#pragma unroll
        for (int h = 0; h < 2; ++h) { const int n = 64 * h + (tid >> 3), ch = tid & 7, cx = (n >> 2) & 31; int w[4];
#pragma unroll
          for (int i = 0; i < 4; ++i) w[i] = *(const int*)(Lb + n * 128 + (((4 * ch + i) ^ cx) << 2));
          *(v4u*)((unsigned char*)jc.dst + (size_t)n * DM + 16 * ch) = (v4u){(unsigned)w[0], (unsigned)w[1], (unsigned)w[2], (unsigned)w[3]}; }
    } else {
#pragma unroll
        for (int p = 0; p < 2; ++p)
#pragma unroll
            for (int j = 0; j < 4; ++j) { const unsigned lo = pk2(cur[4 * p + 0][j], cur[4 * p + 1][j]), hi = pk2(cur[4 * p + 2][j], cur[4 * p + 3][j]);
                const int n = 4 * c4 + j, unit = 16 * p + kr, f = (c4 & 15) << 1;
                *(v2u*)(Lb + n * 256 + ((unit ^ f) << 3)) = (v2u){lo, hi}; }
        __syncthreads();
#pragma unroll
        for (int i = 0; i < 4; ++i) { const int n = 32 * i + (tid >> 4), chunk = tid & 15, f = ((n >> 2) & 15) << 1;
            const v4u w = *(const v4u*)(Lb + n * 256 + (((2 * chunk) ^ f) << 3));
            *(v4u*)(jc.dst + (size_t)n * DM + chunk * 8) = w; }
    }
}
constexpr int CV_MOE = CV_GU + CV_DN, CV_BATCH = 8, CV_FINE = 2048, CV_FB = 2;
constexpr int CV_P1_WGS = 108, CV_P1_NB = 3, CV_P1_JOBS = CV_P1_WGS * CV_P1_NB * CV_BATCH;
#ifndef P2_REP_CV
#define P2_REP_CV 1u
#endif
template <int MODE> struct CvIter {
    volatile LAS unsigned* MISC; unsigned* qword; int tid, G, job0, b0, bstride, nbatch, lim, job, nb_par, inb, bdone, bsz;
    __device__ __forceinline__ void setq(int q) { const int f0 = (CV_MOE - job0) - CV_FINE;
        if (q < f0) { job = job0 + q; bsz = CV_BATCH; } else { job = job0 + f0 + CV_FB * ((q - f0) >> 3); bsz = CV_FB; } }
    __device__ __forceinline__ void init(volatile LAS unsigned* MISC_, unsigned* qword_, int tid_, int bid, int G_, int job0_, int b0_, int bstride_, int nbatch_) {
        MISC = MISC_; qword = qword_; tid = tid_; G = G_; job0 = job0_; b0 = b0_; bstride = bstride_; nbatch = nbatch_; nb_par = 0; inb = 0; bdone = 1; bsz = CV_BATCH;
        if (MODE == 1) { lim = job0_ + (CV_MOE - job0_) * (int)P2_REP_CV;
            if (tid == 0) { MISC[6] = __hip_atomic_fetch_add(qword, (unsigned)CV_BATCH, RLX_AGENT); MISC[7] = __hip_atomic_fetch_add(qword, (unsigned)CV_BATCH, RLX_AGENT); }
            __syncthreads();
            setq(__builtin_amdgcn_readfirstlane((int)MISC[6]));
            __syncthreads(); }
        else if (MODE == 2) { lim = CV_MOE; job = nbatch > 0 ? b0 * CV_BATCH : lim; }
        else { lim = CV_JOBS; job = CV_MOE + bid; }
    }
    __device__ __forceinline__ int next() {
        const int cur = job;
        if (cur >= lim) return cur;
        if (MODE == 1) { if (inb < bsz - 1) { job = cur + 1; ++inb; }
                         else { inb = 0; __syncthreads();
                                setq(__builtin_amdgcn_readfirstlane((int)MISC[7 - nb_par]));
                                if (tid == 0) MISC[6 + nb_par] = __hip_atomic_fetch_add(qword, (unsigned)CV_BATCH, RLX_AGENT); nb_par ^= 1; } }
        else if (MODE == 2) { if (inb < CV_BATCH - 1) { job = cur + 1; ++inb; } else { inb = 0; job = bdone < nbatch ? (b0 + bdone * bstride) * CV_BATCH : lim; ++bdone; } }
        else job = cur + G;
        return cur;
    }
};
template <int MODE>
__device__ __forceinline__ void cv_stream(const Args& a, unsigned char* lds, volatile LAS unsigned* MISC, unsigned* qword, int tid, int bid, int G, int job0 = 0, int b0 = 0, int bstride = 0, int nbatch = 0) {
    CvIter<MODE> it; it.init(MISC, qword, tid, bid, G, job0, b0, bstride, nbatch);
    const int lim = it.lim;
#define CVJ(i) (MODE == 1 && P2_REP_CV > 1u ? job0 + ((i) - job0) % (CV_MOE - job0) : (i))
    f32x4 r0[8], r1[8], r2[8], r3[8], r4[8]; CvJob j0, j1, j2, j3, j4; int i0, i1, i2, i3, i4, buf = 0;
#define CV_ISSUE(n) do { i##n = it.next(); j##n = cv_decode(i##n < lim ? CVJ(i##n) : 0, a); cv_load(j##n, r##n, tid); } while (0)
#define CV_DO(n) do { cv_tile(j##n, r##n, lds + buf * 32768, tid); buf ^= 1; } while (0)
    CV_ISSUE(0); CV_ISSUE(1); CV_ISSUE(2); CV_ISSUE(3);
    while (i0 < lim) {
        CV_ISSUE(4); CV_DO(0); if (i1 >= lim) break;
        CV_ISSUE(0); CV_DO(1); if (i2 >= lim) break;
        CV_ISSUE(1); CV_DO(2); if (i3 >= lim) break;
        CV_ISSUE(2); CV_DO(3); if (i4 >= lim) break;
        CV_ISSUE(3); CV_DO(4);
    }
#undef CV_ISSUE
#undef CV_DO
#undef CVJ
    __syncthreads();
}
__device__ __forceinline__ void p0_prologue(const Args& a, unsigned char* lds, int tid, int lane, int wave, int bid, int G) {
    {
        float* wfT = (float*)(lds + 65536);
        f32x4 g1v[8];
#pragma unroll
        for (int j = 0; j < 8; ++j) g1v[j] = ((const f32x4*)a.in[I_G1])[lane + 64 * j];
        const float bfv = a.in[I_BF][lane & 7];
        const int rstep = G * NWAVES; int row = bid * NWAVES + wave;
        f32x4 v[8], vn[8];
#define P0_XROW(r) ((r) < SEQ ? a.in[I_X] + (size_t)(r) * DM : a.in[I_META] + (size_t)((r) - SEQ) * DM)
        { const int lr = row < LTOT ? row : 0; const float* xr = P0_XROW(lr);
#pragma unroll
          for (int j = 0; j < 8; ++j) v[j] = ((const f32x4*)xr)[lane + 64 * j]; }
        asm volatile("" ::: "memory"); __builtin_amdgcn_sched_barrier(0);
#pragma unroll
        for (int i = 0; i < DM / NTHREADS; ++i) { const int k = tid + i * NTHREADS; const f32x4 w0 = *(const f32x4*)(a.in[I_WIN] + (size_t)k * INCOLS + 3072), w1 = *(const f32x4*)(a.in[I_WIN] + (size_t)k * INCOLS + 3076);
#pragma unroll
            for (int hh = 0; hh < 4; ++hh) { wfT[hh * DM + k] = w0[hh]; wfT[(4 + hh) * DM + k] = w1[hh]; } }
        __syncthreads();
        bf16* HN = (bf16*)(a.ws + WS_HN); float* LOGF = (float*)(a.ws + WS_LOGF);
        for (; row < MIN_ROWS; row += rstep) {
            { const int nr = row + rstep, lr = nr < LTOT ? nr : 0; const float* xr = P0_XROW(lr);
#pragma unroll
              for (int j = 0; j < 8; ++j) vn[j] = ((const f32x4*)xr)[lane + 64 * j];
              asm volatile("" ::: "memory"); __builtin_amdgcn_sched_barrier(0); }
            bf16* orow = HN + (size_t)row * DM;
            if (row >= LTOT) {
#pragma unroll
                for (int j = 0; j < 4; ++j) ((v4u*)orow)[lane + 64 * j] = (v4u){0u, 0u, 0u, 0u};
            } else {
                float ss = 0.f;
#pragma unroll
                for (int j = 0; j < 8; ++j) ss += (v[j][0] * v[j][0] + v[j][1] * v[j][1]) + (v[j][2] * v[j][2] + v[j][3] * v[j][3]);
                ss = wave_sum(ss);
                const float rstd = 1.0f / sqrtf(ss * (1.0f / DM) + NORM_EPS);
                float fa[8];
#pragma unroll
                for (int hh = 0; hh < 8; ++hh) fa[hh] = 0.f;
#pragma unroll
                for (int j = 0; j < 8; ++j) { const f32x4 y = v[j] * rstd * g1v[j];
                    ((v2u*)orow)[lane + 64 * j] = (v2u){pk2(y[0], y[1]), pk2(y[2], y[3])};
#pragma unroll
                    for (int hh = 0; hh < 8; ++hh) { const f32x4 wv = *(const f32x4*)(wfT + hh * DM + 256 * j + 4 * lane); fa[hh] += (y[0] * wv[0] + y[1] * wv[1]) + (y[2] * wv[2] + y[3] * wv[3]); } }
#pragma unroll
                for (int hh = 0; hh < 8; ++hh) fa[hh] = wave_sum(fa[hh]);
                if (lane < 8) {
                    float z = fa[0];
#pragma unroll
                    for (int hh = 1; hh < 8; ++hh) z = lane == hh ? fa[hh] : z;
                    z += bfv;
                    const float lf = fminf(z, 0.f) - log1pf(expf(-fabsf(z)));
                    const int pos = row < SEQ ? NMETA + row : row - SEQ;
                    LOGF[pos * 8 + lane] = lf; }
            }
#pragma unroll
            for (int j = 0; j < 8; ++j) v[j] = vn[j];
        }
#undef P0_XROW
        if (bid == 0) {
            bf16* Kb = (bf16*)(a.ws + WS_K); bf16* Vb = (bf16*)(a.ws + WS_V);
            for (int idx = tid; idx < NHEAD * 768; idx += NTHREADS) { const int head = idx / 768, o = idx - head * 768;
                ((v4u*)(Kb + (size_t)head * SKV * HDIM))[o] = (v4u){0u, 0u, 0u, 0u}; ((v4u*)(Vb + (size_t)head * SKV * HDIM))[o] = (v4u){0u, 0u, 0u, 0u}; } }
        __syncthreads();
    }
    cv_stream<0>(a, lds, nullptr, nullptr, tid, bid, G);
}
__device__ __forceinline__ void p1_cumsum(const Args& a, unsigned char* lds, int tid, int lane, int wave, int head) {
    const float* LOGF = (const float*)(a.ws + WS_LOGF); float* CS = (float*)(a.ws + WS_CS) + (size_t)head * SKV;
    float* wsum = (float*)lds;
    float loc[17]; float s = 0.f;
#pragma unroll
    for (int i = 0; i < 17; ++i) { const int p = 17 * tid + i; const float v = p < LTOT ? LOGF[p * 8 + head] : 0.f; s += v; loc[i] = s; }
    float incl = s;
#pragma unroll
    for (int o = 1; o < 64; o <<= 1) { const float n = __shfl_up(incl, o); if (lane >= o) incl += n; }
    if (lane == 63) wsum[wave] = incl;
    __syncthreads();
    float woff = 0.f;
    for (int w = 0; w < wave; ++w) woff += wsum[w];
    const float excl = woff + incl - s;
#pragma unroll
    for (int i = 0; i < 17; ++i) { const int p = 17 * tid + i; if (p < LTOT) { const float cv = (excl + loc[i]) * INV_SCALE; CS[48 + p] = cv; CS[fox::NC_OFF + 48 + p] = -cv; } }
    if (tid < 48) { CS[tid] = __builtin_inff(); CS[fox::NC_OFF + tid] = -__builtin_inff(); }
    __syncthreads();
}

constexpr int N_ATT_ENT = 80, N_ATT_ITEMS = N_ATT_ENT * NHEAD, CONV_TOK = 32, N_CONV_ITEMS = SEQ / CONV_TOK, N_P2_ITEMS = N_ATT_ITEMS + N_CONV_ITEMS;
__device__ const unsigned short ATT_TAB[N_ATT_ENT] = {
    1151, 855, 559, 263, 1055, 1087, 1119, 1150, 791, 823, 527, 1054, 1086, 1118, 1149, 790, 822, 854, 558, 1053, 1085, 1117, 1148, 821, 853, 526, 1052, 1084, 1116, 1147, 789, 852, 557, 262, 1051, 1083,
    1115, 1146, 788, 820, 525, 1050, 1082, 1114, 1145, 787, 819, 851, 556, 1049, 1081, 1113, 1144, 818, 850, 524, 1048, 1080, 1112, 786, 849, 555, 261, 785, 817, 523, 784, 816, 848, 554, 522, 553, 260, 521,
    552, 520, 259, 258, 257, 256};
__device__ __forceinline__ fox::FoxRef att_decode(int L, const Args& a, const unsigned* ctl) {
    const int ent = L >> 3, head = L & 7; const unsigned t = ATT_TAB[ent]; const int qb = t & 31, part = (t >> 5) & 7, np = t >> 8, NT = 4 * qb + 5;
    fox::FoxRef r;
    r.Q = (const fox::bf16*)(a.ws + WS_Q) + ((size_t)head * SEQ + (size_t)qb * 256) * HDIM;
    r.K = (const fox::bf16*)(a.ws + WS_K) + (size_t)head * SKV * HDIM; r.V = (const fox::bf16*)(a.ws + WS_V) + (size_t)head * SKV * HDIM;
    r.C = (const float*)(a.ws + WS_CS) + (size_t)head * SKV;
    r.P0 = 64 + 256 * qb; r.j_lo = part * NT / np; r.j_hi = (part + 1) * NT / np;
    {
        int lane = threadIdx.x & 63; asm volatile("" : "+v"(lane));
        float cv[3]; const float c0 = r.C[r.P0];
#pragma unroll
        for (int rep = 0; rep < 3; ++rep) { const int t = lane + 64 * rep; cv[rep] = r.C[64 * (t < NT ? t : 0) + 63]; }
        const unsigned* nr = ctl + CW_NORM; float q2 = 0.f, k2 = 0.f;
#pragma unroll
        for (int w = 0; w < 4; ++w) { q2 += __uint_as_float(__hip_atomic_load(nr + head * 4 + w, RLX_AGENT)); k2 += __uint_as_float(__hip_atomic_load(nr + (8 + head) * 4 + w, RLX_AGENT)); }
        const float Bnd = sqrtf(q2 * k2) * fox::SCALE * 1.02f, limit = c0 + (2.0f * Bnd + 110.0f) * INV_SCALE;
        int cnt = 0;
#pragma unroll
        for (int rep = 0; rep < 3; ++rep) { const int t = lane + 64 * rep; const bool past = t < NT && cv[rep] > limit; cnt += __popcll(__ballot(past)); }
        const int jmin = __builtin_amdgcn_readfirstlane(cnt);
        const int jl = jmin < r.j_hi - 1 ? jmin : r.j_hi - 1;
        r.dummy = jmin >= r.j_hi ? 1 : 0;
        if (jl > r.j_lo) r.j_lo = jl; }
    const int slot = (head * 32 + qb) * 4 + part; r.O = (fox::bf16*)(a.ws + WS_OPART) + (size_t)slot * 256 * HDIM; r.ML = (float*)(a.ws + WS_ML) + (size_t)slot * 512;
    return r;
}
__device__ __forceinline__ void conv_item(const Args& a, unsigned char* lds, int tid, int it) {
    const int i0 = it * CONV_TOK, pos0 = NMETA + i0;
    const bf16* U = (const bf16*)(a.ws + WS_U); bf16* MIX = (bf16*)(a.ws + WS_MIXED);
#pragma unroll 1
    for (int h = 0; h < 2; ++h) {
        v4u v[8];
#pragma unroll
        for (int i = 0; i < 8; ++i) { const int idx = tid + (h * 8 + i) * NTHREADS, row = idx >> 7, ch = idx & 127, p = pos0 - 30 + row;
            v[i] = (v4u){0u, 0u, 0u, 0u}; if (idx < 62 * 128 && p >= 0) v[i] = *(const v4u*)(U + (size_t)p * 1024 + ch * 8); }
#pragma unroll
        for (int i = 0; i < 8; ++i) { const int idx = tid + (h * 8 + i) * NTHREADS, row = idx >> 7, ch = idx & 127; if (idx < 62 * 128) *(v4u*)(lds + row * 2048 + ch * 16) = v[i]; } }
    const int c = 2 * tid;
    float cw0[CKW], cw1[CKW];
#pragma unroll
    for (int w = 0; w < CKW; ++w) { const float2 t = *(const float2*)(a.in[I_CW] + w * 1024 + c); cw0[w] = t.x; cw1[w] = t.y; }
    const float2 cb = *(const float2*)(a.in[I_CB] + c), gg = *(const float2*)(a.in[I_GNG] + c), gb = *(const float2*)(a.in[I_GNB] + c);
    __syncthreads();
#pragma unroll 1
    for (int tg = 0; tg < CONV_TOK; tg += 4) {
        float a0[4], a1[4];
#pragma unroll
        for (int q = 0; q < 4; ++q) { a0[q] = cb.x; a1[q] = cb.y; }
#pragma unroll
        for (int r = 0; r < CKW + 3; ++r) { const unsigned pk = *(const unsigned*)(lds + (tg + r) * 2048 + c * 2); const float x0 = bf_lo(pk), x1 = bf_hi(pk);
#pragma unroll
            for (int q = 0; q < 4; ++q) { const int w = r - q; if (w >= 0 && w < CKW) { a0[q] += x0 * cw0[w]; a1[q] += x1 * cw1[w]; } } }
        float sm[4], d0[4], d1[4], vr[4];
#pragma unroll
        for (int q = 0; q < 4; ++q) sm[q] = a0[q] + a1[q];
#pragma unroll
        for (int o = 1; o < 64; o <<= 1)
#pragma unroll
            for (int q = 0; q < 4; ++q) sm[q] += __shfl_xor(sm[q], o);
#pragma unroll
        for (int q = 0; q < 4; ++q) { const float mu = sm[q] * (1.0f / 128.0f); d0[q] = a0[q] - mu; d1[q] = a1[q] - mu; vr[q] = d0[q] * d0[q] + d1[q] * d1[q]; }
#pragma unroll
        for (int o = 1; o < 64; o <<= 1)
#pragma unroll
            for (int q = 0; q < 4; ++q) vr[q] += __shfl_xor(vr[q], o);
#pragma unroll
        for (int q = 0; q < 4; ++q) { const float rs = 1.0f / sqrtf(vr[q] * (1.0f / 128.0f) + NORM_EPS);
            const float y0 = d0[q] * rs * gg.x + gb.x, y1 = d1[q] * rs * gg.y + gb.y;
            const float s0 = y0 * __builtin_amdgcn_rcpf(1.0f + __builtin_amdgcn_exp2f(-1.4426950408889634f * y0)), s1 = y1 * __builtin_amdgcn_rcpf(1.0f + __builtin_amdgcn_exp2f(-1.4426950408889634f * y1));
            *(unsigned*)(MIX + (size_t)(i0 + tg + q) * DM + 1024 + c) = pk2(s0, s1); }
    }
    __syncthreads();
}
#ifndef P2_REP_ATT
#define P2_REP_ATT 1u
#endif
#ifndef P2_REP_CONV
#define P2_REP_CONV 1u
#endif
__device__ __forceinline__ unsigned p2_pop(unsigned* ctl, unsigned x, volatile LAS unsigned* MISC) {
    unsigned s = MISC[5];
    while (s < 8u) { const unsigned h = (x + s) & 7u; const unsigned i = __hip_atomic_fetch_add(ctl + CW_QUEUE + 16 * h, 1u, RLX_AGENT); if (i < (unsigned)N_ATT_ENT * P2_REP_ATT) { MISC[5] = s; return (i % (unsigned)N_ATT_ENT) * 8u + h; } ++s; }
    MISC[5] = 8u;
    { const unsigned i = __hip_atomic_fetch_add(ctl + CW_QUEUE + 16 * 8, 1u, RLX_AGENT); return (unsigned)N_ATT_ITEMS + (i < (unsigned)N_CONV_ITEMS * P2_REP_CONV ? i % (unsigned)N_CONV_ITEMS : (unsigned)N_CONV_ITEMS); }
}
__device__ __forceinline__ void p2_attn_conv(const Args& a, unsigned char* lds, volatile LAS unsigned* MISC, unsigned* ctl, int tid, unsigned xcc, int bid, int G) {
    const bool cv_first = ((((bid >> 3) & 15) * 7) & 15) >= 7;
    if (cv_first) cv_stream<1>(a, lds, MISC, ctl + CW_QUEUE + 16 * 9, tid, bid, G, CV_P1_JOBS);
    if (tid == 0) { MISC[5] = 0u; MISC[0] = p2_pop(ctl, xcc, MISC); MISC[1] = p2_pop(ctl, xcc, MISC); }
    __syncthreads();
    int ia = __builtin_amdgcn_readfirstlane((int)MISC[0]), ib = __builtin_amdgcn_readfirstlane((int)MISC[1]);
    __syncthreads();
    if (ia < N_ATT_ITEMS) {
        fox::FoxRef cur = att_decode(ia, a, ctl); fox::FoxSeam S; S.unused = 0;
        bool primed = false;
        for (int k = 0;; ++k) {
            if (tid == 0) MISC[2 + (k & 1)] = p2_pop(ctl, xcc, MISC);
            const bool last = ib >= N_ATT_ITEMS;
            const fox::FoxRef nxt = last ? cur : att_decode(ib, a, ctl);
            if (cur.dummy) {
                if (tid < 256) *(float2*)(cur.ML + tid * 2) = make_float2(-1e30f, 0.f);
                primed = false; __syncthreads();
            } else {
                if (!primed) fox::fox_prime(cur, (char*)lds, S);
                fox::fox_block(cur, nxt, (char*)lds, S);
                primed = true;
            }
            ia = ib; ib = __builtin_amdgcn_readfirstlane((int)MISC[2 + (k & 1)]);
            if (last) break;
            cur = nxt;
        }
    }
    __syncthreads();
    while (ia < N_P2_ITEMS) {
        if (tid == 0) MISC[4] = p2_pop(ctl, xcc, MISC);
        conv_item(a, lds, tid, ia - N_ATT_ITEMS);
        ia = ib; ib = __builtin_amdgcn_readfirstlane((int)MISC[4]);
        __syncthreads();
    }
    if (!cv_first) cv_stream<1>(a, lds, MISC, ctl + CW_QUEUE + 16 * 9, tid, bid, G, CV_P1_JOBS);
}

__device__ __forceinline__ void p3_combine(const Args& a, int lane, int gw, int NGW) {
    const float C2 = 1.4426950408889634f * fox::SCALE;
    const bf16* OP = (const bf16*)(a.ws + WS_OPART); const float* ML = (const float*)(a.ws + WS_ML); bf16* MIX = (bf16*)(a.ws + WS_MIXED);
    float2 ml[4][4], mln[4][4]; unsigned pk[4][4], pkn[4][4];
#define P3_LOAD(MLr, PKr, r0_) do { const int blk_ = (r0_) >> 8, np_ = ((blk_ & 31) >> 3) + 1, slot_ = blk_ * 4;                                               \
        _Pragma("unroll") for (int q = 0; q < 4; ++q) _Pragma("unroll") for (int p = 0; p < 4; ++p) { const int pp_ = p < np_ ? p : np_ - 1, row_ = ((r0_) & 255) + q; \
            MLr[q][p] = *(const float2*)(ML + (size_t)(slot_ + pp_) * 512 + row_ * 2); PKr[q][p] = *(const unsigned*)(OP + ((size_t)(slot_ + pp_) * 256 + row_) * HDIM + 2 * lane); } \
        asm volatile("" ::: "memory"); __builtin_amdgcn_sched_barrier(0); } while (0)
    int r0 = 4 * gw;
    if (r0 < 256 * 256) P3_LOAD(ml, pk, r0);
    for (; r0 < 256 * 256; r0 += 4 * NGW) {
        { const int rn = r0 + 4 * NGW < 256 * 256 ? r0 + 4 * NGW : r0; P3_LOAD(mln, pkn, rn); }
        const int blk = r0 >> 8, head = blk >> 5, qb = blk & 31, np = (qb >> 3) + 1;
#pragma unroll
        for (int q = 0; q < 4; ++q) { const int row = (r0 & 255) + q; float M = -3.0e38f;
#pragma unroll
            for (int p = 0; p < 4; ++p) if (p < np && ml[q][p].y > 0.f) M = fmaxf(M, ml[q][p].x);
            float a0 = 0.f, a1 = 0.f, den = 0.f;
#pragma unroll
            for (int p = 0; p < 4; ++p) if (p < np && ml[q][p].y > 0.f) { const float w = __builtin_amdgcn_exp2f((ml[q][p].x - M) * C2) * ml[q][p].y; a0 += w * bf_lo(pk[q][p]); a1 += w * bf_hi(pk[q][p]); den += w; }
            const float inv = den > 0.f ? 1.0f / den : 0.f;
            *(unsigned*)(MIX + (size_t)(qb * 256 + row) * DM + head * HDIM + 2 * lane) = pk2(a0 * inv, a1 * inv); }
#pragma unroll
        for (int q = 0; q < 4; ++q)
#pragma unroll
            for (int p = 0; p < 4; ++p) { ml[q][p] = mln[q][p]; pk[q][p] = pkn[q][p]; }
    }
#undef P3_LOAD
}

__device__ __forceinline__ void p5_router(const Args& a, unsigned char* lds, unsigned* ctl, int tid, int lane, int wave, int bid, int G) {
    const float* Hh = (const float*)(a.ws + WS_H); unsigned char* HN2 = a.ws + WS_HN2;
    int* TE = (int*)(a.ws + WS_ROUTE); int* TS = TE + SEQ * 4; float* TG = (float*)(TS + SEQ * 4);
    float* part = (float*)lds; float* ssq = part + 8 * 32 * 33; float* logit = ssq + 8 * 32; float* rstd_l = logit + 32 * 33; unsigned* lcnt = (unsigned*)(rstd_l + 32);
    unsigned* CNTW = (unsigned*)(a.ws + WS_ROUTE) + 4 * SEQ * 4;
    const float* g2 = a.in[I_G2]; const float* rw = a.in[I_RW];
    for (int grp = bid; grp < SEQ / 32; grp += G) {
        const int t0 = grp * 32, i = lane & 31, kk = lane >> 5, kb = wave * 256;
        f32x16 acc = {}, accb = {}; float ss = 0.f;
        const float* hrow = Hh + (size_t)(t0 + i) * DM + kb + 4 * kk;
        f32x4 hA[4], gA[4], hB[4], gB[4], hC[4], gC[4]; float rA[4][4], rB[4][4], rC[4][4];
        unsigned rwo = (unsigned)((4 * kk * NEXP + i) * 4), g2o = (unsigned)(4 * kk * 4); asm volatile("" : "+v"(rwo), "+v"(g2o));
        const char* rwb = (const char*)(rw + (size_t)kb * NEXP); const char* g2b = (const char*)(g2 + kb);
#define P5_LOAD(H, Gv, R, c0) do { _Pragma("unroll") for (int c = 0; c < 4; ++c) {                                                                             \
            H[c] = *(const f32x4*)(hrow + 8 * ((c0) + c)); Gv[c] = *(const f32x4*)(g2b + g2o + 32 * ((c0) + c));                                              \
            _Pragma("unroll") for (int q = 0; q < 4; ++q) R[c][q] = *(const float*)(rwb + rwo + (8 * ((c0) + c) + q) * (NEXP * 4)); }                          \
        asm volatile("" ::: "memory"); __builtin_amdgcn_sched_barrier(0); } while (0)
#define P5_MMA(H, Gv, R) do { _Pragma("unroll") for (int c = 0; c < 4; ++c) { _Pragma("unroll") for (int q = 0; q < 4; q += 2) {                               \
            acc = __builtin_amdgcn_mfma_f32_32x32x2f32(H[c][q], R[c][q] * Gv[c][q], acc, 0, 0, 0);                                                              \
            accb = __builtin_amdgcn_mfma_f32_32x32x2f32(H[c][q + 1], R[c][q + 1] * Gv[c][q + 1], accb, 0, 0, 0);                                                \
            ss += H[c][q] * H[c][q] + H[c][q + 1] * H[c][q + 1]; } } __builtin_amdgcn_sched_barrier(0); } while (0)
        P5_LOAD(hA, gA, rA, 0); P5_LOAD(hB, gB, rB, 4); P5_LOAD(hC, gC, rC, 8);
        P5_MMA(hA, gA, rA); P5_LOAD(hA, gA, rA, 12);
        P5_MMA(hB, gB, rB); P5_LOAD(hB, gB, rB, 16);
        P5_MMA(hC, gC, rC); P5_LOAD(hC, gC, rC, 20);
        P5_MMA(hA, gA, rA); P5_LOAD(hA, gA, rA, 24);
        P5_MMA(hB, gB, rB); P5_LOAD(hB, gB, rB, 28);
        P5_MMA(hC, gC, rC); P5_MMA(hA, gA, rA); P5_MMA(hB, gB, rB);
#undef P5_LOAD
#undef P5_MMA
#pragma unroll
        for (int r = 0; r < 16; ++r) acc[r] += accb[r];
        const float rb0 = a.in[I_RB][2 * (tid & 15)], rb1 = a.in[I_RB][2 * (tid & 15) + 1];
        f32x4 gv[8], hv[4][8];
#pragma unroll
        for (int j = 0; j < 8; ++j) gv[j] = ((const f32x4*)g2)[lane + 64 * j];
#pragma unroll
        for (int r = 0; r < 4; ++r) { const float* hr = Hh + (size_t)(t0 + wave * 4 + r) * DM;
#pragma unroll
            for (int j = 0; j < 8; ++j) hv[r][j] = ((const f32x4*)hr)[lane + 64 * j]; }
        asm volatile("" ::: "memory"); __builtin_amdgcn_sched_barrier(0);
        ss += __shfl_xor(ss, 32);
        if (kk == 0) ssq[wave * 32 + i] = ss;
        if (tid < NEXP) lcnt[tid] = 0u;
#pragma unroll
        for (int r = 0; r < 16; ++r) { const int row = (r & 3) + 8 * (r >> 2) + 4 * kk; part[(wave * 32 + row) * 33 + i] = acc[r]; }
        __syncthreads();
        { const int tk = tid >> 4, e0 = 2 * (tid & 15); float sq = 0.f;
#pragma unroll
          for (int w = 0; w < 8; ++w) sq += ssq[w * 32 + tk];
          const float rs = 1.0f / sqrtf(sq * (1.0f / DM) + NORM_EPS);
          if ((tid & 15) == 0) rstd_l[tk] = rs;
#pragma unroll
          for (int d = 0; d < 2; ++d) { float s = 0.f;
#pragma unroll
              for (int w = 0; w < 8; ++w) s += part[(w * 32 + tk) * 33 + e0 + d];
              logit[tk * 33 + e0 + d] = s * rs + (d ? rb1 : rb0); } }
        __syncthreads();
        if (tid < 32) {
            unsigned taken = 0u; float tv[4]; int ti[4];
#pragma unroll
            for (int k = 0; k < 4; ++k) { float best = -3.0e38f; int bi = 0;
                for (int e = 0; e < NEXP; ++e) { const float v = logit[tid * 33 + e]; if (!((taken >> e) & 1u) && v > best) { best = v; bi = e; } }
                taken |= 1u << bi; tv[k] = best; ti[k] = bi; }
            float w[4], sum = 0.f;
#pragma unroll
            for (int k = 0; k < 4; ++k) { w[k] = expf(tv[k] - tv[0]); sum += w[k]; }
            const float inv = 1.0f / sum;
#pragma unroll
            for (int k = 0; k < 4; ++k) { const unsigned lr = atomicAdd(&lcnt[ti[k]], 1u);
                TE[(t0 + tid) * 4 + k] = ti[k]; TS[(t0 + tid) * 4 + k] = (int)lr; TG[(t0 + tid) * 4 + k] = w[k] * inv; }
        }
        __syncthreads();
        if (tid < NEXP) CNTW[grp * NEXP + tid] = lcnt[tid];
        {
#pragma unroll
            for (int r = 0; r < 4; ++r) { const int tk = wave * 4 + r; const float rs = rstd_l[tk]; unsigned char* orow = HN2 + (size_t)(t0 + tk) * DM;
#pragma unroll
                for (int j = 0; j < 8; ++j) { const f32x4 y = hv[r][j] * rs * gv[j];
                    int d = __builtin_amdgcn_cvt_pk_fp8_f32(y[0], y[1], 0, false); d = __builtin_amdgcn_cvt_pk_fp8_f32(y[2], y[3], d, true);
                    ((int*)orow)[lane + 64 * j] = d; } } }
        __syncthreads();
    }
}

__device__ __forceinline__ void p6_gather(const Args& a, unsigned char* lds, unsigned* ctl, int tid, int lane, int wave, int bid, int G) {
    const unsigned* CNTW = (const unsigned*)(a.ws + WS_ROUTE) + 4 * SEQ * 4;
    int* psum = (int*)lds;
    int* tst = psum + 16 * NEXP;
    int* gbase = tst + NEXP;
    const int* TE = (const int*)(a.ws + WS_ROUTE); const int* TS = TE + SEQ * 4; int* TR = (int*)(a.ws + WS_ROUTE) + 3 * SEQ * 4;
    const unsigned char* HN2 = a.ws + WS_HN2; unsigned char* XG = a.ws + WS_XG;
    const int g0 = bid < SEQ / 32 ? bid : 0;
    v4u v[4][2]; int te[4][4], ts[4][4]; int c2[15];
#define P6_LOADG(grp_) do { _Pragma("unroll") for (int r = 0; r < 4; ++r) { const int t = (grp_) * 32 + wave * 4 + r;                                   \
            _Pragma("unroll") for (int j = 0; j < 2; ++j) v[r][j] = ((const v4u*)(HN2 + (size_t)t * DM))[lane + 64 * j];                                \
            _Pragma("unroll") for (int k = 0; k < 4; ++k) { te[r][k] = TE[t * 4 + k]; ts[r][k] = TS[t * 4 + k]; } }                                     \
        _Pragma("unroll") for (int u = 0; u < 15; ++u) { const int w = ((grp_) >> 4) * 16 + u; c2[u] = (int)CNTW[(w < (grp_) ? w : 0) * NEXP + (tid & 31)]; } \
        asm volatile("" ::: "memory"); __builtin_amdgcn_sched_barrier(0); } while (0)
    P6_LOADG(g0);
    { const int e = tid & 31, p = tid >> 5; int s = 0;
#pragma unroll
      for (int w = 0; w < 16; ++w) s += (int)CNTW[(p * 16 + w) * NEXP + e];
      psum[p * NEXP + e] = s; }
    __syncthreads();
    if (tid < 64) {
        int c = 0;
        if (tid < NEXP) {
#pragma unroll
            for (int p = 0; p < 16; ++p) c += psum[p * NEXP + tid]; }
        const int nt = (c + 255) >> 8; int incl = nt;
#pragma unroll
        for (int o = 1; o < 32; o <<= 1) { const int n = __shfl_up(incl, o); if ((tid & 63) >= o) incl += n; }
        const int s0 = incl - nt;
        if (tid < NEXP) { tst[tid] = s0;
            if (bid == 0) { for (int i = 0; i < nt; ++i) ctl[CW_TEXP + s0 + i] = (unsigned)tid; if (tid == NEXP - 1) ctl[CW_NT] = (unsigned)incl; } }
    }
    __syncthreads();
    for (int grp = bid; grp < SEQ / 32; grp += G) {
        if (grp != g0) { P6_LOADG(grp); }
        if (tid < NEXP) { int s = 0; const int pp = grp >> 4; for (int p = 0; p < pp; ++p) s += psum[p * NEXP + tid];
#pragma unroll
            for (int u = 0; u < 15; ++u) s += (pp * 16 + u < grp) ? c2[u] : 0;
            gbase[tid] = tst[tid] * 256 + s; }
        __syncthreads();
        {
#pragma unroll
            for (int r = 0; r < 4; ++r) { const int t = grp * 32 + wave * 4 + r;
#pragma unroll
                for (int k = 0; k < 4; ++k) { const int row = gbase[te[r][k]] + ts[r][k];
                    if (lane == 0) TR[t * 4 + k] = row;
#pragma unroll
                    for (int j = 0; j < 2; ++j) ((v4u*)(XG + (size_t)row * DM))[lane + 64 * j] = v[r][j]; } } }
        __syncthreads();
    }
#undef P6_LOADG
}

__device__ __forceinline__ void p9_final(const Args& a, int lane, int gw, int NGW) {
    const float* Hh = (const float*)(a.ws + WS_H); const unsigned char* Y = a.ws + WS_Y;
    const float* TG = (const float*)(a.ws + WS_ROUTE) + 2 * SEQ * 4; const int* TR = (const int*)(a.ws + WS_ROUTE) + 3 * SEQ * 4;
    typedef float f32x2_ __attribute__((ext_vector_type(2)));
    f32x4 gfv[8];
#pragma unroll
    for (int j = 0; j < 8; ++j) gfv[j] = ((const f32x4*)a.in[I_GF])[lane + 64 * j];
    f32x4 tg[2], tgn[2]; int tr[2][4], trn[2][4];
    int t0 = 2 * gw;
    { const int tl = t0 < SEQ ? t0 : 0;
#pragma unroll
      for (int q = 0; q < 2; ++q) { tg[q] = *(const f32x4*)(TG + (tl + q) * 4);
#pragma unroll
          for (int k = 0; k < 4; ++k) tr[q][k] = TR[(tl + q) * 4 + k]; } }
    for (; t0 < SEQ; t0 += 2 * NGW) {
        f32x4 v[2][8];
        { const int tn = t0 + 2 * NGW < SEQ ? t0 + 2 * NGW : t0;
#pragma unroll
          for (int q = 0; q < 2; ++q) { tgn[q] = *(const f32x4*)(TG + (tn + q) * 4);
#pragma unroll
              for (int k = 0; k < 4; ++k) trn[q][k] = TR[(tn + q) * 4 + k]; } }
#pragma unroll
        for (int q = 0; q < 2; ++q) {
#pragma unroll
            for (int j = 0; j < 8; ++j) v[q][j] = ((const f32x4*)(Hh + (size_t)(t0 + q) * DM))[lane + 64 * j]; }
        int pk[2][4][8];
#pragma unroll
        for (int q = 0; q < 2; ++q)
#pragma unroll
            for (int k = 0; k < 4; ++k) { const unsigned char* yr = Y + (size_t)tr[q][k] * DM;
#pragma unroll
                for (int j = 0; j < 8; ++j) pk[q][k][j] = ((const int*)yr)[lane + 64 * j]; }
        asm volatile("" ::: "memory"); __builtin_amdgcn_sched_barrier(0);
#pragma unroll
        for (int q = 0; q < 2; ++q) {
#pragma unroll
            for (int k = 0; k < 4; ++k) { const float g = tg[q][k];
#pragma unroll
                for (int j = 0; j < 8; ++j) { const f32x2_ lo = __builtin_amdgcn_cvt_pk_f32_fp8(pk[q][k][j], false), hi = __builtin_amdgcn_cvt_pk_f32_fp8(pk[q][k][j], true);
                    v[q][j][0] += g * lo[0]; v[q][j][1] += g * lo[1]; v[q][j][2] += g * hi[0]; v[q][j][3] += g * hi[1]; } }
            float ss = 0.f;
#pragma unroll
            for (int j = 0; j < 8; ++j) ss += (v[q][j][0] * v[q][j][0] + v[q][j][1] * v[q][j][1]) + (v[q][j][2] * v[q][j][2] + v[q][j][3] * v[q][j][3]);
            ss = wave_sum(ss);
            const float rstd = 1.0f / sqrtf(ss * (1.0f / DM) + NORM_EPS);
#pragma unroll
            for (int j = 0; j < 8; ++j) ((f32x4*)(a.out + (size_t)(t0 + q) * DM))[lane + 64 * j] = v[q][j] * rstd * gfv[j]; }
#pragma unroll
        for (int q = 0; q < 2; ++q) {
#pragma unroll
            for (int k = 0; k < 4; ++k) { tg[q][k] = __uint_as_float(__builtin_amdgcn_readfirstlane(__float_as_uint(tgn[q][k]))); tr[q][k] = __builtin_amdgcn_readfirstlane(trn[q][k]); } }
    }
}

#ifndef MK_PER_PHASE
#define MK_PER_PHASE 0
#endif
constexpr int N_PHASES = 10;
#ifndef PROBE_TS
#define PROBE_TS 0
#endif

#ifndef PROBE_DBL
#define PROBE_DBL 0
#endif
template <int LO, int HI> __global__ void __launch_bounds__(NTHREADS, 2) hymba_fwd(Args a_in) {
    extern __shared__ __attribute__((aligned(16))) unsigned char lds[];
    const int tid0 = threadIdx.x, bid = blockIdx.x, G = gridDim.x;
    volatile LAS unsigned* MISC = (volatile LAS unsigned*)((LAS unsigned char*)lds + MISC_OFF);
    unsigned* ctl = (unsigned*)(a_in.ws + WS_CTL);
#if defined(__HIP_DEVICE_COMPILE__)
#define PHASE_ARGS() const __attribute__((address_space(4))) Args* ap_ = (const __attribute__((address_space(4))) Args*)__builtin_amdgcn_kernarg_segment_ptr(); asm volatile("" : "+s"(ap_)); const Args a = *ap_; int tid = threadIdx.x; asm volatile("" : "+v"(tid)); const int lane = tid & 63, wave = __builtin_amdgcn_readfirstlane(tid >> 6), gw = bid * NWAVES + wave, NGW = G * NWAVES; (void)lane; (void)gw; (void)NGW
#else
#define PHASE_ARGS() const Args& a = a_in; const int tid = threadIdx.x, lane = tid & 63, wave = tid >> 6, gw = bid * NWAVES + wave, NGW = G * NWAVES; (void)lane; (void)gw; (void)NGW
#endif
    for (int u = tid0; u < (LDS_BYTES - MISC_OFF) / 4; u += NTHREADS) MISC[u] = 0u;
    __syncthreads();
    if (PROBE_TS && bid == 0 && tid0 == 0) ((unsigned long long*)(ctl + 16384))[0] = wall_clock64();
    XcdBarrier bar; bar.bar = ctl + CW_BAR; bar.x = 0; bar.st = nullptr;
    if (HI - LO > 1) bar = xcd_barrier_post(ctl + CW_BAR, MISC + 8);
#ifndef PH_MASK
#define PH_MASK 0x3ff
#endif
#define IN(k) ((((PH_MASK) >> (k)) & 1) && LO <= (k) && (k) < HI)
#define SEAM(k) do { if (IN(k) && IN((k) + 1)) { xcd_barrier(bar); if (PROBE_DBL & 1024) xcd_barrier(bar); if (PROBE_TS && bid == 0 && threadIdx.x == 0) ((unsigned long long*)(ctl + 16384))[(k) + 1] = wall_clock64(); } } while (0)

    if (IN(0)) { PHASE_ARGS(); p0_prologue(a, lds, tid, lane, wave, bid, G); if (PROBE_DBL & 1) { __syncthreads(); p0_prologue(a, lds, tid, lane, wave, bid, G); } } SEAM(0);
    if (IN(1)) { PHASE_ARGS();
        if (bid >= G - NHEAD) p1_cumsum(a, lds, tid, lane, wave, bid - (G - NHEAD));
        pg8::Gemm g{(const pg8::bf16_t*)(a.ws + WS_HN), (const pg8::bf16_t*)(a.ws + WS_WIN), MIN_ROWS, NIN, DM}; pg8::StaticOrder S; S.init(MIN_ROWS, NIN, G, bid);
        pg8::EpiIn E{(pg8::bf16_t*)(a.ws + WS_Q), WS_K - WS_Q, WS_V - WS_Q, (pg8::bf16_t*)(a.ws + WS_U), a.in[I_BGLU], ctl + CW_NORM};
        pg8::gemm_phase<pg8::EpiIn, pg8::StaticOrder, true, true>((PG8_LAS unsigned char*)lds, g, S, E);
        if (PROBE_DBL & 2) pg8::gemm_phase<pg8::EpiIn, pg8::StaticOrder, true, true>((PG8_LAS unsigned char*)lds, g, S, E);
        if (G == 256 && bid >= G - CV_P1_WGS) { __syncthreads(); cv_stream<2>(a, lds, nullptr, nullptr, tid, bid, G, 0, bid - (G - CV_P1_WGS), CV_P1_WGS, CV_P1_NB); }
        else if (G != 256 && bid == 0) { __syncthreads(); cv_stream<2>(a, lds, nullptr, nullptr, tid, bid, G, 0, 0, 1, CV_P1_WGS * CV_P1_NB); }
    } SEAM(1);
    if (IN(2)) { PHASE_ARGS(); p2_attn_conv(a, lds, MISC, ctl, tid, xb_xcc_id(), bid, G); } SEAM(2);
    if (IN(3)) { PHASE_ARGS(); p3_combine(a, lane, gw, NGW); if (PROBE_DBL & 8) p3_combine(a, lane, gw, NGW); } SEAM(3);
    if (IN(4)) { PHASE_ARGS();
        pg8::Gemm g{(const pg8::bf16_t*)(a.ws + WS_MIXED), (const pg8::bf16_t*)(a.ws + WS_WOUT), SEQ, DM, DM}; pg8::StaticOrder S; S.init(SEQ, DM, G, bid);
        pg8::EpiOut E{a.in[I_X], (float*)(a.ws + WS_H)};
        pg8::gemm_phase<pg8::EpiOut, pg8::StaticOrder, true, true>((PG8_LAS unsigned char*)lds, g, S, E);
        if (PROBE_DBL & 16) pg8::gemm_phase<pg8::EpiOut, pg8::StaticOrder, true, true>((PG8_LAS unsigned char*)lds, g, S, E);
    } SEAM(4);
    if (IN(5)) { PHASE_ARGS(); p5_router(a, lds, ctl, tid, lane, wave, bid, G); if (PROBE_DBL & 32) p5_router(a, lds, ctl, tid, lane, wave, bid, G); } SEAM(5);
    if (IN(6)) { PHASE_ARGS(); p6_gather(a, lds, ctl, tid, lane, wave, bid, G); if (PROBE_DBL & 64) p6_gather(a, lds, ctl, tid, lane, wave, bid, G); } SEAM(6);
    if (IN(7)) { PHASE_ARGS();
        const int T = (int)__hip_atomic_load(ctl + CW_NT, RLX_AGENT);
        pg8::Gemm g{(const pg8::bf16_t*)(a.ws + WS_XG), (const pg8::bf16_t*)(a.ws + WS_WGU), PROWS, NEXP * 4096, DM  }; for (int i = tid; i < MAXT; i += NTHREADS) MISC[64 + i] = __hip_atomic_load(ctl + CW_TEXP + i, RLX_AGENT);
        __syncthreads();
        pg8::GroupedOrder S; S.init((const volatile PG8_LAS int*)(MISC + 64), T, 16, G, bid);
        pg8::EpiGU E{a.ws + WS_ACT, a.in[I_BGU], W8_INV};
        pg8::gemm_phase<pg8::EpiGU, pg8::GroupedOrder, true, true, true>((PG8_LAS unsigned char*)lds, g, S, E);
        if (PROBE_DBL & 128) pg8::gemm_phase<pg8::EpiGU, pg8::GroupedOrder, true, true, true>((PG8_LAS unsigned char*)lds, g, S, E);
    } SEAM(7);
    if (IN(8)) { PHASE_ARGS();
        const int T = (int)__hip_atomic_load(ctl + CW_NT, RLX_AGENT);
        pg8::Gemm g{(const pg8::bf16_t*)(a.ws + WS_ACT), (const pg8::bf16_t*)(a.ws + WS_WDN), PROWS, NEXP * DM, DM}; for (int i = tid; i < MAXT; i += NTHREADS) MISC[64 + i] = __hip_atomic_load(ctl + CW_TEXP + i, RLX_AGENT);
        __syncthreads();
        pg8::GroupedOrder S; S.init((const volatile PG8_LAS int*)(MISC + 64), T, 8, G, bid);
        pg8::EpiDN E{a.ws + WS_Y, a.in[I_BDN], W8_INV};
        pg8::gemm_phase<pg8::EpiDN, pg8::GroupedOrder, true, true, true>((PG8_LAS unsigned char*)lds, g, S, E);
        if (PROBE_DBL & 256) pg8::gemm_phase<pg8::EpiDN, pg8::GroupedOrder, true, true, true>((PG8_LAS unsigned char*)lds, g, S, E);
    } SEAM(8);
    if (IN(9)) { PHASE_ARGS(); p9_final(a, lane, gw, NGW); if (PROBE_DBL & 512) p9_final(a, lane, gw, NGW);
        if (PROBE_TS) {
            const unsigned long long* ts = (const unsigned long long*)(ctl + 16384);
            const int pa = (PROBE_TS >> 4) & 15, pb = PROBE_TS & 15;
            const float ta = (float)(ts[pa + 1] - ts[pa]) * 0.01f, tb = (float)(ts[pb + 1] - ts[pb]) * 0.01f;
            float M = ta * 0.01f; M = M < 1.0f ? 1.0f : (M > 9.9f ? 9.9f : M); int Ee = 2 + (int)(tb * 0.05f + 0.5f); Ee = Ee > 30 ? 30 : Ee;
            float val = M; for (int i = 0; i < Ee; ++i) val *= 10.0f;
            const float cst = sqrtf(val);
            __syncthreads();
            for (size_t i = (size_t)bid * NTHREADS + tid; i < (size_t)SEQ * DM; i += (size_t)G * NTHREADS) a.out[i] = cst; } }
#undef IN
#undef SEAM
}

template <int LO, int HI> static bool launch_range(const Args& a, int grid, hipStream_t stream) {
    static bool attr = false;
    if (!attr) { attr = true; if (hipFuncSetAttribute((const void*)hymba_fwd<LO, HI>, hipFuncAttributeMaxDynamicSharedMemorySize, LDS_BYTES) != hipSuccess) { fprintf(stderr, "kernel_launch: hipFuncSetAttribute failed\n"); return false; } }
    hipLaunchKernelGGL((hymba_fwd<LO, HI>), dim3(grid), dim3(NTHREADS), LDS_BYTES, stream, a);
    return hipPeekAtLastError() == hipSuccess;
}
extern "C" void kernel_launch(void* const* d_in, const int* in_sizes, int n_in, void* d_out, int out_size, void* d_ws, size_t ws_size, hipStream_t stream) {
    static int grid = 0;
    if (grid == 0) {
        if (n_in != 19 || out_size != SEQ * DM || ws_size < WS_END) { fprintf(stderr, "kernel_launch: unexpected shapes (n_in %d out %d ws %zu)\n", n_in, out_size, ws_size); grid = -1; return; }
        int dev = 0, cus = 0;
        if (hipGetDevice(&dev) != hipSuccess || hipDeviceGetAttribute(&cus, hipDeviceAttributeMultiprocessorCount, dev) != hipSuccess) { grid = -1; return; }
        grid = cus;
    }
    if (grid < 0) return;
    (void)in_sizes;
    if (hipMemsetAsync((char*)d_ws + WS_CTL, 0, CTL_ZERO_BYTES, stream) != hipSuccess) return;
    Args a{};
    for (int i = 0; i < 19; ++i) a.in[i] = (const float*)d_in[i];
    a.out = (float*)d_out; a.ws = (unsigned char*)d_ws;
#if MK_PER_PHASE
    launch_range<0, 1>(a, grid, stream); launch_range<1, 2>(a, grid, stream); launch_range<2, 3>(a, grid, stream); launch_range<3, 4>(a, grid, stream); launch_range<4, 5>(a, grid, stream);
    launch_range<5, 6>(a, grid, stream); launch_range<6, 7>(a, grid, stream); launch_range<7, 8>(a, grid, stream); launch_range<8, 9>(a, grid, stream); launch_range<9, 10>(a, grid, stream);
#else
    launch_range<0, N_PHASES>(a, grid, stream);
#endif
}
```

```cpp
#include <hip/hip_runtime.h>
#include <hip/hip_bf16.h>
#include <cstdio>
#include <cstdint>
namespace pg8 {
#define PG8_LAS __attribute__((address_space(3)))
typedef unsigned short bf16_t;
typedef short bf16x8 __attribute__((ext_vector_type(8)));
typedef float f32x4 __attribute__((ext_vector_type(4)));
typedef unsigned u32x4 __attribute__((ext_vector_type(4)));
constexpr int BM = 256, BK = 64, HALF = 128, HTB = HALF * BK * 2  , STAGE_BYTES = 8 * HTB, NXCD = 8, WGM = 8;

__host__ __device__ __forceinline__ int lds_byte(int r, int c) { const int st = (r >> 4) * 2 + (c >> 5), rr = r & 15, cc = c & 31, ob = rr * 64 + cc * 2; return st * 1024 + (ob ^ (((ob >> 9) & 1) << 5)); }
__host__ __device__ __forceinline__ void stage_rc(int b, int& R, int& C) { const int st = b / 1024, sb = b % 1024, swz = sb ^ (((sb >> 9) & 1) << 5); R = (st >> 1) * 16 + swz / 64; C = (st & 1) * 32 + (swz % 64) / 2; }
__host__ __device__ __forceinline__ int perm32(int rho) { const int n = rho >> 4, i = rho & 15; return 8 * (i >> 2) + 4 * n + (i & 3); }

struct Unit { int pm, pn; };
struct Gemm { const bf16_t* A; const bf16_t* Bt; int M, N, K; };

struct StaticOrder {
    int nM, nN, nwg, G, c;
    __host__ __device__ void init(int M, int N, int G_, int c_) { nM = M / BM; nN = N / BM; nwg = nM * nN; G = G_; c = c_; }
    __host__ __device__ bool next(int i, Unit& u) const {
        const long L = (long)i * G + c; if (L >= nwg) return false;
        int wgid = (int)L; { const int q = nwg / NXCD, r = nwg % NXCD, xcd = wgid % NXCD, off = wgid / NXCD; wgid = (xcd < r ? xcd * (q + 1) : r * (q + 1) + (xcd - r) * q) + off; }
        const int nig = WGM * nN, gid = wgid / nig, fm = gid * WGM, gsz = (nM - fm) < WGM ? (nM - fm) : WGM;
        u.pm = fm + ((wgid % nig) % gsz); u.pn = (wgid % nig) / gsz; return true;
    }
    __device__ __forceinline__ void a_ready(const Unit&) const {}
    __device__ __forceinline__ void done(const Unit&) const {}
};

__device__ __forceinline__ unsigned cvt_pk_bf16(float lo, float hi) { unsigned r; asm volatile("v_cvt_pk_bf16_f32 %0, %1, %2" : "=v"(r) : "v"(lo), "v"(hi)); return r; }
typedef float f32x2 __attribute__((ext_vector_type(2)));
__device__ __forceinline__ f32x2 gelu_pk(f32x2 v) {
    const f32x2 av = __builtin_elementwise_abs(v), d = av * 0.2316418882f + 1.0f;
    f32x2 t; t.x = __builtin_amdgcn_rcpf(d.x); t.y = __builtin_amdgcn_rcpf(d.y);
    f32x2 q = t * 0.5307027145f + (-0.7265760135f); q = q * t + 0.7107068705f; q = q * t + (-0.142248368f); q = q * t + 0.127414796f; q = q * t;
    const f32x2 s = (v * v) * (-0.72134752044f);
    f32x2 e; e.x = __builtin_amdgcn_exp2f(s.x); e.y = __builtin_amdgcn_exp2f(s.y);
    const f32x2 m = v * (q * e), r = v - m;
    f32x2 o; o.x = v.x < 0.f ? m.x : r.x; o.y = v.y < 0.f ? m.y : r.y; return o;
}


__device__ __forceinline__ float sigmoidf_fast(float x) { return __builtin_amdgcn_rcpf(1.0f + __builtin_amdgcn_exp2f(-1.4426950408889634f * x)); }
__device__ __forceinline__ u32x4 pack8_bf16(const f32x4 v0, const f32x4 v1) { u32x4 w; w.x = cvt_pk_bf16(v0[0], v0[1]); w.y = cvt_pk_bf16(v0[2], v0[3]); w.z = cvt_pk_bf16(v1[0], v1[1]); w.w = cvt_pk_bf16(v1[2], v1[3]); return w; }

struct EpiIn {
    static constexpr bool PERM = true, AFTER_DRAIN = false;
    bf16_t* Q; size_t koff, voff; bf16_t* U; const float* bglu; unsigned* nrm;
    __device__ __forceinline__ void operator()(const f32x4 (&acc)[2][2][4][2], const Unit& u, int wr, int wc, int fr, int fq) const {
        const int pn = u.pn, pm = u.pm, dcol = wc * 32 + 8 * fq;
        const int c0 = 128 * ((pn < 12 ? 12 : pn) - 12) + dcol;
        f32x4 ba[2], bg[2];
#pragma unroll
        for (int n = 0; n < 2; ++n) { ba[n] = *(const f32x4*)(bglu + c0 + 4 * n); bg[n] = *(const f32x4*)(bglu + 1024 + c0 + 4 * n); }
        asm volatile("" : "+v"(ba[0]), "+v"(ba[1]), "+v"(bg[0]), "+v"(bg[1]));
        if (pn < 12) {
            const int which = pn >> 2;
            if (which == 0 && pm >= 32) return;
            const size_t boff = which == 0 ? 0 : (which == 1 ? koff : voff);
            bf16_t* base = (bf16_t*)((unsigned char*)Q + boff);
            const int rph = which == 0 ? 8192 : 8256;
            float nmax[2] = {0.f, 0.f};
#pragma unroll
            for (int ai = 0; ai < 2; ++ai)
#pragma unroll
                for (int m = 0; m < 4; ++m) {
                    const int rl = ai * HALF + wr * 64 + m * 16 + fr;
                    const bool ok = pm < 32 || rl < 16;
                    const int idx = pm < 32 ? pm * BM + rl + (which ? 64 : 0) : 48 + rl;
#pragma unroll
                    for (int bj = 0; bj < 2; ++bj) { const int head = 2 * (pn & 3) + bj;
                        if (ok) *(u32x4*)(base + ((size_t)head * rph + idx) * 128 + dcol) = pack8_bf16(acc[ai][bj][m][0], acc[ai][bj][m][1]);
                        if (which < 2) { const f32x4 x0 = acc[ai][bj][m][0], x1 = acc[ai][bj][m][1];
                            float ss = (x0[0] * x0[0] + x0[1] * x0[1]) + (x0[2] * x0[2] + x0[3] * x0[3]) + (x1[0] * x1[0] + x1[1] * x1[1]) + (x1[2] * x1[2] + x1[3] * x1[3]);
                            ss += __shfl_xor(ss, 16); ss += __shfl_xor(ss, 32);
                            nmax[bj] = fmaxf(nmax[bj], ok ? ss : 0.f); } }
                }
            if (which < 2) {
#pragma unroll
                for (int bj = 0; bj < 2; ++bj) { float v = nmax[bj];
#pragma unroll
                    for (int o = 1; o < 16; o <<= 1) v = fmaxf(v, __shfl_xor(v, o));
                    if (fr == 0 && fq == 0) __hip_atomic_fetch_max(nrm + (which * 8 + 2 * (pn & 3) + bj) * 4 + wc, __float_as_uint(v), __ATOMIC_RELAXED, __HIP_MEMORY_SCOPE_AGENT); } }
        } else {
#pragma unroll
            for (int ai = 0; ai < 2; ++ai)
#pragma unroll
                for (int m = 0; m < 4; ++m) {
                    const int rl = ai * HALF + wr * 64 + m * 16 + fr;
                    const bool ok = pm < 32 || rl < 16;
                    const int pos = pm < 32 ? 16 + pm * BM + rl : rl;
                    f32x4 o[2];
#pragma unroll
                    for (int n = 0; n < 2; ++n) { const f32x4 a = acc[ai][0][m][n] + ba[n], g = acc[ai][1][m][n] + bg[n];
#pragma unroll
                        for (int j = 0; j < 4; ++j) o[n][j] = a[j] * sigmoidf_fast(g[j]); }
                    if (ok) *(u32x4*)(U + (size_t)pos * 1024 + c0) = pack8_bf16(o[0], o[1]);
                }
        }
    }
};
struct EpiOut {
    static constexpr bool PERM = false, AFTER_DRAIN = false;
    const float* X; float* Hh;
    __device__ __forceinline__ void operator()(const f32x4 (&acc)[2][2][4][2], const Unit& u, int wr, int wc, int fr, int fq) const {
        const int row0 = u.pm * BM + wr * 64 + fr, col0 = u.pn * BM + wc * 32 + 4 * fq;
#pragma unroll
        for (int ai = 0; ai < 2; ++ai)
#pragma unroll
            for (int m = 0; m < 4; ++m) { const size_t off = (size_t)(row0 + ai * HALF + m * 16) * 2048 + col0;
#pragma unroll
                for (int bj = 0; bj < 2; ++bj)
#pragma unroll
                    for (int n = 0; n < 2; ++n) { const f32x4 xv = *(const f32x4*)(X + off + bj * HALF + n * 16); *(f32x4*)(Hh + off + bj * HALF + n * 16) = xv + acc[ai][bj][m][n]; }
                asm volatile("" ::: "memory"); }
    }
};
struct EpiGU {
    static constexpr bool PERM = true, AFTER_DRAIN = false;
    unsigned char* ACT; const float* bgu; float wscale;
    __device__ __forceinline__ void operator()(const f32x4 (&acc)[2][2][4][2], const Unit& u, int wr, int wc, int fr, int fq) const {
        const int e = u.pn >> 4, c0 = 128 * (u.pn & 15) + wc * 32 + 8 * fq;
        f32x4 bg[2], bu[2];
#pragma unroll
        for (int n = 0; n < 2; ++n) { bg[n] = *(const f32x4*)(bgu + (size_t)e * 4096 + c0 + 4 * n); bu[n] = *(const f32x4*)(bgu + (size_t)e * 4096 + 2048 + c0 + 4 * n); }
#pragma unroll
        for (int ai = 0; ai < 2; ++ai)
#pragma unroll
            for (int m = 0; m < 4; ++m) {
                const int row = u.pm * BM + ai * HALF + wr * 64 + m * 16 + fr;
                int o8[2];
#pragma unroll
                for (int n = 0; n < 2; ++n) { const f32x4 g = acc[ai][0][m][n] * wscale + bg[n], up = acc[ai][1][m][n] * wscale + bu[n]; float o[4];
#pragma unroll
                    for (int j = 0; j < 4; ++j) { const float gg = fminf(g[j], 7.0f), uu = fminf(fmaxf(up[j], -7.0f), 7.0f); o[j] = gg * sigmoidf_fast(1.702f * gg) * (uu + 1.0f); }
                    int d = __builtin_amdgcn_cvt_pk_fp8_f32(o[0], o[1], 0, false); o8[n] = __builtin_amdgcn_cvt_pk_fp8_f32(o[2], o[3], d, true); }
                typedef unsigned u32x2_ __attribute__((ext_vector_type(2)));
                *(u32x2_*)(ACT + (size_t)row * 2048 + c0) = (u32x2_){(unsigned)o8[0], (unsigned)o8[1]};
            }
    }
};
struct EpiDN {
    static constexpr bool PERM = true, AFTER_DRAIN = false;
    unsigned char* Y; const float* bdn; float wscale;
    __device__ __forceinline__ void operator()(const f32x4 (&acc)[2][2][4][2], const Unit& u, int wr, int wc, int fr, int fq) const {
        const int e = u.pn >> 3, c0 = 256 * (u.pn & 7) + wc * 32 + 8 * fq;
        f32x4 bv[2][2];
#pragma unroll
        for (int bj = 0; bj < 2; ++bj)
#pragma unroll
            for (int n = 0; n < 2; ++n) bv[bj][n] = *(const f32x4*)(bdn + (size_t)e * 2048 + c0 + bj * HALF + 4 * n);
#pragma unroll
        for (int ai = 0; ai < 2; ++ai)
#pragma unroll
            for (int m = 0; m < 4; ++m) {
                const int row = u.pm * BM + ai * HALF + wr * 64 + m * 16 + fr;
#pragma unroll
                for (int bj = 0; bj < 2; ++bj) { int o8[2];
#pragma unroll
                    for (int n = 0; n < 2; ++n) { const f32x4 v = acc[ai][bj][m][n] * wscale + bv[bj][n]; const int d = __builtin_amdgcn_cvt_pk_fp8_f32(v[0], v[1], 0, false); o8[n] = __builtin_amdgcn_cvt_pk_fp8_f32(v[2], v[3], d, true); }
                    typedef unsigned u32x2_ __attribute__((ext_vector_type(2)));
                    *(u32x2_*)(Y + (size_t)row * 2048 + c0 + bj * HALF) = (u32x2_){(unsigned)o8[0], (unsigned)o8[1]}; }
            }
    }
};
struct GroupedOrder {
    const volatile PG8_LAS int* texp; int NPN, nwg, G, c;
    __device__ void init(const volatile PG8_LAS int* texp_, int T, int NPN_, int G_, int c_) { texp = texp_; NPN = NPN_; nwg = T * NPN_; G = G_; c = c_; }
    __device__ bool next(int i, Unit& u) const {
        const long L = (long)i * G + c; if (L >= nwg) return false;
        int wgid = (int)L; { const int q = nwg / NXCD, r = nwg % NXCD, xcd = wgid % NXCD, off = wgid / NXCD; wgid = (xcd < r ? xcd * (q + 1) : r * (q + 1) + (xcd - r) * q) + off; }
        const int mt = wgid / NPN, t = wgid - mt * NPN;
        const int e = __builtin_amdgcn_readfirstlane(texp[mt]);
        u.pm = mt; u.pn = e * NPN + t; return true;
    }
    __device__ __forceinline__ void a_ready(const Unit&) const {}
    __device__ __forceinline__ void done(const Unit&) const {}
};
template <class Epi, class Sched, bool ALIGN_EPI = false, bool SP2 = false, bool F8 = false>
__device__ __forceinline__ void gemm_phase(PG8_LAS unsigned char* lds, const Gemm g, const Sched& S, const Epi& E) {
    int tid_o = threadIdx.x; asm volatile("" : "+v"(tid_o));
    const int tid = tid_o, wid = __builtin_amdgcn_readfirstlane(tid >> 6), lane = tid & 63, wr = wid >> 2, wc = wid & 3, fr = lane & 15, fq = lane >> 4;
    const int K = F8 ? g.K / 2 : g.K, nt = K / BK;
    unsigned voffA[2], voffB[2];
#pragma unroll
    for (int i = 0; i < 2; ++i) { int R, C; stage_rc(tid * 16 + i * 8192, R, C); const int Rb = Epi::PERM ? ((R & ~31) + perm32(R & 31)) : R;
        voffA[i] = (unsigned)(R * K + C) * 2u; voffB[i] = (unsigned)(Rb * K + C) * 2u; }
    const size_t kstep = (size_t)(BK * 2);
    const size_t hstep = (size_t)HALF * K * 2;
    const size_t tstep = 2 * hstep;
    const unsigned ldsw = (unsigned)wid * 1024u;
    const int aoff = lds_byte(wr * 64 + fr, fq * 8), boff = lds_byte(wc * 32 + fr, fq * 8);
#define PG8_SA(b, h) (((b) * 2 + (h)) * HTB)
#define PG8_SB(b, h) ((4 + (b) * 2 + (h)) * HTB)
#define PG8_STAGE(bufoff, gbase, voff) do { _Pragma("unroll") for (int _i = 0; _i < 2; ++_i) \
        __builtin_amdgcn_global_load_lds((const unsigned*)((const char*)(gbase) + (voff)[_i]), (PG8_LAS unsigned*)(lds + (bufoff) + ldsw + _i * 8192), 16, 0, 0); } while (0)
#define PG8_RD16(off) (*(const PG8_LAS v4i_*)(lds + (off)))
#define PG8_LDA(dst, b, h) do { _Pragma("unroll") for (int m = 0; m < 4; ++m) { if constexpr (F8) { const v4i_ l_ = PG8_RD16(PG8_SA(b, h) + aoff + m * 2048), h_ = PG8_RD16(PG8_SA(b, h) + aoff + m * 2048 + 1024); dst##8[m] = __builtin_shufflevector(l_, h_, 0, 1, 2, 3, 4, 5, 6, 7); } \
        else { _Pragma("unroll") for (int k = 0; k < 2; ++k) dst[m][k] = *(const PG8_LAS bf16x8*)(lds + PG8_SA(b, h) + aoff + m * 2048 + k * 1024); } } } while (0)
#define PG8_LDB(dst, b, h) do { _Pragma("unroll") for (int n = 0; n < 2; ++n) { if constexpr (F8) { const v4i_ l_ = PG8_RD16(PG8_SB(b, h) + boff + n * 2048), h_ = PG8_RD16(PG8_SB(b, h) + boff + n * 2048 + 1024); dst##8[n] = __builtin_shufflevector(l_, h_, 0, 1, 2, 3, 4, 5, 6, 7); } \
        else { _Pragma("unroll") for (int k = 0; k < 2; ++k) dst[n][k] = *(const PG8_LAS bf16x8*)(lds + PG8_SB(b, h) + boff + n * 2048 + k * 1024); } } } while (0)
#define PG8_MMA(ai, bj, At, Bt) do { __builtin_amdgcn_s_setprio(1); _Pragma("unroll") for (int m = 0; m < 4; ++m) _Pragma("unroll") for (int n = 0; n < 2; ++n) { \
        if constexpr (F8) {   \
            asm("v_mfma_scale_f32_16x16x128_f8f6f4 %0, %1, %2, %0, %3, %3 op_sel_hi:[0,0,0]" : "+v"(acc[ai][bj][m][n]) : "v"(Bt##8[n]), "v"(At##8[m]), "v"(sc8_)); }   \
        else { _Pragma("unroll") for (int k = 0; k < 2; ++k) acc[ai][bj][m][n] = __builtin_amdgcn_mfma_f32_16x16x32_bf16(Bt[n][k], At[m][k], acc[ai][bj][m][n], 0, 0, 0); } } \
        __builtin_amdgcn_s_setprio(0); } while (0)
#define PG8_WAIT_V(n) asm volatile("s_waitcnt vmcnt(" #n ")" ::: "memory")
#define PG8_WAIT_L(n) asm volatile("s_waitcnt lgkmcnt(" #n ")" ::: "memory")
#define PG8_BAR __builtin_amdgcn_s_barrier()
#define PG8_SCHED __builtin_amdgcn_sched_barrier(0)
    Unit cur, nxt; int ui = 0;
    if (!S.next(0, cur)) return;
    f32x4 acc[2][2][4][2];
#pragma unroll
    for (int a = 0; a < 2; ++a)
#pragma unroll
        for (int b = 0; b < 2; ++b)
#pragma unroll
            for (int m = 0; m < 4; ++m)
#pragma unroll
                for (int n = 0; n < 2; ++n) acc[a][b][m][n] = (f32x4){0.f, 0.f, 0.f, 0.f};
    typedef int v8i_ __attribute__((ext_vector_type(8))); typedef int v4i_ __attribute__((ext_vector_type(4)));
    int sc8_ = 0x7f7f7f7f; asm volatile("" : "+v"(sc8_));
    bf16x8 At[4][2], B0[2][2], B1[2][2]; v8i_ At8[4], B08[2], B18[2];
    const char* cA = (const char*)g.A + (size_t)cur.pm * tstep; const char* cB = (const char*)g.Bt + (size_t)cur.pn * tstep;
    S.a_ready(cur);
    if constexpr (SP2) {
        PG8_STAGE(PG8_SB(0, 0), cB, voffB); PG8_STAGE(PG8_SB(0, 1), cB + hstep, voffB); PG8_STAGE(PG8_SA(0, 0), cA, voffA); PG8_STAGE(PG8_SA(0, 1), cA + hstep, voffA);
        if (wr == 1) PG8_BAR;
        PG8_WAIT_V(2); PG8_BAR;
        PG8_STAGE(PG8_SB(1, 0), cB + kstep, voffB); PG8_STAGE(PG8_SA(1, 0), cA + kstep, voffA); PG8_STAGE(PG8_SB(1, 1), cB + hstep + kstep, voffB);
        PG8_WAIT_V(6); PG8_BAR;
    } else {
        PG8_STAGE(PG8_SB(0, 0), cB, voffB); PG8_STAGE(PG8_SA(0, 0), cA, voffA); PG8_STAGE(PG8_SB(0, 1), cB + hstep, voffB); PG8_STAGE(PG8_SA(0, 1), cA + hstep, voffA);
        if (wr == 1) PG8_BAR;
        PG8_WAIT_V(4); PG8_BAR;
        PG8_STAGE(PG8_SB(1, 0), cB + kstep, voffB); PG8_STAGE(PG8_SA(1, 0), cA + kstep, voffA); PG8_STAGE(PG8_SB(1, 1), cB + hstep + kstep, voffB);
        PG8_WAIT_V(6); PG8_BAR;
    }
    for (;;) {
        const bool has_next = S.next(ui + 1, nxt);
        const char* nA = has_next ? (const char*)g.A + (size_t)nxt.pm * tstep : cA; const char* nB = has_next ? (const char*)g.Bt + (size_t)nxt.pn * tstep : cB;
        for (int t = 0; t < nt; t += 2) {
            const bool last = (t == nt - 2);
            const char* a1 = cA + (size_t)(t + 1) * kstep;
            const char* a2 = last ? nA : cA + (size_t)(t + 2) * kstep; const char* b2 = last ? nB : cB + (size_t)(t + 2) * kstep;
            const char* a3 = a2 + kstep; const char* b3 = b2 + kstep;
            if (last && has_next) S.a_ready(nxt);
            if constexpr (SP2) {
            PG8_LDB(B0, 0, 0); PG8_LDB(B1, 0, 1); PG8_SCHED; PG8_LDA(At, 0, 0); PG8_STAGE(PG8_SA(1, 1), a1 + hstep, voffA);
            PG8_WAIT_V(8); PG8_WAIT_L(0); PG8_BAR; PG8_MMA(0, 0, At, B0); PG8_MMA(0, 1, At, B1); PG8_BAR; PG8_SCHED;
            PG8_LDA(At, 0, 1); PG8_STAGE(PG8_SB(0, 0), b2, voffB); PG8_STAGE(PG8_SB(0, 1), b2 + hstep, voffB); PG8_STAGE(PG8_SA(0, 0), a2, voffA);
            PG8_WAIT_V(8); PG8_WAIT_L(0); PG8_BAR; PG8_MMA(1, 0, At, B0); PG8_MMA(1, 1, At, B1); PG8_BAR; PG8_SCHED;
            PG8_LDB(B0, 1, 0); PG8_LDB(B1, 1, 1); PG8_SCHED; PG8_LDA(At, 1, 0); PG8_STAGE(PG8_SA(0, 1), a2 + hstep, voffA);
            PG8_WAIT_V(8); PG8_WAIT_L(0); PG8_BAR; PG8_MMA(0, 0, At, B0); PG8_MMA(0, 1, At, B1); PG8_BAR; PG8_SCHED;
            PG8_LDA(At, 1, 1); PG8_STAGE(PG8_SB(1, 0), b3, voffB); PG8_STAGE(PG8_SB(1, 1), b3 + hstep, voffB); PG8_STAGE(PG8_SA(1, 0), a3, voffA);
            PG8_WAIT_V(8); PG8_WAIT_L(0); PG8_BAR; PG8_MMA(1, 0, At, B0); PG8_MMA(1, 1, At, B1); PG8_BAR; PG8_SCHED;
            } else {
            PG8_LDB(B0, 0, 0); PG8_SCHED; PG8_LDA(At, 0, 0); PG8_STAGE(PG8_SA(1, 1), a1 + hstep, voffA);
            PG8_WAIT_L(8); PG8_BAR; PG8_WAIT_L(0); PG8_MMA(0, 0, At, B0); PG8_BAR; PG8_SCHED;
            PG8_LDB(B1, 0, 1); PG8_STAGE(PG8_SB(0, 0), b2, voffB);
            PG8_BAR; PG8_WAIT_L(0); PG8_MMA(0, 1, At, B1); PG8_BAR;
            PG8_LDA(At, 0, 1); PG8_STAGE(PG8_SA(0, 0), a2, voffA);
            PG8_BAR; PG8_WAIT_L(0); PG8_MMA(1, 0, At, B0); PG8_BAR; PG8_SCHED;
            PG8_STAGE(PG8_SB(0, 1), b2 + hstep, voffB);
            PG8_WAIT_V(6); PG8_BAR; PG8_MMA(1, 1, At, B1); PG8_BAR;
            PG8_LDB(B0, 1, 0); PG8_SCHED; PG8_LDA(At, 1, 0); PG8_STAGE(PG8_SA(0, 1), a2 + hstep, voffA);
            PG8_WAIT_L(8); PG8_BAR; PG8_WAIT_L(0); PG8_MMA(0, 0, At, B0); PG8_BAR; PG8_SCHED;
            PG8_LDB(B1, 1, 1); PG8_STAGE(PG8_SB(1, 0), b3, voffB);
            PG8_BAR; PG8_WAIT_L(0); PG8_MMA(0, 1, At, B1); PG8_BAR;
            PG8_LDA(At, 1, 1); PG8_STAGE(PG8_SA(1, 0), a3, voffA);
            PG8_BAR; PG8_WAIT_L(0); PG8_MMA(1, 0, At, B0); PG8_BAR; PG8_SCHED;
            PG8_STAGE(PG8_SB(1, 1), b3 + hstep, voffB);
            PG8_WAIT_V(6); PG8_BAR; PG8_MMA(1, 1, At, B1); PG8_BAR;
            }
        }
        if constexpr (F8) asm volatile("s_nop 15\n\ts_nop 15" ::: "memory");
        if constexpr (ALIGN_EPI) { if (wr == 0) PG8_BAR; }
        if constexpr (!Epi::AFTER_DRAIN) { E(acc, cur, wr, wc, fr, fq); S.done(cur); }
        if (!has_next) break;
#pragma unroll
        for (int a = 0; a < 2; ++a)
#pragma unroll
            for (int b = 0; b < 2; ++b)
#pragma unroll
                for (int m = 0; m < 4; ++m)
#pragma unroll
                    for (int n = 0; n < 2; ++n) acc[a][b][m][n] = (f32x4){0.f, 0.f, 0.f, 0.f};
        cur = nxt; cA = nA; cB = nB; ++ui;
        if constexpr (ALIGN_EPI) { if (wr == 1) PG8_BAR; }
    }
    PG8_WAIT_V(0);
    if constexpr (!ALIGN_EPI) { if (wr == 0) PG8_BAR; }
    PG8_BAR;
    if constexpr (Epi::AFTER_DRAIN) { E.fused(acc, cur, wr, wc, fr, fq, lds, wid, lane); S.done(cur); }
#undef PG8_SA
#undef PG8_SB
#undef PG8_STAGE
#undef PG8_RD16
#undef PG8_LDA
#undef PG8_LDB
#undef PG8_MMA
#undef PG8_WAIT_V
#undef PG8_WAIT_L
#undef PG8_BAR
#undef PG8_SCHED
}
}
namespace fox {
constexpr float THR = 8.f; constexpr int D = 128;
constexpr float SCALE = 0.08838834764831845f;
constexpr int NW = 8, QBLK = 32, KVBLK = 64, QB = NW * QBLK;
constexpr int SHM_V = KVBLK * D * 2, SHM_K = KVBLK * D * 2;
using bf16 = __hip_bfloat16;
typedef short bf16x8 __attribute__((ext_vector_type(8)));
typedef short s16x4 __attribute__((ext_vector_type(4)));
typedef float f32x16 __attribute__((ext_vector_type(16)));
typedef float f32x4 __attribute__((ext_vector_type(4)));
typedef unsigned u32x4 __attribute__((ext_vector_type(4)));
template <class A, class Bt> struct same_t { static constexpr bool v = false; };
template <class A> struct same_t<A, A> { static constexpr bool v = true; };

#define KSWZ(row, colB) ((row) * 256 + ((colB) ^ (((row) & 7) << 4)))
#define SBAR() __builtin_amdgcn_sched_barrier(0)
__device__ __forceinline__ int v_st(int k, int c) { const int kk = (k & ~0xC) | ((k & 4) << 1) | ((k & 8) >> 1); return ((kk >> 3) * 4 + (c >> 5)) * 512 + ((kk & 7) * 32 + (c & 31)) * 2; }
__device__ __forceinline__ int v_rd_base(int lane) { return ((lane & 3) << 3) | (((lane >> 2) & 3) << 6) | (((lane >> 4) & 1) << 5) | (((lane >> 5) & 1) << 8); }
constexpr int v_rd_off(int d0, int ks, int half) { return d0 * 512 + ks * 4096 + half * 2048; }
__device__ __forceinline__ int crow(int r, int hi) { return (r & 3) + 8 * (r >> 2) + 4 * hi; }
__device__ __forceinline__ unsigned cvtpk(float lo, float hi) {
    unsigned r; asm volatile("v_cvt_pk_bf16_f32 %0, %1, %2" : "=v"(r) : "v"(lo), "v"(hi)); return r;
}
__device__ __forceinline__ bf16x8 pack8(f32x4 a, f32x4 b) {
    u32x4 w = {cvtpk(a[0], a[1]), cvtpk(a[2], a[3]), cvtpk(b[0], b[1]), cvtpk(b[2], b[3])};
    return *reinterpret_cast<bf16x8*>(&w);
}
template <class T> __device__ __forceinline__ bf16x8 load8(const T* p) {
    if constexpr (same_t<T, float>::v) { return pack8(*(const f32x4*)p, *(const f32x4*)(p + 4)); }
    else { return *reinterpret_cast<const bf16x8*>(p); }
}
__device__ __forceinline__ void mask_tile(f32x16& p0, f32x16& p1, int dq, unsigned W) {
    const float NEG = -__builtin_inff();
#pragma unroll
    for (int r = 0; r < 16; ++r) {
        const int c = (r & 3) + 8 * (r >> 2);
        if ((unsigned)(dq - c) >= W) p0[r] = NEG;
        if ((unsigned)(dq - c - 32) >= W) p1[r] = NEG;
    }
}
__device__ __forceinline__ void partialSM(f32x16& p0, f32x16& p1, float& m_reg, float& mn, float& alpha) {
    float pmax = p0[0]; for (int r = 1; r < 16; ++r) pmax = fmaxf(pmax, p0[r]); for (int r = 0; r < 16; ++r) pmax = fmaxf(pmax, p1[r]);
    { auto rr = __builtin_amdgcn_permlane32_swap(__float_as_uint(pmax), __float_as_uint(pmax), false, false);
      pmax = fmaxf(__uint_as_float(rr[0]), __uint_as_float(rr[1])); }
    constexpr float C2 = 1.4426950408889634f * SCALE;
    if (__builtin_expect(__all((pmax - m_reg) * SCALE <= THR), 1)) { mn = m_reg; alpha = 1.f; }
    else { mn = fmaxf(m_reg, pmax); alpha = __builtin_amdgcn_exp2f((m_reg - mn) * C2); m_reg = mn; }
    const float mnL = -mn * C2;
    for (int r = 0; r < 16; ++r) p0[r] = fmaf(p0[r], C2, mnL); for (int r = 0; r < 16; ++r) p1[r] = fmaf(p1[r], C2, mnL);
    for (int r = 0; r < 16; ++r) p0[r] = __builtin_amdgcn_exp2f(p0[r]);
}
__device__ __forceinline__ void finishSM(f32x16& p0, f32x16& p1, float alpha, float& l_reg, bf16x8& pa0, bf16x8& pa1, bf16x8& pa2, bf16x8& pa3) {
    for (int r = 0; r < 16; ++r) p1[r] = __builtin_amdgcn_exp2f(p1[r]);
    float ps = 0; for (int r = 0; r < 16; ++r) ps += p0[r]; for (int r = 0; r < 16; ++r) ps += p1[r];
    { auto rr = __builtin_amdgcn_permlane32_swap(__float_as_uint(ps), __float_as_uint(ps), false, false);
      ps = __uint_as_float(rr[0]) + __uint_as_float(rr[1]); }
    l_reg = l_reg * alpha + ps;
#define PK4(P, B_, OUT) do { unsigned a0 = cvtpk(P[B_+0], P[B_+1]), a1 = cvtpk(P[B_+2], P[B_+3]);                          \
        unsigned b0 = cvtpk(P[B_+4], P[B_+5]), b1 = cvtpk(P[B_+6], P[B_+7]);                                             \
        auto r0 = __builtin_amdgcn_permlane32_swap(a0, b0, false, false); auto r1 = __builtin_amdgcn_permlane32_swap(a1, b1, false, false); \
        u32x4 w = {r0[0], r1[0], r0[1], r1[1]}; OUT = *reinterpret_cast<bf16x8*>(&w); } while (0)
    PK4(p0, 0, pa0); PK4(p0, 8, pa1); PK4(p1, 0, pa2); PK4(p1, 8, pa3);
#undef PK4
}
template <int KB, bool SK>
__device__ __forceinline__ void qkt(f32x16& p0, f32x16& p1, const char* K_lds, int r32, int hi, const char* Qw, const float* cneg, bool act) {
    if (SK && !act) { const float NEG = -__builtin_inff();
#pragma unroll
        for (int r = 0; r < 16; ++r) { p0[r] = NEG; p1[r] = NEG; } return; }
    {
#pragma unroll
        for (int g = 0; g < 4; ++g) { const f32x4 c0 = *(const f32x4*)(cneg + 8 * g), c1 = *(const f32x4*)(cneg + 32 + 8 * g);
#pragma unroll
            for (int j = 0; j < 4; ++j) { p0[4 * g + j] = c0[j]; p1[4 * g + j] = c1[j]; } } }
    const char* kb[4]; const char* qb4[4];
#pragma unroll
    for (int dd = 0; dd < 4; ++dd) { kb[dd] = K_lds + KB * SHM_K + KSWZ(r32, (dd * 16 + hi * 8) * 2); qb4[dd] = Qw + KSWZ(r32, (dd * 16 + hi * 8) * 2); }
#pragma unroll
    for (int d0 = 0; d0 < 8; ++d0) { const char* a = kb[d0 & 3] + (d0 >> 2) * 128;
        bf16x8 b0 = *reinterpret_cast<const bf16x8*>(a);
        bf16x8 b1 = *reinterpret_cast<const bf16x8*>(a + 32 * 256);
        bf16x8 qf = *reinterpret_cast<const bf16x8*>(qb4[d0 & 3] + (d0 >> 2) * 128);
        p0 = __builtin_amdgcn_mfma_f32_32x32x16_bf16(b0, qf, p0, 0, 0, 0);
        p1 = __builtin_amdgcn_mfma_f32_32x32x16_bf16(b1, qf, p1, 0, 0, 0); }
}
template <int VB, bool SK>
__device__ __forceinline__ void pv_tile(f32x16* o, int vb0, bf16x8 pa0, bf16x8 pa1, bf16x8 pa2, bf16x8 pa3, bool act) {
    if (SK && !act) return;
#define TRRD(dst, off) asm volatile("ds_read_b64_tr_b16 %0, %1 offset:%2" : "=&v"(dst) : "v"(vb0), "i"(off) : "memory")
#define PV_D0(d0) do { s16x4 l0, l1, l2, l3, h0, h1, h2, h3; constexpr int b_ = VB * SHM_V + v_rd_off(d0, 0, 0);     \
        TRRD(l0, b_); TRRD(h0, b_ + 2048); TRRD(l1, b_ + 4096); TRRD(h1, b_ + 6144); TRRD(l2, b_ + 8192); TRRD(h2, b_ + 10240); TRRD(l3, b_ + 12288); TRRD(h3, b_ + 14336); \
        asm volatile("s_waitcnt lgkmcnt(0)" ::: "memory"); SBAR();                 \
        o[d0] = __builtin_amdgcn_mfma_f32_32x32x16_bf16(pa0, (bf16x8){l0[0], l0[1], l0[2], l0[3], h0[0], h0[1], h0[2], h0[3]}, o[d0], 0, 0, 0);   \
        o[d0] = __builtin_amdgcn_mfma_f32_32x32x16_bf16(pa1, (bf16x8){l1[0], l1[1], l1[2], l1[3], h1[0], h1[1], h1[2], h1[3]}, o[d0], 0, 0, 0);   \
        o[d0] = __builtin_amdgcn_mfma_f32_32x32x16_bf16(pa2, (bf16x8){l2[0], l2[1], l2[2], l2[3], h2[0], h2[1], h2[2], h2[3]}, o[d0], 0, 0, 0);   \
        o[d0] = __builtin_amdgcn_mfma_f32_32x32x16_bf16(pa3, (bf16x8){l3[0], l3[1], l3[2], l3[3], h3[0], h3[1], h3[2], h3[3]}, o[d0], 0, 0, 0); } while (0)
    PV_D0(0); PV_D0(1); PV_D0(2); PV_D0(3);
#undef PV_D0
#undef TRRD
}
constexpr int LDS_CK = 2 * SHM_V + 2 * SHM_K + NW * 64 * 4, LDS_Q = LDS_CK + 2 * 64 * 4, LDS_BYTES_FOX = LDS_Q + NW * QBLK * D * 2;
struct FoxRef { const bf16* Q; const bf16* K; const bf16* V; const float* C; bf16* O; float* ML; int P0, j_lo, j_hi, dummy; };
struct FoxSeam { int unused; };
#define VMW() asm volatile("s_waitcnt vmcnt(0)" ::: "memory")
#define FOX_LAS __attribute__((address_space(3)))
struct FoxDma { int kof, vof, qof; };
__device__ __forceinline__ FoxDma fox_dma_init(int wid, int lane) {
    FoxDma d; const int lr = lane >> 4, lc = lane & 15;
    d.kof = (wid * 8 + lr) * 256 + ((lc ^ lr) << 4);
    const int kk = wid * 8 + ((lane & 31) >> 2), k = (kk & ~0xC) | ((kk & 4) << 1) | ((kk & 8) >> 1);
    d.vof = k * 256 + ((lane >> 5) * 32 + (lane & 3) * 8) * 2;
    d.qof = (wid * QBLK + lr) * 256 + ((lc ^ lr) << 4);
    return d;
}
constexpr int NC_OFF = 8 * 8256;
#define FOX_G2L(gp, lp, n) __builtin_amdgcn_global_load_lds((const unsigned*)(gp), (FOX_LAS unsigned*)(lp), n, 0, 0)
#define FOX_DMA_K(Kp, Cp, kb_, kbuf) do { const char* kg_ = (const char*)(Kp) + (size_t)(kb_) * 256; unsigned ko_ = dm.kof, lo_ = lane * 4; asm volatile("" : "+v"(ko_), "+v"(lo_));       \
        FOX_G2L(kg_ + ko_, K_lds + (kbuf) * SHM_K + wid * 2048, 16); FOX_G2L(kg_ + ((ko_ ^ 64u) + 1024u), K_lds + (kbuf) * SHM_K + wid * 2048 + 1024, 16);                               \
        if (wid == 0) FOX_G2L((const char*)((Cp) + NC_OFF + (kb_)) + lo_, (char*)ck_lds + (kbuf) * 256, 4); } while (0)
#define FOX_DMA_V(Vp, kb_, vbuf) do { const char* vg_ = (const char*)(Vp) + (size_t)(kb_) * 256; unsigned vo_ = dm.vof; asm volatile("" : "+v"(vo_));                                     \
        FOX_G2L(vg_ + vo_, V_lds + (vbuf) * SHM_V + wid * 2048, 16); FOX_G2L(vg_ + (vo_ + 128u), V_lds + (vbuf) * SHM_V + wid * 2048 + 1024, 16); } while (0)
#define FOX_DMA_Q(Qp) do { const char* qg_ = (const char*)(Qp); unsigned qo_ = dm.qof; asm volatile("" : "+v"(qo_));                                                                      \
        _Pragma("unroll") for (int i_ = 0; i_ < 8; ++i_) FOX_G2L(qg_ + ((qo_ ^ (64u * (i_ & 1))) + 1024u * i_), Qw + 1024 * i_, 16); } while (0)
__device__ __forceinline__ void qkt_rt(f32x16& p0, f32x16& p1, const char* Kt, int r32, int hi, const char* Qw, const float* cneg) {
#pragma unroll
    for (int g = 0; g < 4; ++g) { const f32x4 c0 = *(const f32x4*)(cneg + 8 * g), c1 = *(const f32x4*)(cneg + 32 + 8 * g);
#pragma unroll
        for (int j = 0; j < 4; ++j) { p0[4 * g + j] = c0[j]; p1[4 * g + j] = c1[j]; } }
    const char* kb[4]; const char* qb4[4];
#pragma unroll
    for (int dd = 0; dd < 4; ++dd) { kb[dd] = Kt + KSWZ(r32, (dd * 16 + hi * 8) * 2); qb4[dd] = Qw + KSWZ(r32, (dd * 16 + hi * 8) * 2); }
#pragma unroll
    for (int d0 = 0; d0 < 8; ++d0) { const char* a = kb[d0 & 3] + (d0 >> 2) * 128;
        bf16x8 b0 = *reinterpret_cast<const bf16x8*>(a);
        bf16x8 b1 = *reinterpret_cast<const bf16x8*>(a + 32 * 256);
        bf16x8 qf = *reinterpret_cast<const bf16x8*>(qb4[d0 & 3] + (d0 >> 2) * 128);
        p0 = __builtin_amdgcn_mfma_f32_32x32x16_bf16(b0, qf, p0, 0, 0, 0);
        p1 = __builtin_amdgcn_mfma_f32_32x32x16_bf16(b1, qf, p1, 0, 0, 0); }
}
__device__ __forceinline__ void fox_prime(const FoxRef& cur, char* lds, FoxSeam& S) {
    const int tid = threadIdx.x, wid = __builtin_amdgcn_readfirstlane(tid >> 6), lane = tid & 63;
    char* K_lds = lds + 2 * SHM_V; float* ck_lds = (float*)(lds + LDS_CK); char* Qw = lds + LDS_Q + wid * (QBLK * D * 2);
    const FoxDma dm = fox_dma_init(wid, lane);
    FOX_DMA_K(cur.K, cur.C, cur.j_lo * KVBLK, 0); FOX_DMA_Q(cur.Q);
    S.unused = 0;
    VMW(); __syncthreads();
}
__device__ __forceinline__ void fox_block(const FoxRef& cur, const FoxRef& nxt, char* lds, FoxSeam& S) {
    constexpr unsigned W = 0x7fffffffu;
    int tid_o = threadIdx.x; asm volatile("" : "+v"(tid_o));
    const int tid = tid_o, wid = __builtin_amdgcn_readfirstlane(tid >> 6), lane = tid & 63, r32 = lane & 31, hi = lane >> 5, grp = wid >> 2;
    const int j_lo = cur.j_lo, NT = cur.j_hi - cur.j_lo;
    const int kbn = nxt.j_lo * KVBLK;
    const int qlo = cur.P0 + wid * QBLK, qm = qlo + r32 - 4 * hi;
    char* V_lds = lds; char* K_lds = lds + 2 * SHM_V;
    float* ws = (float*)(lds + 2 * SHM_V + 2 * SHM_K) + wid * 64; float* li_l = ws, * al_l = ws + 32;
    float* ck_lds = (float*)(lds + LDS_CK);
    char* Qw = lds + LDS_Q + wid * (QBLK * D * 2);
    float m_reg = -1e30f, l_reg = 0; f32x16 o[4] = {};
    const int vb0 = (int)(uintptr_t)V_lds + v_rd_base(lane);
    const bf16* Kh = cur.K; const bf16* Vh = cur.V; const float* Ch = cur.C;
    const FoxDma dm = fox_dma_init(wid, lane);
    f32x16 p0, p1; float mn, al; bf16x8 pa0, pa1, pa2, pa3;
#define KBASE(t) ((j_lo + (t)) * KVBLK)
#define DMA_STEP(s) do { FOX_DMA_V(Vh, KBASE(s), (s) & 1); if ((s) + 1 < NT) { FOX_DMA_K(Kh, Ch, KBASE((s) + 1), ((s) + 1) & 1); } SBAR(); } while (0)
#define DMA_SEAM() do { FOX_DMA_K(nxt.K, nxt.C, kbn, 0); FOX_DMA_Q(nxt.Q); SBAR(); } while (0)
#define QK(t) qkt_rt(p0, p1, K_lds + ((t) & 1) * SHM_K, r32, hi, Qw, ck_lds + ((t) & 1) * 64 + 4 * hi)
#define PV(t) pv_tile<0, false>(o, vb0 + ((t) & 1) * SHM_V, pa0, pa1, pa2, pa3, true)
#define SM(t) do { { const int kb_ = KBASE(t); if (kb_ + KVBLK - 1 > qlo) mask_tile(p0, p1, qm - kb_, W); }                                 \
        partialSM(p0, p1, m_reg, mn, al); finishSM(p0, p1, al, l_reg, pa0, pa1, pa2, pa3);                                                  \
        if (__any(al < 1.f)) { if (hi == 0) al_l[r32] = al; asm volatile("s_waitcnt lgkmcnt(0)" ::: "memory");                                \
            for (int d_ = 0; d_ < 4; ++d_) for (int r = 0; r < 16; ++r) o[d_][r] *= al_l[crow(r, hi)]; } } while (0)
#define BAR() do { SBAR(); __syncthreads(); SBAR(); } while (0)
#define EPILOGUE() do {                                                                                                                      \
    if (hi == 0) li_l[r32] = l_reg; asm volatile("s_waitcnt lgkmcnt(0)" ::: "memory");                                                        \
    if (hi == 0) *(float2*)(cur.ML + (wid * QBLK + r32) * 2) = make_float2(m_reg, l_reg);                                                     \
    float rli[16];                                                                                                                           \
    _Pragma("unroll") for (int r = 0; r < 16; ++r) { const float lv = li_l[crow(r, hi)]; rli[r] = lv > 0.f ? __builtin_amdgcn_rcpf(lv) : 0.f; } \
    bf16* Ow = cur.O + (size_t)(wid * QBLK) * D;                                                                                             \
    _Pragma("unroll") for (int r = 0; r < 16; ++r) { const int orow = crow(r, hi);                                                            \
        _Pragma("unroll") for (int d0 = 0; d0 < 4; ++d0) { const float v = o[d0][r] * rli[r];                                                 \
            const float vn = __shfl_xor(v, 1);                                                                                               \
            if ((r32 & 1) == 0) *(unsigned*)(Ow + (size_t)orow * D + d0 * 32 + r32) = cvtpk(v, vn); } } } while (0)
    if (grp == 0) {
        DMA_STEP(0); QK(0); BAR();
#pragma unroll 1
        for (int t = 0; t + 1 < NT; ++t) { SM(t); VMW(); BAR();   DMA_STEP(t + 1); QK(t + 1); PV(t); BAR(); }
        SM(NT - 1); VMW(); BAR();
        DMA_SEAM(); PV(NT - 1); BAR();
        EPILOGUE(); VMW(); BAR();
    } else {
        DMA_STEP(0); BAR();
        QK(0); VMW(); BAR();
#pragma unroll 1
        for (int t = 0; t + 1 < NT; ++t) { DMA_STEP(t + 1); SM(t); BAR();   QK(t + 1); PV(t); VMW(); BAR(); }
        DMA_SEAM(); SM(NT - 1); BAR();
        PV(NT - 1); VMW(); BAR();
        EPILOGUE();
    }
#undef DMA_STEP
#undef DMA_SEAM
#undef QK
#undef PV
#undef SM
#undef BAR
#undef EPILOGUE
#undef KBASE
}
#undef VMW
#undef FOX_G2L
#undef FOX_DMA_K
#undef FOX_DMA_V
#undef FOX_DMA_Q
}
constexpr int NWAVES = 8, NTHREADS = 512;
constexpr int DM = 2048, SEQ = 8192, NMETA = 16, LTOT = SEQ + NMETA, NHEAD = 8, HDIM = 128, INCOLS = 5128, NIN = 5120;
constexpr int NEXP = 32, TOPK = 4, CKW = 31;
constexpr int MIN_ROWS = 8448;
constexpr int SKV = 8256;
constexpr int MAXT = 160, PROWS = MAXT * 256;
constexpr float NORM_EPS = 1e-5f;
constexpr float INV_SCALE = 11.313708498984761f;
constexpr float W8_SCALE = 32.0f, W8_INV = 1.0f / 32.0f;
constexpr size_t MiB = 1u << 20;
constexpr size_t WS_CTL = 0, CTL_ZERO_BYTES = 1 * MiB;
constexpr size_t WS_WIN = 1 * MiB, WS_WOUT = 21 * MiB, WS_WGU = 32 * MiB, WS_WDN = 544 * MiB, WS_HN = 800 * MiB, WS_Q = 834 * MiB, WS_K = 850 * MiB, WS_V = 867 * MiB,
                 WS_U = 884 * MiB, WS_MIXED = 901 * MiB, WS_H = 933 * MiB, WS_HN2 = 997 * MiB, WS_XG = 1029 * MiB, WS_ACT = 1189 * MiB, WS_Y = 1349 * MiB,
                 WS_OPART = 1509 * MiB, WS_ML = 1573 * MiB, WS_LOGF = 1575 * MiB, WS_CS = 1576 * MiB, WS_ROUTE = 1577 * MiB, WS_END = 1579 * MiB;
static_assert(WS_WIN + (size_t)NIN * DM * 2 <= WS_WOUT && WS_WOUT + (size_t)DM * DM * 2 <= WS_WGU && WS_WGU + (size_t)NEXP * 4096 * DM * 2 <= WS_WDN && WS_WDN + (size_t)NEXP * DM * DM * 2 <= WS_HN, "ws map 1");
static_assert(WS_HN + (size_t)MIN_ROWS * DM * 2 <= WS_Q && WS_Q + (size_t)NHEAD * SEQ * HDIM * 2 <= WS_K && WS_K + (size_t)NHEAD * SKV * HDIM * 2 <= WS_V && WS_V + (size_t)NHEAD * SKV * HDIM * 2 <= WS_U, "ws map 2");
static_assert(WS_U + (size_t)LTOT * 1024 * 2 <= WS_MIXED && WS_MIXED + (size_t)SEQ * DM * 2 <= WS_H && WS_H + (size_t)SEQ * DM * 4 <= WS_HN2 && WS_HN2 + (size_t)SEQ * DM * 2 <= WS_XG, "ws map 3");
static_assert(WS_XG + (size_t)PROWS * DM * 2 <= WS_ACT && WS_ACT + (size_t)PROWS * DM * 2 <= WS_Y && WS_Y + (size_t)PROWS * DM * 2 <= WS_OPART && WS_OPART + (size_t)1024 * 256 * 128 * 2 <= WS_ML, "ws map 4");
static_assert(WS_ML + (size_t)1024 * 512 * 4 <= WS_LOGF && WS_LOGF + (size_t)LTOT * 8 * 4 <= WS_CS && WS_CS + (size_t)2 * NHEAD * SKV * 4 <= WS_ROUTE && WS_ROUTE + (size_t)4 * SEQ * 4 * 4 + 256 * 32 * 4 <= WS_END, "ws map 5");
constexpr int CW_BAR = 4096, CW_QUEUE = 8192  , CW_CNT = 8384, CW_TEXP = 8448  , CW_NT = 8640  , CW_NORM = 8704  ;
constexpr int RING_BYTES = 135168, MISC_OFF = RING_BYTES, LDS_BYTES = RING_BYTES + 1024;

#define GAS __attribute__((address_space(1)))
#define LAS __attribute__((address_space(3)))
typedef unsigned short bf16;
typedef unsigned v4u __attribute__((ext_vector_type(4)));
typedef unsigned v2u __attribute__((ext_vector_type(2)));
typedef float f32x4 __attribute__((ext_vector_type(4)));
typedef float f32x16 __attribute__((ext_vector_type(16)));
typedef GAS unsigned gu32;
#define RLX_AGENT __ATOMIC_RELAXED, __HIP_MEMORY_SCOPE_AGENT
__device__ __forceinline__ unsigned pk2(float lo, float hi) { unsigned r; asm volatile("v_cvt_pk_bf16_f32 %0, %1, %2" : "=v"(r) : "v"(lo), "v"(hi)); return r; }
__device__ __forceinline__ float bf_lo(unsigned w) { return __uint_as_float(w << 16); }
__device__ __forceinline__ float bf_hi(unsigned w) { return __uint_as_float(w & 0xffff0000u); }
__device__ __forceinline__ float wave_sum(float v) {
#pragma unroll
    for (int o = 1; o < 64; o <<= 1) v += __shfl_xor(v, o);
    return v;
}
#define XB_TMO      128
#define XB_XCNT(j)  (256  + 64 * (j))
#define XB_XSUB(j)  (1280 + 64 * (j))
#define XB_XGEN(j)  (2304 + 64 * (j))
#define XB_TOP      3328
#define XB_TOPGEN   3392
#define XCD_BAR_WORDS 3456
#define XB_SPIN_CAP (1u << 18)

__device__ __forceinline__ unsigned xb_ld(unsigned* p)              { return __hip_atomic_load(p, __ATOMIC_RELAXED, __HIP_MEMORY_SCOPE_AGENT); }
__device__ __forceinline__ unsigned xb_add(unsigned* p, unsigned v) { return __hip_atomic_fetch_add(p, v, __ATOMIC_RELAXED, __HIP_MEMORY_SCOPE_AGENT); }
__device__ __forceinline__ unsigned xb_xcc_id() { return (unsigned)__builtin_amdgcn_s_getreg((3 << 11) | 20) & 0xFu; }
#define XB_SPIN(cond, bar) do { unsigned _sp = 0; while (cond) { __builtin_amdgcn_s_sleep(1); \
    if ((++_sp & 255u) == 0u) { if (xb_ld(&(bar)[XB_TMO])) break; if (_sp > XB_SPIN_CAP) { atomicAdd(&(bar)[XB_TMO], 1u); break; } } } } while (0)

struct XcdBarrier {
    unsigned* bar; unsigned x;
    volatile LAS unsigned* st;
};

__device__ __forceinline__ XcdBarrier xcd_barrier_post(unsigned* bar, volatile LAS unsigned* st) {
    XcdBarrier b; b.bar = bar; b.x = xb_xcc_id(); b.st = st;
    if (threadIdx.x == 0) (void)xb_add(&bar[XB_XCNT(b.x)], 1u);
    return b;
}
__device__ __forceinline__ void xcd_barrier_complete(unsigned* bar, unsigned x, unsigned& nloc, unsigned& nx) {
    const unsigned G = gridDim.x * gridDim.y * gridDim.z;
    unsigned sum, cnt, mine, sp = 0u;
    for (;;) {
        sum = 0u; cnt = 0u; mine = 0u;
#pragma unroll
        for (unsigned j = 0; j < 16; ++j) { const unsigned c = xb_ld(&bar[XB_XCNT(j)]); sum += c; cnt += (c > 0u) ? 1u : 0u; mine = (j == x) ? c : mine; }
        if (sum == G) break;
        __builtin_amdgcn_s_sleep(1);
        if ((++sp & 255u) == 0u) { if (xb_ld(&bar[XB_TMO])) break; if (sp > XB_SPIN_CAP) { atomicAdd(&bar[XB_TMO], 1u); break; } }
    }
    nloc = mine > 0u ? mine : 1u; nx = cnt > 0u ? cnt : 1u;
}

__device__ __forceinline__ void xcd_barrier(const XcdBarrier& b) {
    asm volatile("s_waitcnt vmcnt(0)" ::: "memory");
    __syncthreads();
    if (threadIdx.x == 0) {
        unsigned* bar = b.bar;
        __builtin_amdgcn_s_waitcnt(0);
        unsigned nloc = b.st[0], nx = b.st[1];
        if (nloc == 0u) { xcd_barrier_complete(bar, b.x, nloc, nx); b.st[0] = nloc; b.st[1] = nx; }
        const unsigned old = xb_add(&bar[XB_XSUB(b.x)], 1u);
        const unsigned gen = old / nloc;
        if (old + 1u == (gen + 1u) * nloc) {
            __builtin_amdgcn_fence(__ATOMIC_RELEASE, "agent");
            asm volatile("s_waitcnt vmcnt(0)" ::: "memory");
            const unsigned og = xb_add(&bar[XB_TOP], 1u);
            const unsigned tg = og / nx;
            if (og + 1u == (tg + 1u) * nx) xb_add(&bar[XB_TOPGEN], 1u);
            else XB_SPIN(xb_ld(&bar[XB_TOPGEN]) == tg, bar);
            __builtin_amdgcn_fence(__ATOMIC_ACQUIRE, "agent");
            xb_add(&bar[XB_XGEN(b.x)], 1u);
            asm volatile("s_waitcnt vmcnt(0)" ::: "memory");
        } else {
            XB_SPIN(xb_ld(&bar[XB_XGEN(b.x)]) == gen, bar);
            __builtin_amdgcn_fence(__ATOMIC_ACQUIRE, "agent");
            asm volatile("s_waitcnt vmcnt(0)" ::: "memory");
        }
    }
    __syncthreads();
}
struct Args { const float* in[19]; float* out; unsigned char* ws; };
enum { I_X = 0, I_META, I_G1, I_WIN, I_BF, I_BGLU, I_CW, I_CB, I_GNG, I_GNB, I_WOUT, I_G2, I_RW, I_RB, I_WGU, I_BGU, I_WDN, I_BDN, I_GF };

struct CvJob { const float* src; bf16* dst; int ld; int f8; };
constexpr int CV_GU = NEXP * 32 * 16, CV_DN = NEXP * 16 * 16, CV_IN = 40 * 16, CV_OUT = 16 * 16, CV_JOBS = CV_GU + CV_DN + CV_IN + CV_OUT;
__device__ __forceinline__ CvJob cv_decode(int job, const Args& a) {
    CvJob j;
    if (job < CV_GU) { const int e = job >> 9, r = job & 511, kb = r >> 5, nb = r & 31, col0 = (nb & 1) * 2048 + 128 * (nb >> 1);
        j.src = a.in[I_WGU] + (size_t)e * DM * 4096 + (size_t)(kb * 128) * 4096 + col0; j.ld = 4096; j.f8 = 1; j.dst = (bf16*)((unsigned char*)(a.ws + WS_WGU) + ((size_t)e * 4096 + nb * 128) * DM + kb * 128); }
    else if (job < CV_GU + CV_DN) { const int q = job - CV_GU, e = q >> 8, r = q & 255, kb = r >> 4, nb = r & 15;
        j.src = a.in[I_WDN] + (size_t)e * DM * DM + (size_t)(kb * 128) * DM + nb * 128; j.ld = DM; j.f8 = 1; j.dst = (bf16*)((unsigned char*)(a.ws + WS_WDN) + ((size_t)e * DM + nb * 128) * DM + kb * 128); }
    else if (job < CV_GU + CV_DN + CV_IN) { const int q = job - CV_GU - CV_DN, kb = q / 40, nb = q - kb * 40;
        const int col0 = nb < 24 ? 128 * nb : ((((nb - 24) & 1) ? 4104 : 3080) + 128 * ((nb - 24) >> 1));
        j.src = a.in[I_WIN] + (size_t)(kb * 128) * INCOLS + col0; j.ld = INCOLS; j.f8 = 0; j.dst = (bf16*)(a.ws + WS_WIN) + (size_t)(nb * 128) * DM + kb * 128; }
    else { const int q = job - CV_GU - CV_DN - CV_IN, kb = q >> 4, nb = q & 15;
        j.src = a.in[I_WOUT] + (size_t)(kb * 128) * DM + nb * 128; j.ld = DM; j.f8 = 0; j.dst = (bf16*)(a.ws + WS_WOUT) + (size_t)(nb * 128) * DM + kb * 128; }
    return j;
}
__device__ __forceinline__ void cv_load(const CvJob& j, f32x4 (&v)[8], int tid) {
    const int c4 = tid & 31, kr = tid >> 5;
#pragma unroll
    for (int p = 0; p < 2; ++p)
#pragma unroll
        for (int r = 0; r < 4; ++r) v[p * 4 + r] = __builtin_nontemporal_load((const f32x4*)(j.src + (size_t)(64 * p + 4 * kr + r) * j.ld + 4 * c4));
    asm volatile("" ::: "memory"); __builtin_amdgcn_sched_barrier(0);
}
__device__ __forceinline__ void cv_tile(const CvJob& jc, const f32x4 (&cur)[8], unsigned char* Lb, int tid) {
    const int c4 = tid & 31, kr = tid >> 5;
    if (jc.f8) {
#pragma unroll
        for (int p = 0; p < 2; ++p)
#pragma unroll
            for (int j = 0; j < 4; ++j) { int d = __builtin_amdgcn_cvt_pk_fp8_f32(cur[4 * p + 0][j] * W8_SCALE, cur[4 * p + 1][j] * W8_SCALE, 0, false);
                d = __builtin_amdgcn_cvt_pk_fp8_f32(cur[4 * p + 2][j] * W8_SCALE, cur[4 * p + 3][j] * W8_SCALE, d, true);
                const int n = 4 * c4 + j, unit = 16 * p + kr;
                *(int*)(Lb + n * 128 + ((unit ^ c4) << 2)) = d; }
        __syncthreads();
#pragma unroll
        for (int h = 0; h < 2; ++h) { const int n = 64 * h + (tid >> 3), ch = tid & 7, cx = (n >> 2) & 31; int w[4];
#pragma unroll
          for (int i = 0; i < 4; ++i) w[i] = *(const int*)(Lb + n * 128 + (((4 * ch + i) ^ cx) << 2));
          *(v4u*)((unsigned char*)jc.dst + (size_t)n * DM + 16 * ch) = (v4u){(unsigned)w[0], (unsigned)w[1], (unsigned)w[2], (unsigned)w[3]}; }
    } else {
#pragma unroll
        for (int p = 0; p < 2; ++p)
#pragma unroll
            for (int j = 0; j < 4; ++j) { const unsigned lo = pk2(cur[4 * p + 0][j], cur[4 * p + 1][j]), hi = pk2(cur[4 * p + 2][j], cur[4 * p + 3][j]);
                const int n = 4 * c4 + j, unit = 16 * p + kr, f = (c4 & 15) << 1;
                *(v2u*)(Lb + n * 256 + ((unit ^ f) << 3)) = (v2u){lo, hi}; }
        __syncthreads();
#pragma unroll
        for (int i = 0; i < 4; ++i) { const int n = 32 * i + (tid >> 4), chunk = tid & 15, f = ((n >> 2) & 15) << 1;
            const v4u w = *(const v4u*)(Lb + n * 256 + (((2 * chunk) ^ f) << 3));
            *(v4u*)(jc.dst + (size_t)n * DM + chunk * 8) = w; }
    }
}
constexpr int CV_MOE = CV_GU + CV_DN, CV_BATCH = 8, CV_FINE = 2048, CV_FB = 2;
constexpr int CV_P1_WGS = 108, CV_P1_NB = 3, CV_P1_JOBS = CV_P1_WGS * CV_P1_NB * CV_BATCH;
#ifndef P2_REP_CV
#define P2_REP_CV 1u
#endif
template <int MODE> struct CvIter {
    volatile LAS unsigned* MISC; unsigned* qword; int tid, G, job0, b0, bstride, nbatch, lim, job, nb_par, inb, bdone, bsz;
    __device__ __forceinline__ void setq(int q) { const int f0 = (CV_MOE - job0) - CV_FINE;
        if (q < f0) { job = job0 + q; bsz = CV_BATCH; } else { job = job0 + f0 + CV_FB * ((q - f0) >> 3); bsz = CV_FB; } }
    __device__ __forceinline__ void init(volatile LAS unsigned* MISC_, unsigned* qword_, int tid_, int bid, int G_, int job0_, int b0_, int bstride_, int nbatch_) {
        MISC = MISC_; qword = qword_; tid = tid_; G = G_; job0 = job0_; b0 = b0_; bstride = bstride_; nbatch = nbatch_; nb_par = 0; inb = 0; bdone = 1; bsz = CV_BATCH;
        if (MODE == 1) { lim = job0_ + (CV_MOE - job0_) * (int)P2_REP_CV;
            if (tid == 0) { MISC[6] = __hip_atomic_fetch_add(qword, (unsigned)CV_BATCH, RLX_AGENT); MISC[7] = __hip_atomic_fetch_add(qword, (unsigned)CV_BATCH, RLX_AGENT); }
            __syncthreads();
            setq(__builtin_amdgcn_readfirstlane((int)MISC[6]));
            __syncthreads(); }
        else if (MODE == 2) { lim = CV_MOE; job = nbatch > 0 ? b0 * CV_BATCH : lim; }
        else { lim = CV_JOBS; job = CV_MOE + bid; }
    }
    __device__ __forceinline__ int next() {
        const int cur = job;
        if (cur >= lim) return cur;
        if (MODE == 1) { if (inb < bsz - 1) { job = cur + 1; ++inb; }
                         else { inb = 0; asm volatile("s_waitcnt lgkmcnt(0)" ::: "memory"); __builtin_amdgcn_s_barrier(); asm volatile("" ::: "memory");
                                setq(__builtin_amdgcn_readfirstlane((int)MISC[7 - nb_par]));
                                if (tid == 0) MISC[6 + nb_par] = __hip_atomic_fetch_add(qword, (unsigned)CV_BATCH, RLX_AGENT); nb_par ^= 1; } }
        else if (MODE == 2) { if (inb < CV_BATCH - 1) { job = cur + 1; ++inb; } else { inb = 0; job = bdone < nbatch ? (b0 + bdone * bstride) * CV_BATCH : lim; ++bdone; } }
        else job = cur + G;
        return cur;
    }
};
template <int MODE>
__device__ __forceinline__ void cv_stream(const Args& a, unsigned char* lds, volatile LAS unsigned* MISC, unsigned* qword, int tid, int bid, int G, int job0 = 0, int b0 = 0, int bstride = 0, int nbatch = 0) {
    CvIter<MODE> it; it.init(MISC, qword, tid, bid, G, job0, b0, bstride, nbatch);
    const int lim = it.lim;
#define CVJ(i) (MODE == 1 && P2_REP_CV > 1u ? job0 + ((i) - job0) % (CV_MOE - job0) : (i))
    f32x4 r0[8], r1[8], r2[8], r3[8], r4[8]; CvJob j0, j1, j2, j3, j4; int i0, i1, i2, i3, i4, buf = 0;
#define CV_ISSUE(n) do { i##n = it.next(); j##n = cv_decode(i##n < lim ? CVJ(i##n) : 0, a); cv_load(j##n, r##n, tid); } while (0)
#define CV_DO(n) do { cv_tile(j##n, r##n, lds + buf * 32768, tid); buf ^= 1; } while (0)
    CV_ISSUE(0); CV_ISSUE(1); CV_ISSUE(2); CV_ISSUE(3);
    while (i0 < lim) {
        CV_ISSUE(4); CV_DO(0); if (i1 >= lim) break;
        CV_ISSUE(0); CV_DO(1); if (i2 >= lim) break;
        CV_ISSUE(1); CV_DO(2); if (i3 >= lim) break;
        CV_ISSUE(2); CV_DO(3); if (i4 >= lim) break;
        CV_ISSUE(3); CV_DO(4);
    }
#undef CV_ISSUE
#undef CV_DO
#undef CVJ
    __syncthreads();
}
template <int MODE>
__device__ __forceinline__ void cv_stream_dma(const Args& a, unsigned char* lds, volatile LAS unsigned* MISC, unsigned* qword, int tid, int bid, int G, int job0 = 0, int b0 = 0, int bstride = 0, int nbatch = 0) {
    CvIter<MODE> it; it.init(MISC, qword, tid, bid, G, job0, b0, bstride, nbatch);
    const int lim = it.lim;
    const int wave = __builtin_amdgcn_readfirstlane(tid >> 6), lane = tid & 63, c4 = tid & 31, kr = tid >> 5;
    unsigned char* img = lds + 98304;
#define CVD_ISSUE(J, p_, slot_) do { const unsigned vo_ = (unsigned)((lane >> 5) * (J).ld * 4 + (lane & 31) * 16);                                         \
        _Pragma("unroll") for (int i_ = 0; i_ < 4; ++i_) { const char* g_ = (const char*)(J).src + (size_t)(64 * (p_) + 16 * i_ + 2 * wave) * (J).ld * 4 + vo_;   \
            __builtin_amdgcn_global_load_lds((const unsigned*)g_, (LAS unsigned*)(lds + (slot_) * 32768 + (16 * i_ + 2 * wave) * 512), 16, 0, 2); } } while (0)
#define CVD_BAR(n_) do { asm volatile("s_waitcnt vmcnt(" #n_ ")" ::: "memory"); asm volatile("s_waitcnt lgkmcnt(0)" ::: "memory"); __builtin_amdgcn_s_barrier(); asm volatile("" ::: "memory"); } while (0)
#define CVD_FLUSH(im_, dst_) do { _Pragma("unroll") for (int h_ = 0; h_ < 2; ++h_) { const int n_ = 64 * h_ + (tid >> 3), ch_ = tid & 7, cx_ = (n_ >> 2) & 31; int w_[4];   \
            _Pragma("unroll") for (int q_ = 0; q_ < 4; ++q_) w_[q_] = *(const int*)(img + (im_) * 16384 + n_ * 128 + (((4 * ch_ + q_) ^ cx_) << 2));                        \
            *(v4u*)((dst_) + (size_t)n_ * DM + 16 * ch_) = (v4u){(unsigned)w_[0], (unsigned)w_[1], (unsigned)w_[2], (unsigned)w_[3]}; } } while (0)
    int ic = it.next(); CvJob jc = cv_decode(ic < lim ? ic : 0, a);
    if (ic < lim) {
        int in_ = it.next(); CvJob jn = cv_decode(in_ < lim ? in_ : 0, a);
        CVD_ISSUE(jc, 0, 0); CVD_ISSUE(jc, 1, 1);
        int slot = 0, imc = 0, have_prev = 0; unsigned char* dprev = nullptr;
        for (int h = 0;; ++h) {
            const int p = h & 1;
            CVD_BAR(4);
            if (p == 0 && have_prev) { CVD_FLUSH(imc ^ 1, dprev); have_prev = 0; }
            {
                f32x4 v[4];
#pragma unroll
                for (int r = 0; r < 4; ++r) v[r] = *(const f32x4*)(lds + slot * 32768 + (4 * kr + r) * 512 + c4 * 16);
#pragma unroll
                for (int j = 0; j < 4; ++j) { int d = __builtin_amdgcn_cvt_pk_fp8_f32(v[0][j] * W8_SCALE, v[1][j] * W8_SCALE, 0, false);
                    d = __builtin_amdgcn_cvt_pk_fp8_f32(v[2][j] * W8_SCALE, v[3][j] * W8_SCALE, d, true);
                    *(int*)(img + imc * 16384 + (4 * c4 + j) * 128 + (((16 * p + kr) ^ c4) << 2)) = d; } }
            { const int s2 = slot + 2 >= 3 ? slot - 1 : slot + 2; CVD_ISSUE(jn, p, s2); }
            slot = slot + 1 >= 3 ? 0 : slot + 1;
            if (p == 1) { dprev = (unsigned char*)jc.dst; have_prev = 1; imc ^= 1; jc = jn; ic = in_; if (ic >= lim) break; in_ = it.next(); jn = cv_decode(in_ < lim ? in_ : 0, a); }
        }
        CVD_BAR(0);
        if (have_prev) CVD_FLUSH(imc ^ 1, dprev);
    }
#undef CVD_ISSUE
#undef CVD_BAR
#undef CVD_FLUSH
    __syncthreads();
}
__device__ __forceinline__ void p0_prologue(const Args& a, unsigned char* lds, int tid, int lane, int wave, int bid, int G) {
    {
        float* wfT = (float*)(lds + 65536);
        f32x4 g1v[8];
#pragma unroll
        for (int j = 0; j < 8; ++j) g1v[j] = ((const f32x4*)a.in[I_G1])[lane + 64 * j];
        const float bfv = a.in[I_BF][lane & 7];
        const int rstep = G * NWAVES; int row = bid * NWAVES + wave;
        f32x4 v[8], vn[8];
#define P0_XROW(r) ((r) < SEQ ? a.in[I_X] + (size_t)(r) * DM : a.in[I_META] + (size_t)((r) - SEQ) * DM)
        { const int lr = row < LTOT ? row : 0; const float* xr = P0_XROW(lr);
#pragma unroll
          for (int j = 0; j < 8; ++j) v[j] = ((const f32x4*)xr)[lane + 64 * j]; }
        asm volatile("" ::: "memory"); __builtin_amdgcn_sched_barrier(0);
#pragma unroll
        for (int i = 0; i < DM / NTHREADS; ++i) { const int k = tid + i * NTHREADS; const f32x4 w0 = *(const f32x4*)(a.in[I_WIN] + (size_t)k * INCOLS + 3072), w1 = *(const f32x4*)(a.in[I_WIN] + (size_t)k * INCOLS + 3076);
#pragma unroll
            for (int hh = 0; hh < 4; ++hh) { wfT[hh * DM + k] = w0[hh]; wfT[(4 + hh) * DM + k] = w1[hh]; } }
        __syncthreads();
        bf16* HN = (bf16*)(a.ws + WS_HN); float* LOGF = (float*)(a.ws + WS_LOGF);
        for (; row < MIN_ROWS; row += rstep) {
            { const int nr = row + rstep, lr = nr < LTOT ? nr : 0; const float* xr = P0_XROW(lr);
#pragma unroll
              for (int j = 0; j < 8; ++j) vn[j] = ((const f32x4*)xr)[lane + 64 * j];
              asm volatile("" ::: "memory"); __builtin_amdgcn_sched_barrier(0); }
            bf16* orow = HN + (size_t)row * DM;
            if (row >= LTOT) {
#pragma unroll
                for (int j = 0; j < 4; ++j) ((v4u*)orow)[lane + 64 * j] = (v4u){0u, 0u, 0u, 0u};
            } else {
                float ss = 0.f;
#pragma unroll
                for (int j = 0; j < 8; ++j) ss += (v[j][0] * v[j][0] + v[j][1] * v[j][1]) + (v[j][2] * v[j][2] + v[j][3] * v[j][3]);
                ss = wave_sum(ss);
                const float rstd = 1.0f / sqrtf(ss * (1.0f / DM) + NORM_EPS);
                float fa[8];
#pragma unroll
                for (int hh = 0; hh < 8; ++hh) fa[hh] = 0.f;
#pragma unroll
                for (int j = 0; j < 8; ++j) { const f32x4 y = v[j] * rstd * g1v[j];
                    ((v2u*)orow)[lane + 64 * j] = (v2u){pk2(y[0], y[1]), pk2(y[2], y[3])};
#pragma unroll
                    for (int hh = 0; hh < 8; ++hh) { const f32x4 wv = *(const f32x4*)(wfT + hh * DM + 256 * j + 4 * lane); fa[hh] += (y[0] * wv[0] + y[1] * wv[1]) + (y[2] * wv[2] + y[3] * wv[3]); } }
#pragma unroll
                for (int hh = 0; hh < 8; ++hh) fa[hh] = wave_sum(fa[hh]);
                if (lane < 8) {
                    float z = fa[0];
#pragma unroll
                    for (int hh = 1; hh < 8; ++hh) z = lane == hh ? fa[hh] : z;
                    z += bfv;
                    const float lf = fminf(z, 0.f) - log1pf(expf(-fabsf(z)));
                    const int pos = row < SEQ ? NMETA + row : row - SEQ;
                    LOGF[pos * 8 + lane] = lf; }
            }
#pragma unroll
            for (int j = 0; j < 8; ++j) v[j] = vn[j];
        }
#undef P0_XROW
        if (bid == 0) {
            bf16* Kb = (bf16*)(a.ws + WS_K); bf16* Vb = (bf16*)(a.ws + WS_V);
            for (int idx = tid; idx < NHEAD * 768; idx += NTHREADS) { const int head = idx / 768, o = idx - head * 768;
                ((v4u*)(Kb + (size_t)head * SKV * HDIM))[o] = (v4u){0u, 0u, 0u, 0u}; ((v4u*)(Vb + (size_t)head * SKV * HDIM))[o] = (v4u){0u, 0u, 0u, 0u}; } }
        __syncthreads();
    }
    cv_stream<0>(a, lds, nullptr, nullptr, tid, bid, G);
}
__device__ __forceinline__ void p1_cumsum(const Args& a, unsigned char* lds, int tid, int lane, int wave, int head) {
    const float* LOGF = (const float*)(a.ws + WS_LOGF); float* CS = (float*)(a.ws + WS_CS) + (size_t)head * SKV;
    float* wsum = (float*)lds;
    float loc[17]; float s = 0.f;
#pragma unroll
    for (int i = 0; i < 17; ++i) { const int p = 17 * tid + i; const float v = p < LTOT ? LOGF[p * 8 + head] : 0.f; s += v; loc[i] = s; }
    float incl = s;
#pragma unroll
    for (int o = 1; o < 64; o <<= 1) { const float n = __shfl_up(incl, o); if (lane >= o) incl += n; }
    if (lane == 63) wsum[wave] = incl;
    __syncthreads();
    float woff = 0.f;
    for (int w = 0; w < wave; ++w) woff += wsum[w];
    const float excl = woff + incl - s;
#pragma unroll
    for (int i = 0; i < 17; ++i) { const int p = 17 * tid + i; if (p < LTOT) { const float cv = (excl + loc[i]) * INV_SCALE; CS[48 + p] = cv; CS[fox::NC_OFF + 48 + p] = -cv; } }
    if (tid < 48) { CS[tid] = __builtin_inff(); CS[fox::NC_OFF + tid] = -__builtin_inff(); }
    __syncthreads();
}

constexpr int N_ATT_ENT = 80, N_ATT_ITEMS = N_ATT_ENT * NHEAD, CONV_TOK = 32, N_CONV_ITEMS = SEQ / CONV_TOK, N_P2_ITEMS = N_ATT_ITEMS + N_CONV_ITEMS;
__device__ const unsigned short ATT_TAB[N_ATT_ENT] = {
    1151, 855, 559, 263, 1055, 1087, 1119, 1150, 791, 823, 527, 1054, 1086, 1118, 1149, 790, 822, 854, 558, 1053, 1085, 1117, 1148, 821, 853, 526, 1052, 1084, 1116, 1147, 789, 852, 557, 262, 1051, 1083,
    1115, 1146, 788, 820, 525, 1050, 1082, 1114, 1145, 787, 819, 851, 556, 1049, 1081, 1113, 1144, 818, 850, 524, 1048, 1080, 1112, 786, 849, 555, 261, 785, 817, 523, 784, 816, 848, 554, 522, 553, 260, 521,
    552, 520, 259, 258, 257, 256};
__device__ __forceinline__ fox::FoxRef att_decode(int L, const Args& a, const unsigned* ctl) {
    const int ent = L >> 3, head = L & 7; const unsigned t = ATT_TAB[ent]; const int qb = t & 31, part = (t >> 5) & 7, np = t >> 8, NT = 4 * qb + 5;
    fox::FoxRef r;
    r.Q = (const fox::bf16*)(a.ws + WS_Q) + ((size_t)head * SEQ + (size_t)qb * 256) * HDIM;
    r.K = (const fox::bf16*)(a.ws + WS_K) + (size_t)head * SKV * HDIM; r.V = (const fox::bf16*)(a.ws + WS_V) + (size_t)head * SKV * HDIM;
    r.C = (const float*)(a.ws + WS_CS) + (size_t)head * SKV;
    r.P0 = 64 + 256 * qb; r.j_lo = part * NT / np; r.j_hi = (part + 1) * NT / np;
    {
        int lane = threadIdx.x & 63; asm volatile("" : "+v"(lane));
        float cv[3]; const float c0 = r.C[r.P0];
#pragma unroll
        for (int rep = 0; rep < 3; ++rep) { const int t = lane + 64 * rep; cv[rep] = r.C[64 * (t < NT ? t : 0) + 63]; }
        const unsigned* nr = ctl + CW_NORM; float q2 = 0.f, k2 = 0.f;
#pragma unroll
        for (int w = 0; w < 4; ++w) { q2 += __uint_as_float(__hip_atomic_load(nr + head * 4 + w, RLX_AGENT)); k2 += __uint_as_float(__hip_atomic_load(nr + (8 + head) * 4 + w, RLX_AGENT)); }
        const float Bnd = sqrtf(q2 * k2) * fox::SCALE * 1.02f, limit = c0 + (2.0f * Bnd + 110.0f) * INV_SCALE;
        int cnt = 0;
#pragma unroll
        for (int rep = 0; rep < 3; ++rep) { const int t = lane + 64 * rep; const bool past = t < NT && cv[rep] > limit; cnt += __popcll(__ballot(past)); }
        const int jmin = __builtin_amdgcn_readfirstlane(cnt);
        const int jl = jmin < r.j_hi - 1 ? jmin : r.j_hi - 1;
        r.dummy = jmin >= r.j_hi ? 1 : 0;
        if (jl > r.j_lo) r.j_lo = jl; }
    const int slot = (head * 32 + qb) * 4 + part; r.O = (fox::bf16*)(a.ws + WS_OPART) + (size_t)slot * 256 * HDIM; r.ML = (float*)(a.ws + WS_ML) + (size_t)slot * 512;
    return r;
}
__device__ __forceinline__ void conv_item(const Args& a, unsigned char* lds, int tid, int it) {
    const int i0 = it * CONV_TOK, pos0 = NMETA + i0;
    const bf16* U = (const bf16*)(a.ws + WS_U); bf16* MIX = (bf16*)(a.ws + WS_MIXED);
#pragma unroll 1
    for (int h = 0; h < 2; ++h) {
        v4u v[8];
#pragma unroll
        for (int i = 0; i < 8; ++i) { const int idx = tid + (h * 8 + i) * NTHREADS, row = idx >> 7, ch = idx & 127, p = pos0 - 30 + row;
            v[i] = (v4u){0u, 0u, 0u, 0u}; if (idx < 62 * 128 && p >= 0) v[i] = *(const v4u*)(U + (size_t)p * 1024 + ch * 8); }
#pragma unroll
        for (int i = 0; i < 8; ++i) { const int idx = tid + (h * 8 + i) * NTHREADS, row = idx >> 7, ch = idx & 127; if (idx < 62 * 128) *(v4u*)(lds + row * 2048 + ch * 16) = v[i]; } }
    const int c = 2 * tid;
    float cw0[CKW], cw1[CKW];
#pragma unroll
    for (int w = 0; w < CKW; ++w) { const float2 t = *(const float2*)(a.in[I_CW] + w * 1024 + c); cw0[w] = t.x; cw1[w] = t.y; }
    const float2 cb = *(const float2*)(a.in[I_CB] + c), gg = *(const float2*)(a.in[I_GNG] + c), gb = *(const float2*)(a.in[I_GNB] + c);
    __syncthreads();
#pragma unroll 1
    for (int tg = 0; tg < CONV_TOK; tg += 4) {
        float a0[4], a1[4];
#pragma unroll
        for (int q = 0; q < 4; ++q) { a0[q] = cb.x; a1[q] = cb.y; }
#pragma unroll
        for (int r = 0; r < CKW + 3; ++r) { const unsigned pk = *(const unsigned*)(lds + (tg + r) * 2048 + c * 2); const float x0 = bf_lo(pk), x1 = bf_hi(pk);
#pragma unroll
            for (int q = 0; q < 4; ++q) { const int w = r - q; if (w >= 0 && w < CKW) { a0[q] += x0 * cw0[w]; a1[q] += x1 * cw1[w]; } } }
        float sm[4], d0[4], d1[4], vr[4];
#pragma unroll
        for (int q = 0; q < 4; ++q) sm[q] = a0[q] + a1[q];
#pragma unroll
        for (int o = 1; o < 64; o <<= 1)
#pragma unroll
            for (int q = 0; q < 4; ++q) sm[q] += __shfl_xor(sm[q], o);
#pragma unroll
        for (int q = 0; q < 4; ++q) { const float mu = sm[q] * (1.0f / 128.0f); d0[q] = a0[q] - mu; d1[q] = a1[q] - mu; vr[q] = d0[q] * d0[q] + d1[q] * d1[q]; }
#pragma unroll
        for (int o = 1; o < 64; o <<= 1)
#pragma unroll
            for (int q = 0; q < 4; ++q) vr[q] += __shfl_xor(vr[q], o);
#pragma unroll
        for (int q = 0; q < 4; ++q) { const float rs = 1.0f / sqrtf(vr[q] * (1.0f / 128.0f) + NORM_EPS);
            const float y0 = d0[q] * rs * gg.x + gb.x, y1 = d1[q] * rs * gg.y + gb.y;
            const float s0 = y0 * __builtin_amdgcn_rcpf(1.0f + __builtin_amdgcn_exp2f(-1.4426950408889634f * y0)), s1 = y1 * __builtin_amdgcn_rcpf(1.0f + __builtin_amdgcn_exp2f(-1.4426950408889634f * y1));
            *(unsigned*)(MIX + (size_t)(i0 + tg + q) * DM + 1024 + c) = pk2(s0, s1); }
    }
    __syncthreads();
}
#ifndef P2_REP_ATT
#define P2_REP_ATT 1u
#endif
#ifndef P2_REP_CONV
#define P2_REP_CONV 1u
#endif
__device__ __forceinline__ unsigned p2_pop(unsigned* ctl, unsigned x, volatile LAS unsigned* MISC) {
    unsigned s = MISC[5];
    while (s < 8u) { const unsigned h = (x + s) & 7u; const unsigned i = __hip_atomic_fetch_add(ctl + CW_QUEUE + 16 * h, 1u, RLX_AGENT); if (i < (unsigned)N_ATT_ENT * P2_REP_ATT) { MISC[5] = s; return (i % (unsigned)N_ATT_ENT) * 8u + h; } ++s; }
    MISC[5] = 8u;
    { const unsigned i = __hip_atomic_fetch_add(ctl + CW_QUEUE + 16 * 8, 1u, RLX_AGENT); return (unsigned)N_ATT_ITEMS + (i < (unsigned)N_CONV_ITEMS * P2_REP_CONV ? i % (unsigned)N_CONV_ITEMS : (unsigned)N_CONV_ITEMS); }
}
__device__ __forceinline__ void p2_attn_conv(const Args& a, unsigned char* lds, volatile LAS unsigned* MISC, unsigned* ctl, int tid, unsigned xcc, int bid, int G) {
    const bool cv_first = ((bid >> 3) & 15) >= 7;
    if (cv_first) cv_stream_dma<1>(a, lds, MISC, ctl + CW_QUEUE + 16 * 9, tid, bid, G, CV_P1_JOBS);
    if (tid == 0) { MISC[5] = 0u; MISC[0] = p2_pop(ctl, xcc, MISC); MISC[1] = p2_pop(ctl, xcc, MISC); }
    __syncthreads();
    int ia = __builtin_amdgcn_readfirstlane((int)MISC[0]), ib = __builtin_amdgcn_readfirstlane((int)MISC[1]);
    __syncthreads();
    if (ia < N_ATT_ITEMS) {
        fox::FoxRef cur = att_decode(ia, a, ctl); fox::FoxSeam S; S.unused = 0;
        bool primed = false;
        for (int k = 0;; ++k) {
            if (tid == 0) MISC[2 + (k & 1)] = p2_pop(ctl, xcc, MISC);
            const bool last = ib >= N_ATT_ITEMS;
            const fox::FoxRef nxt = last ? cur : att_decode(ib, a, ctl);
            if (cur.dummy) {
                if (tid < 256) *(float2*)(cur.ML + tid * 2) = make_float2(-1e30f, 0.f);
                primed = false; __syncthreads();
            } else {
                if (!primed) fox::fox_prime(cur, (char*)lds, S);
                fox::fox_block(cur, nxt, (char*)lds, S);
                primed = true;
            }
            ia = ib; ib = __builtin_amdgcn_readfirstlane((int)MISC[2 + (k & 1)]);
            if (last) break;
            cur = nxt;
        }
    }
    __syncthreads();
    while (ia < N_P2_ITEMS) {
        if (tid == 0) MISC[4] = p2_pop(ctl, xcc, MISC);
        conv_item(a, lds, tid, ia - N_ATT_ITEMS);
        ia = ib; ib = __builtin_amdgcn_readfirstlane((int)MISC[4]);
        __syncthreads();
    }
    if (!cv_first) cv_stream_dma<1>(a, lds, MISC, ctl + CW_QUEUE + 16 * 9, tid, bid, G, CV_P1_JOBS);
}

__device__ __forceinline__ void p3_combine(const Args& a, int lane, int gw, int NGW) {
    const float C2 = 1.4426950408889634f * fox::SCALE;
    const bf16* OP = (const bf16*)(a.ws + WS_OPART); const float* ML = (const float*)(a.ws + WS_ML); bf16* MIX = (bf16*)(a.ws + WS_MIXED);
    float2 ml[4][4], mln[4][4]; unsigned pk[4][4], pkn[4][4];
#define P3_LOAD(MLr, PKr, r0_) do { const int blk_ = (r0_) >> 8, np_ = ((blk_ & 31) >> 3) + 1, slot_ = blk_ * 4;                                               \
        _Pragma("unroll") for (int q = 0; q < 4; ++q) _Pragma("unroll") for (int p = 0; p < 4; ++p) { const int pp_ = p < np_ ? p : np_ - 1, row_ = ((r0_) & 255) + q; \
            MLr[q][p] = *(const float2*)(ML + (size_t)(slot_ + pp_) * 512 + row_ * 2); PKr[q][p] = *(const unsigned*)(OP + ((size_t)(slot_ + pp_) * 256 + row_) * HDIM + 2 * lane); } \
        asm volatile("" ::: "memory"); __builtin_amdgcn_sched_barrier(0); } while (0)
    int r0 = 4 * gw;
    if (r0 < 256 * 256) P3_LOAD(ml, pk, r0);
    for (; r0 < 256 * 256; r0 += 4 * NGW) {
        { const int rn = r0 + 4 * NGW < 256 * 256 ? r0 + 4 * NGW : r0; P3_LOAD(mln, pkn, rn); }
        const int blk = r0 >> 8, head = blk >> 5, qb = blk & 31, np = (qb >> 3) + 1;
#pragma unroll
        for (int q = 0; q < 4; ++q) { const int row = (r0 & 255) + q; float M = -3.0e38f;
#pragma unroll
            for (int p = 0; p < 4; ++p) if (p < np && ml[q][p].y > 0.f) M = fmaxf(M, ml[q][p].x);
            float a0 = 0.f, a1 = 0.f, den = 0.f;
#pragma unroll
            for (int p = 0; p < 4; ++p) if (p < np && ml[q][p].y > 0.f) { const float w = __builtin_amdgcn_exp2f((ml[q][p].x - M) * C2) * ml[q][p].y; a0 += w * bf_lo(pk[q][p]); a1 += w * bf_hi(pk[q][p]); den += w; }
            const float inv = den > 0.f ? 1.0f / den : 0.f;
            *(unsigned*)(MIX + (size_t)(qb * 256 + row) * DM + head * HDIM + 2 * lane) = pk2(a0 * inv, a1 * inv); }
#pragma unroll
        for (int q = 0; q < 4; ++q)
#pragma unroll
            for (int p = 0; p < 4; ++p) { ml[q][p] = mln[q][p]; pk[q][p] = pkn[q][p]; }
    }
#undef P3_LOAD
}

__device__ __forceinline__ void p5_router(const Args& a, unsigned char* lds, unsigned* ctl, int tid, int lane, int wave, int bid, int G) {
    const float* Hh = (const float*)(a.ws + WS_H); unsigned char* HN2 = a.ws + WS_HN2;
    int* TE = (int*)(a.ws + WS_ROUTE); int* TS = TE + SEQ * 4; float* TG = (float*)(TS + SEQ * 4);
    float* part = (float*)lds; float* ssq = part + 8 * 32 * 33; float* logit = ssq + 8 * 32; float* rstd_l = logit + 32 * 33; unsigned* lcnt = (unsigned*)(rstd_l + 32);
    unsigned* CNTW = (unsigned*)(a.ws + WS_ROUTE) + 4 * SEQ * 4;
    const float* g2 = a.in[I_G2]; const float* rw = a.in[I_RW];
    for (int grp = bid; grp < SEQ / 32; grp += G) {
        const int t0 = grp * 32, i = lane & 31, kk = lane >> 5, kb = wave * 256;
        f32x16 acc = {}, accb = {}; float ss = 0.f;
        const float* hrow = Hh + (size_t)(t0 + i) * DM + kb + 4 * kk;
        f32x4 hA[4], gA[4], hB[4], gB[4], hC[4], gC[4]; float rA[4][4], rB[4][4], rC[4][4];
        unsigned rwo = (unsigned)((4 * kk * NEXP + i) * 4), g2o = (unsigned)(4 * kk * 4); asm volatile("" : "+v"(rwo), "+v"(g2o));
        const char* rwb = (const char*)(rw + (size_t)kb * NEXP); const char* g2b = (const char*)(g2 + kb);
#define P5_LOAD(H, Gv, R, c0) do { _Pragma("unroll") for (int c = 0; c < 4; ++c) {                                                                             \
            H[c] = *(const f32x4*)(hrow + 8 * ((c0) + c)); Gv[c] = *(const f32x4*)(g2b + g2o + 32 * ((c0) + c));                                              \
            _Pragma("unroll") for (int q = 0; q < 4; ++q) R[c][q] = *(const float*)(rwb + rwo + (8 * ((c0) + c) + q) * (NEXP * 4)); }                          \
        asm volatile("" ::: "memory"); __builtin_amdgcn_sched_barrier(0); } while (0)
#define P5_MMA(H, Gv, R) do { _Pragma("unroll") for (int c = 0; c < 4; ++c) { _Pragma("unroll") for (int q = 0; q < 4; q += 2) {                               \
            acc = __builtin_amdgcn_mfma_f32_32x32x2f32(H[c][q], R[c][q] * Gv[c][q], acc, 0, 0, 0);                                                              \
            accb = __builtin_amdgcn_mfma_f32_32x32x2f32(H[c][q + 1], R[c][q + 1] * Gv[c][q + 1], accb, 0, 0, 0);                                                \
            ss += H[c][q] * H[c][q] + H[c][q + 1] * H[c][q + 1]; } } __builtin_amdgcn_sched_barrier(0); } while (0)
        P5_LOAD(hA, gA, rA, 0); P5_LOAD(hB, gB, rB, 4); P5_LOAD(hC, gC, rC, 8);
        P5_MMA(hA, gA, rA); P5_LOAD(hA, gA, rA, 12);
        P5_MMA(hB, gB, rB); P5_LOAD(hB, gB, rB, 16);
        P5_MMA(hC, gC, rC); P5_LOAD(hC, gC, rC, 20);
        P5_MMA(hA, gA, rA); P5_LOAD(hA, gA, rA, 24);
        P5_MMA(hB, gB, rB); P5_LOAD(hB, gB, rB, 28);
        P5_MMA(hC, gC, rC); P5_MMA(hA, gA, rA); P5_MMA(hB, gB, rB);
#undef P5_LOAD
#undef P5_MMA
#pragma unroll
        for (int r = 0; r < 16; ++r) acc[r] += accb[r];
        const float rb0 = a.in[I_RB][2 * (tid & 15)], rb1 = a.in[I_RB][2 * (tid & 15) + 1];
        f32x4 gv[8], hv[4][8];
#pragma unroll
        for (int j = 0; j < 8; ++j) gv[j] = ((const f32x4*)g2)[lane + 64 * j];
#pragma unroll
        for (int r = 0; r < 4; ++r) { const float* hr = Hh + (size_t)(t0 + wave * 4 + r) * DM;
#pragma unroll
            for (int j = 0; j < 8; ++j) hv[r][j] = ((const f32x4*)hr)[lane + 64 * j]; }
        asm volatile("" ::: "memory"); __builtin_amdgcn_sched_barrier(0);
        ss += __shfl_xor(ss, 32);
        if (kk == 0) ssq[wave * 32 + i] = ss;
        if (tid < NEXP) lcnt[tid] = 0u;
#pragma unroll
        for (int r = 0; r < 16; ++r) { const int row = (r & 3) + 8 * (r >> 2) + 4 * kk; part[(wave * 32 + row) * 33 + i] = acc[r]; }
        __syncthreads();
        { const int tk = tid >> 4, e0 = 2 * (tid & 15); float sq = 0.f;
#pragma unroll
          for (int w = 0; w < 8; ++w) sq += ssq[w * 32 + tk];
          const float rs = 1.0f / sqrtf(sq * (1.0f / DM) + NORM_EPS);
          if ((tid & 15) == 0) rstd_l[tk] = rs;
#pragma unroll
          for (int d = 0; d < 2; ++d) { float s = 0.f;
#pragma unroll
              for (int w = 0; w < 8; ++w) s += part[(w * 32 + tk) * 33 + e0 + d];
              logit[tk * 33 + e0 + d] = s * rs + (d ? rb1 : rb0); } }
        __syncthreads();
        if (tid < 32) {
            unsigned taken = 0u; float tv[4]; int ti[4];
#pragma unroll
            for (int k = 0; k < 4; ++k) { float best = -3.0e38f; int bi = 0;
                for (int e = 0; e < NEXP; ++e) { const float v = logit[tid * 33 + e]; if (!((taken >> e) & 1u) && v > best) { best = v; bi = e; } }
                taken |= 1u << bi; tv[k] = best; ti[k] = bi; }
            float w[4], sum = 0.f;
#pragma unroll
            for (int k = 0; k < 4; ++k) { w[k] = expf(tv[k] - tv[0]); sum += w[k]; }
            const float inv = 1.0f / sum;
#pragma unroll
            for (int k = 0; k < 4; ++k) { const unsigned lr = atomicAdd(&lcnt[ti[k]], 1u);
                TE[(t0 + tid) * 4 + k] = ti[k]; TS[(t0 + tid) * 4 + k] = (int)lr; TG[(t0 + tid) * 4 + k] = w[k] * inv; }
        }
        __syncthreads();
        if (tid < NEXP) CNTW[grp * NEXP + tid] = lcnt[tid];
        {
#pragma unroll
            for (int r = 0; r < 4; ++r) { const int tk = wave * 4 + r; const float rs = rstd_l[tk]; unsigned char* orow = HN2 + (size_t)(t0 + tk) * DM;
#pragma unroll
                for (int j = 0; j < 8; ++j) { const f32x4 y = hv[r][j] * rs * gv[j];
                    int d = __builtin_amdgcn_cvt_pk_fp8_f32(y[0], y[1], 0, false); d = __builtin_amdgcn_cvt_pk_fp8_f32(y[2], y[3], d, true);
                    ((int*)orow)[lane + 64 * j] = d; } } }
        __syncthreads();
    }
}

__device__ __forceinline__ void p6_gather(const Args& a, unsigned char* lds, unsigned* ctl, int tid, int lane, int wave, int bid, int G) {
    const unsigned* CNTW = (const unsigned*)(a.ws + WS_ROUTE) + 4 * SEQ * 4;
    int* psum = (int*)lds;
    int* tst = psum + 16 * NEXP;
    int* gbase = tst + NEXP;
    const int* TE = (const int*)(a.ws + WS_ROUTE); const int* TS = TE + SEQ * 4; int* TR = (int*)(a.ws + WS_ROUTE) + 3 * SEQ * 4;
    const unsigned char* HN2 = a.ws + WS_HN2; unsigned char* XG = a.ws + WS_XG;
    const int g0 = bid < SEQ / 32 ? bid : 0;
    v4u v[4][2]; int te[4][4], ts[4][4]; int c2[15];
#define P6_LOADG(grp_) do { _Pragma("unroll") for (int r = 0; r < 4; ++r) { const int t = (grp_) * 32 + wave * 4 + r;                                   \
            _Pragma("unroll") for (int j = 0; j < 2; ++j) v[r][j] = ((const v4u*)(HN2 + (size_t)t * DM))[lane + 64 * j];                                \
            _Pragma("unroll") for (int k = 0; k < 4; ++k) { te[r][k] = TE[t * 4 + k]; ts[r][k] = TS[t * 4 + k]; } }                                     \
        _Pragma("unroll") for (int u = 0; u < 15; ++u) { const int w = ((grp_) >> 4) * 16 + u; c2[u] = (int)CNTW[(w < (grp_) ? w : 0) * NEXP + (tid & 31)]; } \
        asm volatile("" ::: "memory"); __builtin_amdgcn_sched_barrier(0); } while (0)
    P6_LOADG(g0);
    { const int e = tid & 31, p = tid >> 5; int s = 0;
#pragma unroll
      for (int w = 0; w < 16; ++w) s += (int)CNTW[(p * 16 + w) * NEXP + e];
      psum[p * NEXP + e] = s; }
    __syncthreads();
    if (tid < 64) {
        int c = 0;
        if (tid < NEXP) {
#pragma unroll
            for (int p = 0; p < 16; ++p) c += psum[p * NEXP + tid]; }
        const int nt = (c + 255) >> 8; int incl = nt;
#pragma unroll
        for (int o = 1; o < 32; o <<= 1) { const int n = __shfl_up(incl, o); if ((tid & 63) >= o) incl += n; }
        const int s0 = incl - nt;
        if (tid < NEXP) { tst[tid] = s0;
            if (bid == 0) { for (int i = 0; i < nt; ++i) ctl[CW_TEXP + s0 + i] = (unsigned)tid; if (tid == NEXP - 1) ctl[CW_NT] = (unsigned)incl; } }
    }
    __syncthreads();
    for (int grp = bid; grp < SEQ / 32; grp += G) {
        if (grp != g0) { P6_LOADG(grp); }
        if (tid < NEXP) { int s = 0; const int pp = grp >> 4; for (int p = 0; p < pp; ++p) s += psum[p * NEXP + tid];
#pragma unroll
            for (int u = 0; u < 15; ++u) s += (pp * 16 + u < grp) ? c2[u] : 0;
            gbase[tid] = tst[tid] * 256 + s; }
        __syncthreads();
        {
#pragma unroll
            for (int r = 0; r < 4; ++r) { const int t = grp * 32 + wave * 4 + r;
#pragma unroll
                for (int k = 0; k < 4; ++k) { const int row = gbase[te[r][k]] + ts[r][k];
                    if (lane == 0) TR[t * 4 + k] = row;
#pragma unroll
                    for (int j = 0; j < 2; ++j) ((v4u*)(XG + (size_t)row * DM))[lane + 64 * j] = v[r][j]; } } }
        __syncthreads();
    }
#undef P6_LOADG
}

__device__ __forceinline__ void p9_final(const Args& a, int lane, int gw, int NGW) {
    const float* Hh = (const float*)(a.ws + WS_H); const unsigned char* Y = a.ws + WS_Y;
    const float* TG = (const float*)(a.ws + WS_ROUTE) + 2 * SEQ * 4; const int* TR = (const int*)(a.ws + WS_ROUTE) + 3 * SEQ * 4;
    typedef float f32x2_ __attribute__((ext_vector_type(2)));
    f32x4 gfv[8];
#pragma unroll
    for (int j = 0; j < 8; ++j) gfv[j] = ((const f32x4*)a.in[I_GF])[lane + 64 * j];
    f32x4 tg[2], tgn[2]; int tr[2][4], trn[2][4];
    int t0 = 2 * gw;
    { const int tl = t0 < SEQ ? t0 : 0;
#pragma unroll
      for (int q = 0; q < 2; ++q) { tg[q] = *(const f32x4*)(TG + (tl + q) * 4);
#pragma unroll
          for (int k = 0; k < 4; ++k) tr[q][k] = TR[(tl + q) * 4 + k]; } }
    for (; t0 < SEQ; t0 += 2 * NGW) {
        f32x4 v[2][8];
        { const int tn = t0 + 2 * NGW < SEQ ? t0 + 2 * NGW : t0;
#pragma unroll
          for (int q = 0; q < 2; ++q) { tgn[q] = *(const f32x4*)(TG + (tn + q) * 4);
#pragma unroll
              for (int k = 0; k < 4; ++k) trn[q][k] = TR[(tn + q) * 4 + k]; } }
#pragma unroll
        for (int q = 0; q < 2; ++q) {
#pragma unroll
            for (int j = 0; j < 8; ++j) v[q][j] = ((const f32x4*)(Hh + (size_t)(t0 + q) * DM))[lane + 64 * j]; }
        int pk[2][4][8];
#pragma unroll
        for (int q = 0; q < 2; ++q)
#pragma unroll
            for (int k = 0; k < 4; ++k) { const unsigned char* yr = Y + (size_t)tr[q][k] * DM;
#pragma unroll
                for (int j = 0; j < 8; ++j) pk[q][k][j] = ((const int*)yr)[lane + 64 * j]; }
        asm volatile("" ::: "memory"); __builtin_amdgcn_sched_barrier(0);
#pragma unroll
        for (int q = 0; q < 2; ++q) {
#pragma unroll
            for (int k = 0; k < 4; ++k) { const float g = tg[q][k];
#pragma unroll
                for (int j = 0; j < 8; ++j) { const f32x2_ lo = __builtin_amdgcn_cvt_pk_f32_fp8(pk[q][k][j], false), hi = __builtin_amdgcn_cvt_pk_f32_fp8(pk[q][k][j], true);
                    v[q][j][0] += g * lo[0]; v[q][j][1] += g * lo[1]; v[q][j][2] += g * hi[0]; v[q][j][3] += g * hi[1]; } }
            float ss = 0.f;
#pragma unroll
            for (int j = 0; j < 8; ++j) ss += (v[q][j][0] * v[q][j][0] + v[q][j][1] * v[q][j][1]) + (v[q][j][2] * v[q][j][2] + v[q][j][3] * v[q][j][3]);
            ss = wave_sum(ss);
            const float rstd = 1.0f / sqrtf(ss * (1.0f / DM) + NORM_EPS);
#pragma unroll
            for (int j = 0; j < 8; ++j) ((f32x4*)(a.out + (size_t)(t0 + q) * DM))[lane + 64 * j] = v[q][j] * rstd * gfv[j]; }
#pragma unroll
        for (int q = 0; q < 2; ++q) {
#pragma unroll
            for (int k = 0; k < 4; ++k) { tg[q][k] = __uint_as_float(__builtin_amdgcn_readfirstlane(__float_as_uint(tgn[q][k]))); tr[q][k] = __builtin_amdgcn_readfirstlane(trn[q][k]); } }
    }
}

#ifndef MK_PER_PHASE
#define MK_PER_PHASE 0
#endif
constexpr int N_PHASES = 10;
#ifndef PROBE_TS
#define PROBE_TS 0
#endif

#ifndef PROBE_DBL
#define PROBE_DBL 0
#endif
template <int LO, int HI> __global__ void __launch_bounds__(NTHREADS, 2) hymba_fwd(Args a_in) {
    extern __shared__ __attribute__((aligned(16))) unsigned char lds[];
    const int tid0 = threadIdx.x, bid = blockIdx.x, G = gridDim.x;
    volatile LAS unsigned* MISC = (volatile LAS unsigned*)((LAS unsigned char*)lds + MISC_OFF);
    unsigned* ctl = (unsigned*)(a_in.ws + WS_CTL);
#if defined(__HIP_DEVICE_COMPILE__)
#define PHASE_ARGS() const __attribute__((address_space(4))) Args* ap_ = (const __attribute__((address_space(4))) Args*)__builtin_amdgcn_kernarg_segment_ptr(); asm volatile("" : "+s"(ap_)); const Args a = *ap_; int tid = threadIdx.x; asm volatile("" : "+v"(tid)); const int lane = tid & 63, wave = __builtin_amdgcn_readfirstlane(tid >> 6), gw = bid * NWAVES + wave, NGW = G * NWAVES; (void)lane; (void)gw; (void)NGW
#else
#define PHASE_ARGS() const Args& a = a_in; const int tid = threadIdx.x, lane = tid & 63, wave = tid >> 6, gw = bid * NWAVES + wave, NGW = G * NWAVES; (void)lane; (void)gw; (void)NGW
#endif
    for (int u = tid0; u < (LDS_BYTES - MISC_OFF) / 4; u += NTHREADS) MISC[u] = 0u;
    __syncthreads();
    if (PROBE_TS && bid == 0 && tid0 == 0) ((unsigned long long*)(ctl + 16384))[0] = wall_clock64();
    XcdBarrier bar; bar.bar = ctl + CW_BAR; bar.x = 0; bar.st = nullptr;
    if (HI - LO > 1) bar = xcd_barrier_post(ctl + CW_BAR, MISC + 8);
#ifndef PH_MASK
#define PH_MASK 0x3ff
#endif
#define IN(k) ((((PH_MASK) >> (k)) & 1) && LO <= (k) && (k) < HI)
#define SEAM(k) do { if (IN(k) && IN((k) + 1)) { xcd_barrier(bar); if (PROBE_DBL & 1024) xcd_barrier(bar); if (PROBE_TS && bid == 0 && threadIdx.x == 0) ((unsigned long long*)(ctl + 16384))[(k) + 1] = wall_clock64(); } } while (0)

    if (IN(0)) { PHASE_ARGS(); p0_prologue(a, lds, tid, lane, wave, bid, G); if (PROBE_DBL & 1) { __syncthreads(); p0_prologue(a, lds, tid, lane, wave, bid, G); } } SEAM(0);
    if (IN(1)) { PHASE_ARGS();
        if (bid >= G - NHEAD) p1_cumsum(a, lds, tid, lane, wave, bid - (G - NHEAD));
        pg8::Gemm g{(const pg8::bf16_t*)(a.ws + WS_HN), (const pg8::bf16_t*)(a.ws + WS_WIN), MIN_ROWS, NIN, DM}; pg8::StaticOrder S; S.init(MIN_ROWS, NIN, G, bid);
        pg8::EpiIn E{(pg8::bf16_t*)(a.ws + WS_Q), WS_K - WS_Q, WS_V - WS_Q, (pg8::bf16_t*)(a.ws + WS_U), a.in[I_BGLU], ctl + CW_NORM};
        pg8::gemm_phase<pg8::EpiIn, pg8::StaticOrder, true, true>((PG8_LAS unsigned char*)lds, g, S, E);
        if (PROBE_DBL & 2) pg8::gemm_phase<pg8::EpiIn, pg8::StaticOrder, true, true>((PG8_LAS unsigned char*)lds, g, S, E);
        if (G == 256 && bid >= G - CV_P1_WGS) { __syncthreads(); cv_stream_dma<2>(a, lds, nullptr, nullptr, tid, bid, G, 0, bid - (G - CV_P1_WGS), CV_P1_WGS, CV_P1_NB); }
        else if (G != 256 && bid == 0) { __syncthreads(); cv_stream_dma<2>(a, lds, nullptr, nullptr, tid, bid, G, 0, 0, 1, CV_P1_WGS * CV_P1_NB); }
    } SEAM(1);
    if (IN(2)) { PHASE_ARGS(); p2_attn_conv(a, lds, MISC, ctl, tid, xb_xcc_id(), bid, G); } SEAM(2);
    if (IN(3)) { PHASE_ARGS(); p3_combine(a, lane, gw, NGW); if (PROBE_DBL & 8) p3_combine(a, lane, gw, NGW); } SEAM(3);
    if (IN(4)) { PHASE_ARGS();
        pg8::Gemm g{(const pg8::bf16_t*)(a.ws + WS_MIXED), (const pg8::bf16_t*)(a.ws + WS_WOUT), SEQ, DM, DM}; pg8::StaticOrder S; S.init(SEQ, DM, G, bid);
        pg8::EpiOut E{a.in[I_X], (float*)(a.ws + WS_H)};
        pg8::gemm_phase<pg8::EpiOut, pg8::StaticOrder, true, true>((PG8_LAS unsigned char*)lds, g, S, E);
        if (PROBE_DBL & 16) pg8::gemm_phase<pg8::EpiOut, pg8::StaticOrder, true, true>((PG8_LAS unsigned char*)lds, g, S, E);
    } SEAM(4);
    if (IN(5)) { PHASE_ARGS(); p5_router(a, lds, ctl, tid, lane, wave, bid, G); if (PROBE_DBL & 32) p5_router(a, lds, ctl, tid, lane, wave, bid, G); } SEAM(5);
    if (IN(6)) { PHASE_ARGS(); p6_gather(a, lds, ctl, tid, lane, wave, bid, G); if (PROBE_DBL & 64) p6_gather(a, lds, ctl, tid, lane, wave, bid, G); } SEAM(6);
    if (IN(7)) { PHASE_ARGS();
        const int T = (int)__hip_atomic_load(ctl + CW_NT, RLX_AGENT);
        pg8::Gemm g{(const pg8::bf16_t*)(a.ws + WS_XG), (const pg8::bf16_t*)(a.ws + WS_WGU), PROWS, NEXP * 4096, DM  }; for (int i = tid; i < MAXT; i += NTHREADS) MISC[64 + i] = __hip_atomic_load(ctl + CW_TEXP + i, RLX_AGENT);
        __syncthreads();
        pg8::GroupedOrder S; S.init((const volatile PG8_LAS int*)(MISC + 64), T, 16, G, bid);
        pg8::EpiGU E{a.ws + WS_ACT, a.in[I_BGU], W8_INV};
        pg8::gemm_phase<pg8::EpiGU, pg8::GroupedOrder, true, true, true>((PG8_LAS unsigned char*)lds, g, S, E);
        if (PROBE_DBL & 128) pg8::gemm_phase<pg8::EpiGU, pg8::GroupedOrder, true, true, true>((PG8_LAS unsigned char*)lds, g, S, E);
    } SEAM(7);
    if (IN(8)) { PHASE_ARGS();
        const int T = (int)__hip_atomic_load(ctl + CW_NT, RLX_AGENT);
        pg8::Gemm g{(const pg8::bf16_t*)(a.ws + WS_ACT), (const pg8::bf16_t*)(a.ws + WS_WDN), PROWS, NEXP * DM, DM}; for (int i = tid; i < MAXT; i += NTHREADS) MISC[64 + i] = __hip_atomic_load(ctl + CW_TEXP + i, RLX_AGENT);
        __syncthreads();
        pg8::GroupedOrder S; S.init((const volatile PG8_LAS int*)(MISC + 64), T, 8, G, bid);
        pg8::EpiDN E{a.ws + WS_Y, a.in[I_BDN], W8_INV};
        pg8::gemm_phase<pg8::EpiDN, pg8::GroupedOrder, true, true, true>((PG8_LAS unsigned char*)lds, g, S, E);
        if (PROBE_DBL & 256) pg8::gemm_phase<pg8::EpiDN, pg8::GroupedOrder, true, true, true>((PG8_LAS unsigned char*)lds, g, S, E);
    } SEAM(8);
    if (IN(9)) { PHASE_ARGS(); p9_final(a, lane, gw, NGW); if (PROBE_DBL & 512) p9_final(a, lane, gw, NGW);
        if (PROBE_TS) {
            const unsigned long long* ts = (const unsigned long long*)(ctl + 16384);
            const int pa = (PROBE_TS >> 4) & 15, pb = PROBE_TS & 15;
            const float ta = (float)(ts[pa + 1] - ts[pa]) * 0.01f, tb = (float)(ts[pb + 1] - ts[pb]) * 0.01f;
            float M = ta * 0.01f; M = M < 1.0f ? 1.0f : (M > 9.9f ? 9.9f : M); int Ee = 2 + (int)(tb * 0.05f + 0.5f); Ee = Ee > 30 ? 30 : Ee;
            float val = M; for (int i = 0; i < Ee; ++i) val *= 10.0f;
            const float cst = sqrtf(val);
            __syncthreads();
            for (size_t i = (size_t)bid * NTHREADS + tid; i < (size_t)SEQ * DM; i += (size_t)G * NTHREADS) a.out[i] = cst; } }
#undef IN
#undef SEAM
}

template <int LO, int HI> static bool launch_range(const Args& a, int grid, hipStream_t stream) {
    static bool attr = false;
    if (!attr) { attr = true; if (hipFuncSetAttribute((const void*)hymba_fwd<LO, HI>, hipFuncAttributeMaxDynamicSharedMemorySize, LDS_BYTES) != hipSuccess) { fprintf(stderr, "kernel_launch: hipFuncSetAttribute failed\n"); return false; } }
    hipLaunchKernelGGL((hymba_fwd<LO, HI>), dim3(grid), dim3(NTHREADS), LDS_BYTES, stream, a);
    return hipPeekAtLastError() == hipSuccess;
}
extern "C" void kernel_launch(void* const* d_in, const int* in_sizes, int n_in, void* d_out, int out_size, void* d_ws, size_t ws_size, hipStream_t stream) {
    static int grid = 0;
    if (grid == 0) {
        if (n_in != 19 || out_size != SEQ * DM || ws_size < WS_END) { fprintf(stderr, "kernel_launch: unexpected shapes (n_in %d out %d ws %zu)\n", n_in, out_size, ws_size); grid = -1; return; }
        int dev = 0, cus = 0;
        if (hipGetDevice(&dev) != hipSuccess || hipDeviceGetAttribute(&cus, hipDeviceAttributeMultiprocessorCount, dev) != hipSuccess) { grid = -1; return; }
        grid = cus;
    }
    if (grid < 0) return;
    (void)in_sizes;
    if (hipMemsetAsync((char*)d_ws + WS_CTL, 0, CTL_ZERO_BYTES, stream) != hipSuccess) return;
    Args a{};
    for (int i = 0; i < 19; ++i) a.in[i] = (const float*)d_in[i];
    a.out = (float*)d_out; a.ws = (unsigned char*)d_ws;
#if MK_PER_PHASE
    launch_range<0, 1>(a, grid, stream); launch_range<1, 2>(a, grid, stream); launch_range<2, 3>(a, grid, stream); launch_range<3, 4>(a, grid, stream); launch_range<4, 5>(a, grid, stream);
    launch_range<5, 6>(a, grid, stream); launch_range<6, 7>(a, grid, stream); launch_range<7, 8>(a, grid, stream); launch_range<8, 9>(a, grid, stream); launch_range<9, 10>(a, grid, stream);
#else
    launch_range<0, N_PHASES>(a, grid, stream);
#endif
}
```

```cpp
#include <hip/hip_runtime.h>
#include <hip/hip_bf16.h>
#include <cstdio>
#include <cstdint>
namespace pg8 {
#define PG8_LAS __attribute__((address_space(3)))
typedef unsigned short bf16_t;
typedef short bf16x8 __attribute__((ext_vector_type(8)));
typedef float f32x4 __attribute__((ext_vector_type(4)));
typedef unsigned u32x4 __attribute__((ext_vector_type(4)));
constexpr int BM = 256, BK = 64, HALF = 128, HTB = HALF * BK * 2  , STAGE_BYTES = 8 * HTB, NXCD = 8, WGM = 8;

__host__ __device__ __forceinline__ int lds_byte(int r, int c) { const int st = (r >> 4) * 2 + (c >> 5), rr = r & 15, cc = c & 31, ob = rr * 64 + cc * 2; return st * 1024 + (ob ^ (((ob >> 9) & 1) << 5)); }
__host__ __device__ __forceinline__ void stage_rc(int b, int& R, int& C) { const int st = b / 1024, sb = b % 1024, swz = sb ^ (((sb >> 9) & 1) << 5); R = (st >> 1) * 16 + swz / 64; C = (st & 1) * 32 + (swz % 64) / 2; }
__host__ __device__ __forceinline__ int perm32(int rho) { const int n = rho >> 4, i = rho & 15; return 8 * (i >> 2) + 4 * n + (i & 3); }

struct Unit { int pm, pn; };
struct Gemm { const bf16_t* A; const bf16_t* Bt; int M, N, K; };

struct StaticOrder {
    int nM, nN, nwg, G, c;
    __host__ __device__ void init(int M, int N, int G_, int c_) { nM = M / BM; nN = N / BM; nwg = nM * nN; G = G_; c = c_; }
    __host__ __device__ bool next(int i, Unit& u) const {
        const long L = (long)i * G + c; if (L >= nwg) return false;
        int wgid = (int)L; { const int q = nwg / NXCD, r = nwg % NXCD, xcd = wgid % NXCD, off = wgid / NXCD; wgid = (xcd < r ? xcd * (q + 1) : r * (q + 1) + (xcd - r) * q) + off; }
        const int nig = WGM * nN, gid = wgid / nig, fm = gid * WGM, gsz = (nM - fm) < WGM ? (nM - fm) : WGM;
        u.pm = fm + ((wgid % nig) % gsz); u.pn = (wgid % nig) / gsz; return true;
    }
    __device__ __forceinline__ void a_ready(const Unit&) const {}
    __device__ __forceinline__ void done(const Unit&) const {}
};

__device__ __forceinline__ unsigned cvt_pk_bf16(float lo, float hi) { unsigned r; asm volatile("v_cvt_pk_bf16_f32 %0, %1, %2" : "=v"(r) : "v"(lo), "v"(hi)); return r; }
typedef float f32x2 __attribute__((ext_vector_type(2)));
__device__ __forceinline__ f32x2 gelu_pk(f32x2 v) {
    const f32x2 av = __builtin_elementwise_abs(v), d = av * 0.2316418882f + 1.0f;
    f32x2 t; t.x = __builtin_amdgcn_rcpf(d.x); t.y = __builtin_amdgcn_rcpf(d.y);
    f32x2 q = t * 0.5307027145f + (-0.7265760135f); q = q * t + 0.7107068705f; q = q * t + (-0.142248368f); q = q * t + 0.127414796f; q = q * t;
    const f32x2 s = (v * v) * (-0.72134752044f);
    f32x2 e; e.x = __builtin_amdgcn_exp2f(s.x); e.y = __builtin_amdgcn_exp2f(s.y);
    const f32x2 m = v * (q * e), r = v - m;
    f32x2 o; o.x = v.x < 0.f ? m.x : r.x; o.y = v.y < 0.f ? m.y : r.y; return o;
}


__device__ __forceinline__ float sigmoidf_fast(float x) { return __builtin_amdgcn_rcpf(1.0f + __builtin_amdgcn_exp2f(-1.4426950408889634f * x)); }
__device__ __forceinline__ u32x4 pack8_bf16(const f32x4 v0, const f32x4 v1) { u32x4 w; w.x = cvt_pk_bf16(v0[0], v0[1]); w.y = cvt_pk_bf16(v0[2], v0[3]); w.z = cvt_pk_bf16(v1[0], v1[1]); w.w = cvt_pk_bf16(v1[2], v1[3]); return w; }

struct EpiIn {
    static constexpr bool PERM = true, AFTER_DRAIN = false;
    bf16_t* Q; size_t koff, voff; bf16_t* U; const float* bglu; unsigned* nrm;
    __device__ __forceinline__ void operator()(const f32x4 (&acc)[2][2][4][2], const Unit& u, int wr, int wc, int fr, int fq) const {
        const int pn = u.pn, pm = u.pm, dcol = wc * 32 + 8 * fq;
        const int c0 = 128 * ((pn < 12 ? 12 : pn) - 12) + dcol;
        f32x4 ba[2], bg[2];
#pragma unroll
        for (int n = 0; n < 2; ++n) { ba[n] = *(const f32x4*)(bglu + c0 + 4 * n); bg[n] = *(const f32x4*)(bglu + 1024 + c0 + 4 * n); }
        asm volatile("" : "+v"(ba[0]), "+v"(ba[1]), "+v"(bg[0]), "+v"(bg[1]));
        if (pn < 12) {
            const int which = pn >> 2;
            if (which == 0 && pm >= 32) return;
            const size_t boff = which == 0 ? 0 : (which == 1 ? koff : voff);
            bf16_t* base = (bf16_t*)((unsigned char*)Q + boff);
            const int rph = which == 0 ? 8192 : 8256;
            float nmax[2] = {0.f, 0.f};
#pragma unroll
            for (int ai = 0; ai < 2; ++ai)
#pragma unroll
                for (int m = 0; m < 4; ++m) {
                    const int rl = ai * HALF + wr * 64 + m * 16 + fr;
                    const bool ok = pm < 32 || rl < 16;
                    const int idx = pm < 32 ? pm * BM + rl + (which ? 64 : 0) : 48 + rl;
#pragma unroll
                    for (int bj = 0; bj < 2; ++bj) { const int head = 2 * (pn & 3) + bj;
                        if (ok) *(u32x4*)(base + ((size_t)head * rph + idx) * 128 + dcol) = pack8_bf16(acc[ai][bj][m][0], acc[ai][bj][m][1]);
                        if (which < 2) { const f32x4 x0 = acc[ai][bj][m][0], x1 = acc[ai][bj][m][1];
                            float ss = (x0[0] * x0[0] + x0[1] * x0[1]) + (x0[2] * x0[2] + x0[3] * x0[3]) + (x1[0] * x1[0] + x1[1] * x1[1]) + (x1[2] * x1[2] + x1[3] * x1[3]);
                            ss += __shfl_xor(ss, 16); ss += __shfl_xor(ss, 32);
                            nmax[bj] = fmaxf(nmax[bj], ok ? ss : 0.f); } }
                }
            if (which < 2) {
#pragma unroll
                for (int bj = 0; bj < 2; ++bj) { float v = nmax[bj];
#pragma unroll
                    for (int o = 1; o < 16; o <<= 1) v = fmaxf(v, __shfl_xor(v, o));
                    if (fr == 0 && fq == 0) __hip_atomic_fetch_max(nrm + (which * 8 + 2 * (pn & 3) + bj) * 4 + wc, __float_as_uint(v), __ATOMIC_RELAXED, __HIP_MEMORY_SCOPE_AGENT); } }
        } else {
#pragma unroll
            for (int ai = 0; ai < 2; ++ai)
#pragma unroll
                for (int m = 0; m < 4; ++m) {
                    const int rl = ai * HALF + wr * 64 + m * 16 + fr;
                    const bool ok = pm < 32 || rl < 16;
                    const int pos = pm < 32 ? 16 + pm * BM + rl : rl;
                    f32x4 o[2];
#pragma unroll
                    for (int n = 0; n < 2; ++n) { const f32x4 a = acc[ai][0][m][n] + ba[n], g = acc[ai][1][m][n] + bg[n];
#pragma unroll
                        for (int j = 0; j < 4; ++j) o[n][j] = a[j] * sigmoidf_fast(g[j]); }
                    if (ok) *(u32x4*)(U + (size_t)pos * 1024 + c0) = pack8_bf16(o[0], o[1]);
                }
        }
    }
};
struct EpiOut {
    static constexpr bool PERM = false, AFTER_DRAIN = false;
    const float* X; float* Hh;
    __device__ __forceinline__ void operator()(const f32x4 (&acc)[2][2][4][2], const Unit& u, int wr, int wc, int fr, int fq) const {
        const int row0 = u.pm * BM + wr * 64 + fr, col0 = u.pn * BM + wc * 32 + 4 * fq;
#pragma unroll
        for (int ai = 0; ai < 2; ++ai)
#pragma unroll
            for (int m = 0; m < 4; ++m) { const size_t off = (size_t)(row0 + ai * HALF + m * 16) * 2048 + col0;
#pragma unroll
                for (int bj = 0; bj < 2; ++bj)
#pragma unroll
                    for (int n = 0; n < 2; ++n) { const f32x4 xv = *(const f32x4*)(X + off + bj * HALF + n * 16); *(f32x4*)(Hh + off + bj * HALF + n * 16) = xv + acc[ai][bj][m][n]; }
                asm volatile("" ::: "memory"); }
    }
};
struct EpiGU {
    static constexpr bool PERM = true, AFTER_DRAIN = false;
    unsigned char* ACT; const float* bgu; float wscale;
    __device__ __forceinline__ void operator()(const f32x4 (&acc)[2][2][4][2], const Unit& u, int wr, int wc, int fr, int fq) const {
        const int e = u.pn >> 4, c0 = 128 * (u.pn & 15) + wc * 32 + 8 * fq;
        f32x4 bg[2], bu[2];
#pragma unroll
        for (int n = 0; n < 2; ++n) { bg[n] = *(const f32x4*)(bgu + (size_t)e * 4096 + c0 + 4 * n); bu[n] = *(const f32x4*)(bgu + (size_t)e * 4096 + 2048 + c0 + 4 * n); }
#pragma unroll
        for (int ai = 0; ai < 2; ++ai)
#pragma unroll
            for (int m = 0; m < 4; ++m) {
                const int row = u.pm * BM + ai * HALF + wr * 64 + m * 16 + fr;
                int o8[2];
#pragma unroll
                for (int n = 0; n < 2; ++n) { const f32x4 g = acc[ai][0][m][n] * wscale + bg[n], up = acc[ai][1][m][n] * wscale + bu[n]; float o[4];
#pragma unroll
                    for (int j = 0; j < 4; ++j) { const float gg = fminf(g[j], 7.0f), uu = fminf(fmaxf(up[j], -7.0f), 7.0f); o[j] = gg * sigmoidf_fast(1.702f * gg) * (uu + 1.0f); }
                    int d = __builtin_amdgcn_cvt_pk_fp8_f32(o[0], o[1], 0, false); o8[n] = __builtin_amdgcn_cvt_pk_fp8_f32(o[2], o[3], d, true); }
                typedef unsigned u32x2_ __attribute__((ext_vector_type(2)));
                *(u32x2_*)(ACT + (size_t)row * 2048 + c0) = (u32x2_){(unsigned)o8[0], (unsigned)o8[1]};
            }
    }
};
struct EpiDN {
    static constexpr bool PERM = true, AFTER_DRAIN = false;
    unsigned char* Y; const float* bdn; float wscale;
    __device__ __forceinline__ void operator()(const f32x4 (&acc)[2][2][4][2], const Unit& u, int wr, int wc, int fr, int fq) const {
        const int e = u.pn >> 3, c0 = 256 * (u.pn & 7) + wc * 32 + 8 * fq;
        f32x4 bv[2][2];
#pragma unroll
        for (int bj = 0; bj < 2; ++bj)
#pragma unroll
            for (int n = 0; n < 2; ++n) bv[bj][n] = *(const f32x4*)(bdn + (size_t)e * 2048 + c0 + bj * HALF + 4 * n);
#pragma unroll
        for (int ai = 0; ai < 2; ++ai)
#pragma unroll
            for (int m = 0; m < 4; ++m) {
                const int row = u.pm * BM + ai * HALF + wr * 64 + m * 16 + fr;
#pragma unroll
                for (int bj = 0; bj < 2; ++bj) { int o8[2];
#pragma unroll
                    for (int n = 0; n < 2; ++n) { const f32x4 v = acc[ai][bj][m][n] * wscale + bv[bj][n]; const int d = __builtin_amdgcn_cvt_pk_fp8_f32(v[0], v[1], 0, false); o8[n] = __builtin_amdgcn_cvt_pk_fp8_f32(v[2], v[3], d, true); }
                    typedef unsigned u32x2_ __attribute__((ext_vector_type(2)));
                    *(u32x2_*)(Y + (size_t)row * 2048 + c0 + bj * HALF) = (u32x2_){(unsigned)o8[0], (unsigned)o8[1]}; }
            }
    }
};
struct GroupedOrder {
    const volatile PG8_LAS int* texp; int NPN, nwg, G, c;
    __device__ void init(const volatile PG8_LAS int* texp_, int T, int NPN_, int G_, int c_) { texp = texp_; NPN = NPN_; nwg = T * NPN_; G = G_; c = c_; }
    __device__ bool next(int i, Unit& u) const {
        const long L = (long)i * G + c; if (L >= nwg) return false;
        int wgid = (int)L; { const int q = nwg / NXCD, r = nwg % NXCD, xcd = wgid % NXCD, off = wgid / NXCD; wgid = (xcd < r ? xcd * (q + 1) : r * (q + 1) + (xcd - r) * q) + off; }
        const int mt = wgid / NPN, t = wgid - mt * NPN;
        const int e = __builtin_amdgcn_readfirstlane(texp[mt]);
        u.pm = mt; u.pn = e * NPN + t; return true;
    }
    __device__ __forceinline__ void a_ready(const Unit&) const {}
    __device__ __forceinline__ void done(const Unit&) const {}
};
template <class Epi, class Sched, bool ALIGN_EPI = false, bool SP2 = false, bool F8 = false>
__device__ __forceinline__ void gemm_phase(PG8_LAS unsigned char* lds, const Gemm g, const Sched& S, const Epi& E) {
    int tid_o = threadIdx.x; asm volatile("" : "+v"(tid_o));
    const int tid = tid_o, wid = __builtin_amdgcn_readfirstlane(tid >> 6), lane = tid & 63, wr = wid >> 2, wc = wid & 3, fr = lane & 15, fq = lane >> 4;
    const int K = F8 ? g.K / 2 : g.K, nt = K / BK;
    unsigned voffA[2], voffB[2];
#pragma unroll
    for (int i = 0; i < 2; ++i) { int R, C; stage_rc(tid * 16 + i * 8192, R, C); const int Rb = Epi::PERM ? ((R & ~31) + perm32(R & 31)) : R;
        voffA[i] = (unsigned)(R * K + C) * 2u; voffB[i] = (unsigned)(Rb * K + C) * 2u; }
    const size_t kstep = (size_t)(BK * 2);
    const size_t hstep = (size_t)HALF * K * 2;
    const size_t tstep = 2 * hstep;
    const unsigned ldsw = (unsigned)wid * 1024u;
    const int aoff = lds_byte(wr * 64 + fr, fq * 8), boff = lds_byte(wc * 32 + fr, fq * 8);
#define PG8_SA(b, h) (((b) * 2 + (h)) * HTB)
#define PG8_SB(b, h) ((4 + (b) * 2 + (h)) * HTB)
#define PG8_STAGE(bufoff, gbase, voff) do { _Pragma("unroll") for (int _i = 0; _i < 2; ++_i) \
        __builtin_amdgcn_global_load_lds((const unsigned*)((const char*)(gbase) + (voff)[_i]), (PG8_LAS unsigned*)(lds + (bufoff) + ldsw + _i * 8192), 16, 0, 0); } while (0)
#define PG8_RD16(off) (*(const PG8_LAS v4i_*)(lds + (off)))
#define PG8_LDA(dst, b, h) do { _Pragma("unroll") for (int m = 0; m < 4; ++m) { if constexpr (F8) { const v4i_ l_ = PG8_RD16(PG8_SA(b, h) + aoff + m * 2048), h_ = PG8_RD16(PG8_SA(b, h) + aoff + m * 2048 + 1024); dst##8[m] = __builtin_shufflevector(l_, h_, 0, 1, 2, 3, 4, 5, 6, 7); } \
        else { _Pragma("unroll") for (int k = 0; k < 2; ++k) dst[m][k] = *(const PG8_LAS bf16x8*)(lds + PG8_SA(b, h) + aoff + m * 2048 + k * 1024); } } } while (0)
#define PG8_LDB(dst, b, h) do { _Pragma("unroll") for (int n = 0; n < 2; ++n) { if constexpr (F8) { const v4i_ l_ = PG8_RD16(PG8_SB(b, h) + boff + n * 2048), h_ = PG8_RD16(PG8_SB(b, h) + boff + n * 2048 + 1024); dst##8[n] = __builtin_shufflevector(l_, h_, 0, 1, 2, 3, 4, 5, 6, 7); } \
        else { _Pragma("unroll") for (int k = 0; k < 2; ++k) dst[n][k] = *(const PG8_LAS bf16x8*)(lds + PG8_SB(b, h) + boff + n * 2048 + k * 1024); } } } while (0)
#define PG8_MMA(ai, bj, At, Bt) do { __builtin_amdgcn_s_setprio(1); _Pragma("unroll") for (int m = 0; m < 4; ++m) _Pragma("unroll") for (int n = 0; n < 2; ++n) { \
        if constexpr (F8) {   \
            asm("v_mfma_scale_f32_16x16x128_f8f6f4 %0, %1, %2, %0, %3, %3 op_sel_hi:[0,0,0]" : "+v"(acc[ai][bj][m][n]) : "v"(Bt##8[n]), "v"(At##8[m]), "v"(sc8_)); }   \
        else { _Pragma("unroll") for (int k = 0; k < 2; ++k) acc[ai][bj][m][n] = __builtin_amdgcn_mfma_f32_16x16x32_bf16(Bt[n][k], At[m][k], acc[ai][bj][m][n], 0, 0, 0); } } \
        __builtin_amdgcn_s_setprio(0); } while (0)
#define PG8_WAIT_V(n) asm volatile("s_waitcnt vmcnt(" #n ")" ::: "memory")
#define PG8_WAIT_L(n) asm volatile("s_waitcnt lgkmcnt(" #n ")" ::: "memory")
#define PG8_BAR __builtin_amdgcn_s_barrier()
#define PG8_SCHED __builtin_amdgcn_sched_barrier(0)
    Unit cur, nxt; int ui = 0;
    if (!S.next(0, cur)) return;
    f32x4 acc[2][2][4][2];
#pragma unroll
    for (int a = 0; a < 2; ++a)
#pragma unroll
        for (int b = 0; b < 2; ++b)
#pragma unroll
            for (int m = 0; m < 4; ++m)
#pragma unroll
                for (int n = 0; n < 2; ++n) acc[a][b][m][n] = (f32x4){0.f, 0.f, 0.f, 0.f};
    typedef int v8i_ __attribute__((ext_vector_type(8))); typedef int v4i_ __attribute__((ext_vector_type(4)));
    int sc8_ = 0x7f7f7f7f; asm volatile("" : "+v"(sc8_));
    bf16x8 At[4][2], B0[2][2], B1[2][2]; v8i_ At8[4], B08[2], B18[2];
    const char* cA = (const char*)g.A + (size_t)cur.pm * tstep; const char* cB = (const char*)g.Bt + (size_t)cur.pn * tstep;
    S.a_ready(cur);
    if constexpr (SP2) {
        PG8_STAGE(PG8_SB(0, 0), cB, voffB); PG8_STAGE(PG8_SB(0, 1), cB + hstep, voffB); PG8_STAGE(PG8_SA(0, 0), cA, voffA); PG8_STAGE(PG8_SA(0, 1), cA + hstep, voffA);
        if (wr == 1) PG8_BAR;
        PG8_WAIT_V(2); PG8_BAR;
        PG8_STAGE(PG8_SB(1, 0), cB + kstep, voffB); PG8_STAGE(PG8_SA(1, 0), cA + kstep, voffA); PG8_STAGE(PG8_SB(1, 1), cB + hstep + kstep, voffB);
        PG8_WAIT_V(6); PG8_BAR;
    } else {
        PG8_STAGE(PG8_SB(0, 0), cB, voffB); PG8_STAGE(PG8_SA(0, 0), cA, voffA); PG8_STAGE(PG8_SB(0, 1), cB + hstep, voffB); PG8_STAGE(PG8_SA(0, 1), cA + hstep, voffA);
        if (wr == 1) PG8_BAR;
        PG8_WAIT_V(4); PG8_BAR;
        PG8_STAGE(PG8_SB(1, 0), cB + kstep, voffB); PG8_STAGE(PG8_SA(1, 0), cA + kstep, voffA); PG8_STAGE(PG8_SB(1, 1), cB + hstep + kstep, voffB);
        PG8_WAIT_V(6); PG8_BAR;
    }
    for (;;) {
        const bool has_next = S.next(ui + 1, nxt);
        const char* nA = has_next ? (const char*)g.A + (size_t)nxt.pm * tstep : cA; const char* nB = has_next ? (const char*)g.Bt + (size_t)nxt.pn * tstep : cB;
        for (int t = 0; t < nt; t += 2) {
            const bool last = (t == nt - 2);
            const char* a1 = cA + (size_t)(t + 1) * kstep;
            const char* a2 = last ? nA : cA + (size_t)(t + 2) * kstep; const char* b2 = last ? nB : cB + (size_t)(t + 2) * kstep;
            const char* a3 = a2 + kstep; const char* b3 = b2 + kstep;
            if (last && has_next) S.a_ready(nxt);
            if constexpr (SP2) {
            PG8_LDB(B0, 0, 0); PG8_LDB(B1, 0, 1); PG8_SCHED; PG8_LDA(At, 0, 0); PG8_STAGE(PG8_SA(1, 1), a1 + hstep, voffA);
            PG8_WAIT_V(8); PG8_WAIT_L(0); PG8_BAR; PG8_MMA(0, 0, At, B0); PG8_MMA(0, 1, At, B1); PG8_BAR; PG8_SCHED;
            PG8_LDA(At, 0, 1); PG8_STAGE(PG8_SB(0, 0), b2, voffB); PG8_STAGE(PG8_SB(0, 1), b2 + hstep, voffB); PG8_STAGE(PG8_SA(0, 0), a2, voffA);
            PG8_WAIT_V(8); PG8_WAIT_L(0); PG8_BAR; PG8_MMA(1, 0, At, B0); PG8_MMA(1, 1, At, B1); PG8_BAR; PG8_SCHED;
            PG8_LDB(B0, 1, 0); PG8_LDB(B1, 1, 1); PG8_SCHED; PG8_LDA(At, 1, 0); PG8_STAGE(PG8_SA(0, 1), a2 + hstep, voffA);
            PG8_WAIT_V(8); PG8_WAIT_L(0); PG8_BAR; PG8_MMA(0, 0, At, B0); PG8_MMA(0, 1, At, B1); PG8_BAR; PG8_SCHED;
            PG8_LDA(At, 1, 1); PG8_STAGE(PG8_SB(1, 0), b3, voffB); PG8_STAGE(PG8_SB(1, 1), b3 + hstep, voffB); PG8_STAGE(PG8_SA(1, 0), a3, voffA);
            PG8_WAIT_V(8); PG8_WAIT_L(0); PG8_BAR; PG8_MMA(1, 0, At, B0); PG8_MMA(1, 1, At, B1); PG8_BAR; PG8_SCHED;
            } else {
            PG8_LDB(B0, 0, 0); PG8_SCHED; PG8_LDA(At, 0, 0); PG8_STAGE(PG8_SA(1, 1), a1 + hstep, voffA);
            PG8_WAIT_L(8); PG8_BAR; PG8_WAIT_L(0); PG8_MMA(0, 0, At, B0); PG8_BAR; PG8_SCHED;
            PG8_LDB(B1, 0, 1); PG8_STAGE(PG8_SB(0, 0), b2, voffB);
            PG8_BAR; PG8_WAIT_L(0); PG8_MMA(0, 1, At, B1); PG8_BAR;
            PG8_LDA(At, 0, 1); PG8_STAGE(PG8_SA(0, 0), a2, voffA);
            PG8_BAR; PG8_WAIT_L(0); PG8_MMA(1, 0, At, B0); PG8_BAR; PG8_SCHED;
            PG8_STAGE(PG8_SB(0, 1), b2 + hstep, voffB);
            PG8_WAIT_V(6); PG8_BAR; PG8_MMA(1, 1, At, B1); PG8_BAR;
            PG8_LDB(B0, 1, 0); PG8_SCHED; PG8_LDA(At, 1, 0); PG8_STAGE(PG8_SA(0, 1), a2 + hstep, voffA);
            PG8_WAIT_L(8); PG8_BAR; PG8_WAIT_L(0); PG8_MMA(0, 0, At, B0); PG8_BAR; PG8_SCHED;
            PG8_LDB(B1, 1, 1); PG8_STAGE(PG8_SB(1, 0), b3, voffB);
            PG8_BAR; PG8_WAIT_L(0); PG8_MMA(0, 1, At, B1); PG8_BAR;
            PG8_LDA(At, 1, 1); PG8_STAGE(PG8_SA(1, 0), a3, voffA);
            PG8_BAR; PG8_WAIT_L(0); PG8_MMA(1, 0, At, B0); PG8_BAR; PG8_SCHED;
            PG8_STAGE(PG8_SB(1, 1), b3 + hstep, voffB);
            PG8_WAIT_V(6); PG8_BAR; PG8_MMA(1, 1, At, B1); PG8_BAR;
            }
        }
        if constexpr (F8) asm volatile("s_nop 15\n\ts_nop 15" ::: "memory");
        if constexpr (ALIGN_EPI) { if (wr == 0) PG8_BAR; }
        if constexpr (!Epi::AFTER_DRAIN) { E(acc, cur, wr, wc, fr, fq); S.done(cur); }
        if (!has_next) break;
#pragma unroll
        for (int a = 0; a < 2; ++a)
#pragma unroll
            for (int b = 0; b < 2; ++b)
#pragma unroll
                for (int m = 0; m < 4; ++m)
#pragma unroll
                    for (int n = 0; n < 2; ++n) acc[a][b][m][n] = (f32x4){0.f, 0.f, 0.f, 0.f};
        cur = nxt; cA = nA; cB = nB; ++ui;
        if constexpr (ALIGN_EPI) { if (wr == 1) PG8_BAR; }
    }
    PG8_WAIT_V(0);
    if constexpr (!ALIGN_EPI) { if (wr == 0) PG8_BAR; }
    PG8_BAR;
    if constexpr (Epi::AFTER_DRAIN) { E.fused(acc, cur, wr, wc, fr, fq, lds, wid, lane); S.done(cur); }
#undef PG8_SA
#undef PG8_SB
#undef PG8_STAGE
#undef PG8_RD16
#undef PG8_LDA
#undef PG8_LDB
#undef PG8_MMA
#undef PG8_WAIT_V
#undef PG8_WAIT_L
#undef PG8_BAR
#undef PG8_SCHED
}
}
namespace fox {
constexpr float THR = 8.f; constexpr int D = 128;
constexpr float SCALE = 0.08838834764831845f;
constexpr int NW = 8, QBLK = 32, KVBLK = 64, QB = NW * QBLK;
constexpr int SHM_V = KVBLK * D * 2, SHM_K = KVBLK * D * 2;
using bf16 = __hip_bfloat16;
typedef short bf16x8 __attribute__((ext_vector_type(8)));
typedef short s16x4 __attribute__((ext_vector_type(4)));
typedef float f32x16 __attribute__((ext_vector_type(16)));
typedef float f32x4 __attribute__((ext_vector_type(4)));
typedef unsigned u32x4 __attribute__((ext_vector_type(4)));
template <class A, class Bt> struct same_t { static constexpr bool v = false; };
template <class A> struct same_t<A, A> { static constexpr bool v = true; };

#define KSWZ(row, colB) ((row) * 256 + ((colB) ^ (((row) & 7) << 4)))
#define SBAR() __builtin_amdgcn_sched_barrier(0)
__device__ __forceinline__ int v_st(int k, int c) { const int kk = (k & ~0xC) | ((k & 4) << 1) | ((k & 8) >> 1); return ((kk >> 3) * 4 + (c >> 5)) * 512 + ((kk & 7) * 32 + (c & 31)) * 2; }
__device__ __forceinline__ int v_rd_base(int lane) { return ((lane & 3) << 3) | (((lane >> 2) & 3) << 6) | (((lane >> 4) & 1) << 5) | (((lane >> 5) & 1) << 8); }
constexpr int v_rd_off(int d0, int ks, int half) { return d0 * 512 + ks * 4096 + half * 2048; }
__device__ __forceinline__ int crow(int r, int hi) { return (r & 3) + 8 * (r >> 2) + 4 * hi; }
__device__ __forceinline__ unsigned cvtpk(float lo, float hi) {
    unsigned r; asm volatile("v_cvt_pk_bf16_f32 %0, %1, %2" : "=v"(r) : "v"(lo), "v"(hi)); return r;
}
__device__ __forceinline__ bf16x8 pack8(f32x4 a, f32x4 b) {
    u32x4 w = {cvtpk(a[0], a[1]), cvtpk(a[2], a[3]), cvtpk(b[0], b[1]), cvtpk(b[2], b[3])};
    return *reinterpret_cast<bf16x8*>(&w);
}
template <class T> __device__ __forceinline__ bf16x8 load8(const T* p) {
    if constexpr (same_t<T, float>::v) { return pack8(*(const f32x4*)p, *(const f32x4*)(p + 4)); }
    else { return *reinterpret_cast<const bf16x8*>(p); }
}
__device__ __forceinline__ void mask_tile(f32x16& p0, f32x16& p1, int dq, unsigned W) {
    const float NEG = -__builtin_inff();
#pragma unroll
    for (int r = 0; r < 16; ++r) {
        const int c = (r & 3) + 8 * (r >> 2);
        if ((unsigned)(dq - c) >= W) p0[r] = NEG;
        if ((unsigned)(dq - c - 32) >= W) p1[r] = NEG;
    }
}
__device__ __forceinline__ void partialSM(f32x16& p0, f32x16& p1, float& m_reg, float& mn, float& alpha) {
    float pmax = p0[0]; for (int r = 1; r < 16; ++r) pmax = fmaxf(pmax, p0[r]); for (int r = 0; r < 16; ++r) pmax = fmaxf(pmax, p1[r]);
    { auto rr = __builtin_amdgcn_permlane32_swap(__float_as_uint(pmax), __float_as_uint(pmax), false, false);
      pmax = fmaxf(__uint_as_float(rr[0]), __uint_as_float(rr[1])); }
    constexpr float C2 = 1.4426950408889634f * SCALE;
    if (__builtin_expect(__all((pmax - m_reg) * SCALE <= THR), 1)) { mn = m_reg; alpha = 1.f; }
    else { mn = fmaxf(m_reg, pmax); alpha = __builtin_amdgcn_exp2f((m_reg - mn) * C2); m_reg = mn; }
    const float mnL = -mn * C2;
    for (int r = 0; r < 16; ++r) p0[r] = fmaf(p0[r], C2, mnL); for (int r = 0; r < 16; ++r) p1[r] = fmaf(p1[r], C2, mnL);
    for (int r = 0; r < 16; ++r) p0[r] = __builtin_amdgcn_exp2f(p0[r]);
}
__device__ __forceinline__ void finishSM(f32x16& p0, f32x16& p1, float alpha, float& l_reg, bf16x8& pa0, bf16x8& pa1, bf16x8& pa2, bf16x8& pa3) {
    for (int r = 0; r < 16; ++r) p1[r] = __builtin_amdgcn_exp2f(p1[r]);
    float ps = 0; for (int r = 0; r < 16; ++r) ps += p0[r]; for (int r = 0; r < 16; ++r) ps += p1[r];
    { auto rr = __builtin_amdgcn_permlane32_swap(__float_as_uint(ps), __float_as_uint(ps), false, false);
      ps = __uint_as_float(rr[0]) + __uint_as_float(rr[1]); }
    l_reg = l_reg * alpha + ps;
#define PK4(P, B_, OUT) do { unsigned a0 = cvtpk(P[B_+0], P[B_+1]), a1 = cvtpk(P[B_+2], P[B_+3]);                          \
        unsigned b0 = cvtpk(P[B_+4], P[B_+5]), b1 = cvtpk(P[B_+6], P[B_+7]);                                             \
        auto r0 = __builtin_amdgcn_permlane32_swap(a0, b0, false, false); auto r1 = __builtin_amdgcn_permlane32_swap(a1, b1, false, false); \
        u32x4 w = {r0[0], r1[0], r0[1], r1[1]}; OUT = *reinterpret_cast<bf16x8*>(&w); } while (0)
    PK4(p0, 0, pa0); PK4(p0, 8, pa1); PK4(p1, 0, pa2); PK4(p1, 8, pa3);
#undef PK4
}
template <int KB, bool SK>
__device__ __forceinline__ void qkt(f32x16& p0, f32x16& p1, const char* K_lds, int r32, int hi, const char* Qw, const float* cneg, bool act) {
    if (SK && !act) { const float NEG = -__builtin_inff();
#pragma unroll
        for (int r = 0; r < 16; ++r) { p0[r] = NEG; p1[r] = NEG; } return; }
    {
#pragma unroll
        for (int g = 0; g < 4; ++g) { const f32x4 c0 = *(const f32x4*)(cneg + 8 * g), c1 = *(const f32x4*)(cneg + 32 + 8 * g);
#pragma unroll
            for (int j = 0; j < 4; ++j) { p0[4 * g + j] = c0[j]; p1[4 * g + j] = c1[j]; } } }
    const char* kb[4]; const char* qb4[4];
#pragma unroll
    for (int dd = 0; dd < 4; ++dd) { kb[dd] = K_lds + KB * SHM_K + KSWZ(r32, (dd * 16 + hi * 8) * 2); qb4[dd] = Qw + KSWZ(r32, (dd * 16 + hi * 8) * 2); }
#pragma unroll
    for (int d0 = 0; d0 < 8; ++d0) { const char* a = kb[d0 & 3] + (d0 >> 2) * 128;
        bf16x8 b0 = *reinterpret_cast<const bf16x8*>(a);
        bf16x8 b1 = *reinterpret_cast<const bf16x8*>(a + 32 * 256);
        bf16x8 qf = *reinterpret_cast<const bf16x8*>(qb4[d0 & 3] + (d0 >> 2) * 128);
        p0 = __builtin_amdgcn_mfma_f32_32x32x16_bf16(b0, qf, p0, 0, 0, 0);
        p1 = __builtin_amdgcn_mfma_f32_32x32x16_bf16(b1, qf, p1, 0, 0, 0); }
}
template <int VB, bool SK>
__device__ __forceinline__ void pv_tile(f32x16* o, int vb0, bf16x8 pa0, bf16x8 pa1, bf16x8 pa2, bf16x8 pa3, bool act) {
    if (SK && !act) return;
#define TRRD(dst, off) asm volatile("ds_read_b64_tr_b16 %0, %1 offset:%2" : "=&v"(dst) : "v"(vb0), "i"(off) : "memory")
#define PV_D0(d0) do { s16x4 l0, l1, l2, l3, h0, h1, h2, h3; constexpr int b_ = VB * SHM_V + v_rd_off(d0, 0, 0);     \
        TRRD(l0, b_); TRRD(h0, b_ + 2048); TRRD(l1, b_ + 4096); TRRD(h1, b_ + 6144); TRRD(l2, b_ + 8192); TRRD(h2, b_ + 10240); TRRD(l3, b_ + 12288); TRRD(h3, b_ + 14336); \
        asm volatile("s_waitcnt lgkmcnt(0)" ::: "memory"); SBAR();                 \
        o[d0] = __builtin_amdgcn_mfma_f32_32x32x16_bf16(pa0, (bf16x8){l0[0], l0[1], l0[2], l0[3], h0[0], h0[1], h0[2], h0[3]}, o[d0], 0, 0, 0);   \
        o[d0] = __builtin_amdgcn_mfma_f32_32x32x16_bf16(pa1, (bf16x8){l1[0], l1[1], l1[2], l1[3], h1[0], h1[1], h1[2], h1[3]}, o[d0], 0, 0, 0);   \
        o[d0] = __builtin_amdgcn_mfma_f32_32x32x16_bf16(pa2, (bf16x8){l2[0], l2[1], l2[2], l2[3], h2[0], h2[1], h2[2], h2[3]}, o[d0], 0, 0, 0);   \
        o[d0] = __builtin_amdgcn_mfma_f32_32x32x16_bf16(pa3, (bf16x8){l3[0], l3[1], l3[2], l3[3], h3[0], h3[1], h3[2], h3[3]}, o[d0], 0, 0, 0); } while (0)
    PV_D0(0); PV_D0(1); PV_D0(2); PV_D0(3);
#undef PV_D0
#undef TRRD
}
constexpr int LDS_CK = 2 * SHM_V + 2 * SHM_K + NW * 64 * 4, LDS_Q = LDS_CK + 2 * 64 * 4, LDS_BYTES_FOX = LDS_Q + NW * QBLK * D * 2;
struct FoxRef { const bf16* Q; const bf16* K; const bf16* V; const float* C; bf16* O; float* ML; int P0, j_lo, j_hi, dummy; };
struct FoxSeam { int unused; };
#define VMW() asm volatile("s_waitcnt vmcnt(0)" ::: "memory")
#define FOX_LAS __attribute__((address_space(3)))
struct FoxDma { int kof, vof, qof; };
__device__ __forceinline__ FoxDma fox_dma_init(int wid, int lane) {
    FoxDma d; const int lr = lane >> 4, lc = lane & 15;
    d.kof = (wid * 8 + lr) * 256 + ((lc ^ lr) << 4);
    const int kk = wid * 8 + ((lane & 31) >> 2), k = (kk & ~0xC) | ((kk & 4) << 1) | ((kk & 8) >> 1);
    d.vof = k * 256 + ((lane >> 5) * 32 + (lane & 3) * 8) * 2;
    d.qof = (wid * QBLK + lr) * 256 + ((lc ^ lr) << 4);
    return d;
}
constexpr int NC_OFF = 8 * 8256;
#define FOX_G2L(gp, lp, n) __builtin_amdgcn_global_load_lds((const unsigned*)(gp), (FOX_LAS unsigned*)(lp), n, 0, 0)
#define FOX_DMA_K(Kp, Cp, kb_, kbuf) do { const char* kg_ = (const char*)(Kp) + (size_t)(kb_) * 256; unsigned ko_ = dm.kof, lo_ = lane * 4; asm volatile("" : "+v"(ko_), "+v"(lo_));       \
        FOX_G2L(kg_ + ko_, K_lds + (kbuf) * SHM_K + wid * 2048, 16); FOX_G2L(kg_ + ((ko_ ^ 64u) + 1024u), K_lds + (kbuf) * SHM_K + wid * 2048 + 1024, 16);                               \
        if (wid == 0) FOX_G2L((const char*)((Cp) + NC_OFF + (kb_)) + lo_, (char*)ck_lds + (kbuf) * 256, 4); } while (0)
#define FOX_DMA_V(Vp, kb_, vbuf) do { const char* vg_ = (const char*)(Vp) + (size_t)(kb_) * 256; unsigned vo_ = dm.vof; asm volatile("" : "+v"(vo_));                                     \
        FOX_G2L(vg_ + vo_, V_lds + (vbuf) * SHM_V + wid * 2048, 16); FOX_G2L(vg_ + (vo_ + 128u), V_lds + (vbuf) * SHM_V + wid * 2048 + 1024, 16); } while (0)
#define FOX_DMA_Q(Qp) do { const char* qg_ = (const char*)(Qp); unsigned qo_ = dm.qof; asm volatile("" : "+v"(qo_));                                                                      \
        _Pragma("unroll") for (int i_ = 0; i_ < 8; ++i_) FOX_G2L(qg_ + ((qo_ ^ (64u * (i_ & 1))) + 1024u * i_), Qw + 1024 * i_, 16); } while (0)
__device__ __forceinline__ void qkt_rt(f32x16& p0, f32x16& p1, const char* Kt, int r32, int hi, const char* Qw, const float* cneg) {
#pragma unroll
    for (int g = 0; g < 4; ++g) { const f32x4 c0 = *(const f32x4*)(cneg + 8 * g), c1 = *(const f32x4*)(cneg + 32 + 8 * g);
#pragma unroll
        for (int j = 0; j < 4; ++j) { p0[4 * g + j] = c0[j]; p1[4 * g + j] = c1[j]; } }
    const char* kb[4]; const char* qb4[4];
#pragma unroll
    for (int dd = 0; dd < 4; ++dd) { kb[dd] = Kt + KSWZ(r32, (dd * 16 + hi * 8) * 2); qb4[dd] = Qw + KSWZ(r32, (dd * 16 + hi * 8) * 2); }
#pragma unroll
    for (int d0 = 0; d0 < 8; ++d0) { const char* a = kb[d0 & 3] + (d0 >> 2) * 128;
        bf16x8 b0 = *reinterpret_cast<const bf16x8*>(a);
        bf16x8 b1 = *reinterpret_cast<const bf16x8*>(a + 32 * 256);
        bf16x8 qf = *reinterpret_cast<const bf16x8*>(qb4[d0 & 3] + (d0 >> 2) * 128);
        p0 = __builtin_amdgcn_mfma_f32_32x32x16_bf16(b0, qf, p0, 0, 0, 0);
        p1 = __builtin_amdgcn_mfma_f32_32x32x16_bf16(b1, qf, p1, 0, 0, 0); }
}
__device__ __forceinline__ void fox_prime(const FoxRef& cur, char* lds, FoxSeam& S) {
    const int tid = threadIdx.x, wid = __builtin_amdgcn_readfirstlane(tid >> 6), lane = tid & 63;
    char* K_lds = lds + 2 * SHM_V; float* ck_lds = (float*)(lds + LDS_CK); char* Qw = lds + LDS_Q + wid * (QBLK * D * 2);
    const FoxDma dm = fox_dma_init(wid, lane);
    FOX_DMA_K(cur.K, cur.C, cur.j_lo * KVBLK, 0); FOX_DMA_Q(cur.Q);
    S.unused = 0;
    VMW(); __syncthreads();
}
__device__ __forceinline__ void fox_block(const FoxRef& cur, const FoxRef& nxt, char* lds, FoxSeam& S) {
    constexpr unsigned W = 0x7fffffffu;
    int tid_o = threadIdx.x; asm volatile("" : "+v"(tid_o));
    const int tid = tid_o, wid = __builtin_amdgcn_readfirstlane(tid >> 6), lane = tid & 63, r32 = lane & 31, hi = lane >> 5, grp = wid >> 2;
    const int j_lo = cur.j_lo, NT = cur.j_hi - cur.j_lo;
    const int kbn = nxt.j_lo * KVBLK;
    const int qlo = cur.P0 + wid * QBLK, qm = qlo + r32 - 4 * hi;
    char* V_lds = lds; char* K_lds = lds + 2 * SHM_V;
    float* ws = (float*)(lds + 2 * SHM_V + 2 * SHM_K) + wid * 64; float* li_l = ws, * al_l = ws + 32;
    float* ck_lds = (float*)(lds + LDS_CK);
    char* Qw = lds + LDS_Q + wid * (QBLK * D * 2);
    float m_reg = -1e30f, l_reg = 0; f32x16 o[4] = {};
    const int vb0 = (int)(uintptr_t)V_lds + v_rd_base(lane);
    const bf16* Kh = cur.K; const bf16* Vh = cur.V; const float* Ch = cur.C;
    const FoxDma dm = fox_dma_init(wid, lane);
    f32x16 p0, p1; float mn, al; bf16x8 pa0, pa1, pa2, pa3;
#define KBASE(t) ((j_lo + (t)) * KVBLK)
#define DMA_STEP(s) do { FOX_DMA_V(Vh, KBASE(s), (s) & 1); if ((s) + 1 < NT) { FOX_DMA_K(Kh, Ch, KBASE((s) + 1), ((s) + 1) & 1); } SBAR(); } while (0)
#define DMA_SEAM() do { FOX_DMA_K(nxt.K, nxt.C, kbn, 0); FOX_DMA_Q(nxt.Q); SBAR(); } while (0)
#define QK(t) qkt_rt(p0, p1, K_lds + ((t) & 1) * SHM_K, r32, hi, Qw, ck_lds + ((t) & 1) * 64 + 4 * hi)
#define PV(t) pv_tile<0, false>(o, vb0 + ((t) & 1) * SHM_V, pa0, pa1, pa2, pa3, true)
#define SM(t) do { { const int kb_ = KBASE(t); if (kb_ + KVBLK - 1 > qlo) mask_tile(p0, p1, qm - kb_, W); }                                 \
        partialSM(p0, p1, m_reg, mn, al); finishSM(p0, p1, al, l_reg, pa0, pa1, pa2, pa3);                                                  \
        if (__any(al < 1.f)) { if (hi == 0) al_l[r32] = al; asm volatile("s_waitcnt lgkmcnt(0)" ::: "memory");                                \
            for (int d_ = 0; d_ < 4; ++d_) for (int r = 0; r < 16; ++r) o[d_][r] *= al_l[crow(r, hi)]; } } while (0)
#define BAR() do { SBAR(); __syncthreads(); SBAR(); } while (0)
#define EPILOGUE() do {                                                                                                                      \
    if (hi == 0) li_l[r32] = l_reg; asm volatile("s_waitcnt lgkmcnt(0)" ::: "memory");                                                        \
    if (hi == 0) *(float2*)(cur.ML + (wid * QBLK + r32) * 2) = make_float2(m_reg, l_reg);                                                     \
    float rli[16];                                                                                                                           \
    _Pragma("unroll") for (int r = 0; r < 16; ++r) { const float lv = li_l[crow(r, hi)]; rli[r] = lv > 0.f ? __builtin_amdgcn_rcpf(lv) : 0.f; } \
    bf16* Ow = cur.O + (size_t)(wid * QBLK) * D;                                                                                             \
    _Pragma("unroll") for (int r = 0; r < 16; ++r) { const int orow = crow(r, hi);                                                            \
        _Pragma("unroll") for (int d0 = 0; d0 < 4; ++d0) { const float v = o[d0][r] * rli[r];                                                 \
            const float vn = __shfl_xor(v, 1);                                                                                               \
            if ((r32 & 1) == 0) *(unsigned*)(Ow + (size_t)orow * D + d0 * 32 + r32) = cvtpk(v, vn); } } } while (0)
    if (grp == 0) {
        DMA_STEP(0); QK(0); BAR();
#pragma unroll 1
        for (int t = 0; t + 1 < NT; ++t) { SM(t); VMW(); BAR();   DMA_STEP(t + 1); QK(t + 1); PV(t); BAR(); }
        SM(NT - 1); VMW(); BAR();
        DMA_SEAM(); PV(NT - 1); BAR();
        EPILOGUE(); VMW(); BAR();
    } else {
        DMA_STEP(0); BAR();
        QK(0); VMW(); BAR();
#pragma unroll 1
        for (int t = 0; t + 1 < NT; ++t) { DMA_STEP(t + 1); SM(t); BAR();   QK(t + 1); PV(t); VMW(); BAR(); }
        DMA_SEAM(); SM(NT - 1); BAR();
        PV(NT - 1); VMW(); BAR();
        EPILOGUE();
    }
#undef DMA_STEP
#undef DMA_SEAM
#undef QK
#undef PV
#undef SM
#undef BAR
#undef EPILOGUE
#undef KBASE
}
#undef VMW
#undef FOX_G2L
#undef FOX_DMA_K
#undef FOX_DMA_V
#undef FOX_DMA_Q
}
constexpr int NWAVES = 8, NTHREADS = 512;
constexpr int DM = 2048, SEQ = 8192, NMETA = 16, LTOT = SEQ + NMETA, NHEAD = 8, HDIM = 128, INCOLS = 5128, NIN = 5120;
constexpr int NEXP = 32, TOPK = 4, CKW = 31;
constexpr int MIN_ROWS = 8448;
constexpr int SKV = 8256;
constexpr int MAXT = 160, PROWS = MAXT * 256;
constexpr float NORM_EPS = 1e-5f;
constexpr float INV_SCALE = 11.313708498984761f;
constexpr float W8_SCALE = 32.0f, W8_INV = 1.0f / 32.0f;
constexpr size_t MiB = 1u << 20;
constexpr size_t WS_CTL = 0, CTL_ZERO_BYTES = 1 * MiB;
constexpr size_t WS_WIN = 1 * MiB, WS_WOUT = 21 * MiB, WS_WGU = 32 * MiB, WS_WDN = 544 * MiB, WS_HN = 800 * MiB, WS_Q = 834 * MiB, WS_K = 850 * MiB, WS_V = 867 * MiB,
                 WS_U = 884 * MiB, WS_MIXED = 901 * MiB, WS_H = 933 * MiB, WS_HN2 = 997 * MiB, WS_XG = 1029 * MiB, WS_ACT = 1189 * MiB, WS_Y = 1349 * MiB,
                 WS_OPART = 1509 * MiB, WS_ML = 1573 * MiB, WS_LOGF = 1575 * MiB, WS_CS = 1576 * MiB, WS_ROUTE = 1577 * MiB, WS_END = 1579 * MiB;
static_assert(WS_WIN + (size_t)NIN * DM * 2 <= WS_WOUT && WS_WOUT + (size_t)DM * DM * 2 <= WS_WGU && WS_WGU + (size_t)NEXP * 4096 * DM * 2 <= WS_WDN && WS_WDN + (size_t)NEXP * DM * DM * 2 <= WS_HN, "ws map 1");
static_assert(WS_HN + (size_t)MIN_ROWS * DM * 2 <= WS_Q && WS_Q + (size_t)NHEAD * SEQ * HDIM * 2 <= WS_K && WS_K + (size_t)NHEAD * SKV * HDIM * 2 <= WS_V && WS_V + (size_t)NHEAD * SKV * HDIM * 2 <= WS_U, "ws map 2");
static_assert(WS_U + (size_t)LTOT * 1024 * 2 <= WS_MIXED && WS_MIXED + (size_t)SEQ * DM * 2 <= WS_H && WS_H + (size_t)SEQ * DM * 4 <= WS_HN2 && WS_HN2 + (size_t)SEQ * DM * 2 <= WS_XG, "ws map 3");
static_assert(WS_XG + (size_t)PROWS * DM * 2 <= WS_ACT && WS_ACT + (size_t)PROWS * DM * 2 <= WS_Y && WS_Y + (size_t)PROWS * DM * 2 <= WS_OPART && WS_OPART + (size_t)1024 * 256 * 128 * 2 <= WS_ML, "ws map 4");
static_assert(WS_ML + (size_t)1024 * 512 * 4 <= WS_LOGF && WS_LOGF + (size_t)LTOT * 8 * 4 <= WS_CS && WS_CS + (size_t)2 * NHEAD * SKV * 4 <= WS_ROUTE && WS_ROUTE + (size_t)4 * SEQ * 4 * 4 + 256 * 32 * 4 <= WS_END, "ws map 5");
constexpr int CW_BAR = 4096, CW_QUEUE = 8192  , CW_CNT = 8384, CW_TEXP = 8448  , CW_NT = 8640  , CW_NORM = 8704  ;
constexpr int RING_BYTES = 135168, MISC_OFF = RING_BYTES, LDS_BYTES = RING_BYTES + 1024;

#define GAS __attribute__((address_space(1)))
#define LAS __attribute__((address_space(3)))
typedef unsigned short bf16;
typedef unsigned v4u __attribute__((ext_vector_type(4)));
typedef unsigned v2u __attribute__((ext_vector_type(2)));
typedef float f32x4 __attribute__((ext_vector_type(4)));
typedef float f32x16 __attribute__((ext_vector_type(16)));
typedef GAS unsigned gu32;
#define RLX_AGENT __ATOMIC_RELAXED, __HIP_MEMORY_SCOPE_AGENT
__device__ __forceinline__ unsigned pk2(float lo, float hi) { unsigned r; asm volatile("v_cvt_pk_bf16_f32 %0, %1, %2" : "=v"(r) : "v"(lo), "v"(hi)); return r; }
__device__ __forceinline__ float bf_lo(unsigned w) { return __uint_as_float(w << 16); }
__device__ __forceinline__ float bf_hi(unsigned w) { return __uint_as_float(w & 0xffff0000u); }
__device__ __forceinline__ float wave_sum(float v) {
#pragma unroll
    for (int o = 1; o < 64; o <<= 1) v += __shfl_xor(v, o);
    return v;
}
#define XB_TMO      128
#define XB_XCNT(j)  (256  + 64 * (j))
#define XB_XSUB(j)  (1280 + 64 * (j))
#define XB_XGEN(j)  (2304 + 64 * (j))
#define XB_TOP      3328
#define XB_TOPGEN   3392
#define XCD_BAR_WORDS 3456
#define XB_SPIN_CAP (1u << 18)

__device__ __forceinline__ unsigned xb_ld(unsigned* p)              { return __hip_atomic_load(p, __ATOMIC_RELAXED, __HIP_MEMORY_SCOPE_AGENT); }
__device__ __forceinline__ unsigned xb_add(unsigned* p, unsigned v) { return __hip_atomic_fetch_add(p, v, __ATOMIC_RELAXED, __HIP_MEMORY_SCOPE_AGENT); }
__device__ __forceinline__ unsigned xb_xcc_id() { return (unsigned)__builtin_amdgcn_s_getreg((3 << 11) | 20) & 0xFu; }
#define XB_SPIN(cond, bar) do { unsigned _sp = 0; while (cond) { __builtin_amdgcn_s_sleep(1); \
    if ((++_sp & 255u) == 0u) { if (xb_ld(&(bar)[XB_TMO])) break; if (_sp > XB_SPIN_CAP) { atomicAdd(&(bar)[XB_TMO], 1u); break; } } } } while (0)

struct XcdBarrier {
    unsigned* bar; unsigned x;
    volatile LAS unsigned* st;
};

__device__ __forceinline__ XcdBarrier xcd_barrier_post(unsigned* bar, volatile LAS unsigned* st) {
    XcdBarrier b; b.bar = bar; b.x = xb_xcc_id(); b.st = st;
    if (threadIdx.x == 0) (void)xb_add(&bar[XB_XCNT(b.x)], 1u);
    return b;
}
__device__ __forceinline__ void xcd_barrier_complete(unsigned* bar, unsigned x, unsigned& nloc, unsigned& nx) {
    const unsigned G = gridDim.x * gridDim.y * gridDim.z;
    unsigned sum, cnt, mine, sp = 0u;
    for (;;) {
        sum = 0u; cnt = 0u; mine = 0u;
#pragma unroll
        for (unsigned j = 0; j < 16; ++j) { const unsigned c = xb_ld(&bar[XB_XCNT(j)]); sum += c; cnt += (c > 0u) ? 1u : 0u; mine = (j == x) ? c : mine; }
        if (sum == G) break;
        __builtin_amdgcn_s_sleep(1);
        if ((++sp & 255u) == 0u) { if (xb_ld(&bar[XB_TMO])) break; if (sp > XB_SPIN_CAP) { atomicAdd(&bar[XB_TMO], 1u); break; } }
    }
    nloc = mine > 0u ? mine : 1u; nx = cnt > 0u ? cnt : 1u;
}

__device__ __forceinline__ void xcd_barrier(const XcdBarrier& b) {
    asm volatile("s_waitcnt vmcnt(0)" ::: "memory");
    __syncthreads();
    if (threadIdx.x == 0) {
        unsigned* bar = b.bar;
        __builtin_amdgcn_s_waitcnt(0);
        unsigned nloc = b.st[0], nx = b.st[1];
        if (nloc == 0u) { xcd_barrier_complete(bar, b.x, nloc, nx); b.st[0] = nloc; b.st[1] = nx; }
        const unsigned old = xb_add(&bar[XB_XSUB(b.x)], 1u);
        const unsigned gen = old / nloc;
        if (old + 1u == (gen + 1u) * nloc) {
            __builtin_amdgcn_fence(__ATOMIC_RELEASE, "agent");
            asm volatile("s_waitcnt vmcnt(0)" ::: "memory");
            const unsigned og = xb_add(&bar[XB_TOP], 1u);
            const unsigned tg = og / nx;
            if (og + 1u == (tg + 1u) * nx) xb_add(&bar[XB_TOPGEN], 1u);
            else XB_SPIN(xb_ld(&bar[XB_TOPGEN]) == tg, bar);
            __builtin_amdgcn_fence(__ATOMIC_ACQUIRE, "agent");
            xb_add(&bar[XB_XGEN(b.x)], 1u);
            asm volatile("s_waitcnt vmcnt(0)" ::: "memory");
        } else {
            XB_SPIN(xb_ld(&bar[XB_XGEN(b.x)]) == gen, bar);
            __builtin_amdgcn_fence(__ATOMIC_ACQUIRE, "agent");
            asm volatile("s_waitcnt vmcnt(0)" ::: "memory");
        }
    }
    __syncthreads();
}
struct Args { const float* in[19]; float* out; unsigned char* ws; };
enum { I_X = 0, I_META, I_G1, I_WIN, I_BF, I_BGLU, I_CW, I_CB, I_GNG, I_GNB, I_WOUT, I_G2, I_RW, I_RB, I_WGU, I_BGU, I_WDN, I_BDN, I_GF };

struct CvJob { const float* src; bf16* dst; int ld; int f8; };
constexpr int CV_GU = NEXP * 32 * 16, CV_DN = NEXP * 16 * 16, CV_IN = 40 * 16, CV_OUT = 16 * 16, CV_JOBS = CV_GU + CV_DN + CV_IN + CV_OUT;
__device__ __forceinline__ CvJob cv_decode(int job, const Args& a) {
    CvJob j;
    if (job < CV_GU) { const int e = job >> 9, r = job & 511, kb = r >> 5, nb = r & 31, col0 = (nb & 1) * 2048 + 128 * (nb >> 1);
        j.src = a.in[I_WGU] + (size_t)e * DM * 4096 + (size_t)(kb * 128) * 4096 + col0; j.ld = 4096; j.f8 = 1; j.dst = (bf16*)((unsigned char*)(a.ws + WS_WGU) + ((size_t)e * 4096 + nb * 128) * DM + kb * 128); }
    else if (job < CV_GU + CV_DN) { const int q = job - CV_GU, e = q >> 8, r = q & 255, kb = r >> 4, nb = r & 15;
        j.src = a.in[I_WDN] + (size_t)e * DM * DM + (size_t)(kb * 128) * DM + nb * 128; j.ld = DM; j.f8 = 1; j.dst = (bf16*)((unsigned char*)(a.ws + WS_WDN) + ((size_t)e * DM + nb * 128) * DM + kb * 128); }
    else if (job < CV_GU + CV_DN + CV_IN) { const int q = job - CV_GU - CV_DN, kb = q / 40, nb = q - kb * 40;
        const int col0 = nb < 24 ? 128 * nb : ((((nb - 24) & 1) ? 4104 : 3080) + 128 * ((nb - 24) >> 1));
        j.src = a.in[I_WIN] + (size_t)(kb * 128) * INCOLS + col0; j.ld = INCOLS; j.f8 = 0; j.dst = (bf16*)(a.ws + WS_WIN) + (size_t)(nb * 128) * DM + kb * 128; }
    else { const int q = job - CV_GU - CV_DN - CV_IN, kb = q >> 4, nb = q & 15;
        j.src = a.in[I_WOUT] + (size_t)(kb * 128) * DM + nb * 128; j.ld = DM; j.f8 = 0; j.dst = (bf16*)(a.ws + WS_WOUT) + (size_t)(nb * 128) * DM + kb * 128; }
    return j;
}
__device__ __forceinline__ void cv_load(const CvJob& j, f32x4 (&v)[8], int tid) {
    const int c4 = tid & 31, kr = tid >> 5;
#pragma unroll
    for (int p = 0; p < 2; ++p)
#pragma unroll
        for (int r = 0; r < 4; ++r) v[p * 4 + r] = __builtin_nontemporal_load((const f32x4*)(j.src + (size_t)(64 * p + 4 * kr + r) * j.ld + 4 * c4));
    asm volatile("" ::: "memory"); __builtin_amdgcn_sched_barrier(0);
}
__device__ __forceinline__ void cv_tile(const CvJob& jc, const f32x4 (&cur)[8], unsigned char* Lb, int tid) {
    const int c4 = tid & 31, kr = tid >> 5;
    if (jc.f8) {
#pragma unroll
        for (int p = 0; p < 2; ++p)
#pragma unroll
            for (int j = 0; j < 4; ++j) { int d = __builtin_amdgcn_cvt_pk_fp8_f32(cur[4 * p + 0][j] * W8_SCALE, cur[4 * p + 1][j] * W8_SCALE, 0, false);
                d = __builtin_amdgcn_cvt_pk_fp8_f32(cur[4 * p + 2][j] * W8_SCALE, cur[4 * p + 3][j] * W8_SCALE, d, true);
                const int n = 4 * c4 + j, unit = 16 * p + kr;
                *(int*)(Lb + n * 128 + ((unit ^ c4) << 2)) = d; }
        __syncthreads();
#pragma unroll
        for (int h = 0; h < 2; ++h) { const int n = 64 * h + (tid >> 3), ch = tid & 7, cx = (n >> 2) & 31; int w[4];
#pragma unroll
          for (int i = 0; i < 4; ++i) w[i] = *(const int*)(Lb + n * 128 + (((4 * ch + i) ^ cx) << 2));
          *(v4u*)((unsigned char*)jc.dst + (size_t)n * DM + 16 * ch) = (v4u){(unsigned)w[0], (unsigned)w[1], (unsigned)w[2], (unsigned)w[3]}; }
    } else {
#pragma unroll
        for (int p = 0; p < 2; ++p)
#pragma unroll
            for (int j = 0; j < 4; ++j) { const unsigned lo = pk2(cur[4 * p + 0][j], cur[4 * p + 1][j]), hi = pk2(cur[4 * p + 2][j], cur[4 * p + 3][j]);
                const int n = 4 * c4 + j, unit = 16 * p + kr, f = (c4 & 15) << 1;
                *(v2u*)(Lb + n * 256 + ((unit ^ f) << 3)) = (v2u){lo, hi}; }
        __syncthreads();
#pragma unroll
        for (int i = 0; i < 4; ++i) { const int n = 32 * i + (tid >> 4), chunk = tid & 15, f = ((n >> 2) & 15) << 1;
            const v4u w = *(const v4u*)(Lb + n * 256 + (((2 * chunk) ^ f) << 3));
            *(v4u*)(jc.dst + (size_t)n * DM + chunk * 8) = w; }
    }
}
constexpr int CV_MOE = CV_GU + CV_DN, CV_BATCH = 8, CV_FINE = 2048, CV_FB = 2;
constexpr int CV_P1_WGS = 108, CV_P1_NB = 3, CV_P1_JOBS = CV_P1_WGS * CV_P1_NB * CV_BATCH;
#ifndef P2_REP_CV
#define P2_REP_CV 1u
#endif
template <int MODE> struct CvIter {
    volatile LAS unsigned* MISC; unsigned* qword; int tid, G, job0, b0, bstride, nbatch, lim, job, nb_par, inb, bdone, bsz;
    __device__ __forceinline__ void setq(int q) { const int f0 = (CV_MOE - job0) - CV_FINE;
        if (q < f0) { job = job0 + q; bsz = CV_BATCH; } else { job = job0 + f0 + CV_FB * ((q - f0) >> 3); bsz = CV_FB; } }
    __device__ __forceinline__ void init(volatile LAS unsigned* MISC_, unsigned* qword_, int tid_, int bid, int G_, int job0_, int b0_, int bstride_, int nbatch_) {
        MISC = MISC_; qword = qword_; tid = tid_; G = G_; job0 = job0_; b0 = b0_; bstride = bstride_; nbatch = nbatch_; nb_par = 0; inb = 0; bdone = 1; bsz = CV_BATCH;
        if (MODE == 1) { lim = job0_ + (CV_MOE - job0_) * (int)P2_REP_CV;
            if (tid == 0) { MISC[6] = __hip_atomic_fetch_add(qword, (unsigned)CV_BATCH, RLX_AGENT); MISC[7] = __hip_atomic_fetch_add(qword, (unsigned)CV_BATCH, RLX_AGENT); }
            __syncthreads();
            setq(__builtin_amdgcn_readfirstlane((int)MISC[6]));
            __syncthreads(); }
        else if (MODE == 2) { lim = CV_MOE; job = nbatch > 0 ? b0 * CV_BATCH : lim; }
        else { lim = CV_JOBS; job = CV_MOE + bid; }
    }
    __device__ __forceinline__ int next() {
        const int cur = job;
        if (cur >= lim) return cur;
        if (MODE == 1) { if (inb < bsz - 1) { job = cur + 1; ++inb; }
                         else { inb = 0; asm volatile("s_waitcnt lgkmcnt(0)" ::: "memory"); __builtin_amdgcn_s_barrier(); asm volatile("" ::: "memory");
                                setq(__builtin_amdgcn_readfirstlane((int)MISC[7 - nb_par]));
                                if (tid == 0) MISC[6 + nb_par] = __hip_atomic_fetch_add(qword, (unsigned)CV_BATCH, RLX_AGENT); nb_par ^= 1; } }
        else if (MODE == 2) { if (inb < CV_BATCH - 1) { job = cur + 1; ++inb; } else { inb = 0; job = bdone < nbatch ? (b0 + bdone * bstride) * CV_BATCH : lim; ++bdone; } }
        else job = cur + G;
        return cur;
    }
};
template <int MODE>
__device__ __forceinline__ void cv_stream(const Args& a, unsigned char* lds, volatile LAS unsigned* MISC, unsigned* qword, int tid, int bid, int G, int job0 = 0, int b0 = 0, int bstride = 0, int nbatch = 0) {
    CvIter<MODE> it; it.init(MISC, qword, tid, bid, G, job0, b0, bstride, nbatch);
    const int lim = it.lim;
#define CVJ(i) (MODE == 1 && P2_REP_CV > 1u ? job0 + ((i) - job0) % (CV_MOE - job0) : (i))
    f32x4 r0[8], r1[8], r2[8], r3[8], r4[8]; CvJob j0, j1, j2, j3, j4; int i0, i1, i2, i3, i4, buf = 0;
#define CV_ISSUE(n) do { i##n = it.next(); j##n = cv_decode(i##n < lim ? CVJ(i##n) : 0, a); cv_load(j##n, r##n, tid); } while (0)
#define CV_DO(n) do { cv_tile(j##n, r##n, lds + buf * 32768, tid); buf ^= 1; } while (0)
    CV_ISSUE(0); CV_ISSUE(1); CV_ISSUE(2); CV_ISSUE(3);
    while (i0 < lim) {
        CV_ISSUE(4); CV_DO(0); if (i1 >= lim) break;
        CV_ISSUE(0); CV_DO(1); if (i2 >= lim) break;
        CV_ISSUE(1); CV_DO(2); if (i3 >= lim) break;
        CV_ISSUE(2); CV_DO(3); if (i4 >= lim) break;
        CV_ISSUE(3); CV_DO(4);
    }
#undef CV_ISSUE
#undef CV_DO
#undef CVJ
    __syncthreads();
}
template <int MODE>
__device__ __forceinline__ void cv_stream_dma(const Args& a, unsigned char* lds, volatile LAS unsigned* MISC, unsigned* qword, int tid, int bid, int G, int job0 = 0, int b0 = 0, int bstride = 0, int nbatch = 0) {
    CvIter<MODE> it; it.init(MISC, qword, tid, bid, G, job0, b0, bstride, nbatch);
    const int lim = it.lim;
    const int wave = __builtin_amdgcn_readfirstlane(tid >> 6), lane = tid & 63, c4 = tid & 31, kr = tid >> 5;
    unsigned char* img = lds + 98304;
#define CVD_ISSUE(J, p_, slot_) do { const unsigned vo_ = (unsigned)((lane >> 5) * (J).ld * 4 + (lane & 31) * 16);                                         \
        _Pragma("unroll") for (int i_ = 0; i_ < 4; ++i_) { const char* g_ = (const char*)(J).src + (size_t)(64 * (p_) + 16 * i_ + 2 * wave) * (J).ld * 4 + vo_;   \
            __builtin_amdgcn_global_load_lds((const unsigned*)g_, (LAS unsigned*)(lds + (slot_) * 32768 + (16 * i_ + 2 * wave) * 512), 16, 0, 2); } } while (0)
#define CVD_BAR(n_) do { asm volatile("s_waitcnt vmcnt(" #n_ ")" ::: "memory"); asm volatile("s_waitcnt lgkmcnt(0)" ::: "memory"); __builtin_amdgcn_s_barrier(); asm volatile("" ::: "memory"); } while (0)
#define CVD_FLUSH(im_, dst_) do { _Pragma("unroll") for (int h_ = 0; h_ < 2; ++h_) { const int n_ = 64 * h_ + (tid >> 3), ch_ = tid & 7, cx_ = (n_ >> 2) & 31; int w_[4];   \
            _Pragma("unroll") for (int q_ = 0; q_ < 4; ++q_) w_[q_] = *(const int*)(img + (im_) * 16384 + n_ * 128 + (((4 * ch_ + q_) ^ cx_) << 2));                        \
            __builtin_nontemporal_store((v4u){(unsigned)w_[0], (unsigned)w_[1], (unsigned)w_[2], (unsigned)w_[3]}, (v4u*)((dst_) + (size_t)n_ * DM + 16 * ch_)); } } while (0)
    int ic = it.next(); CvJob jc = cv_decode(ic < lim ? ic : 0, a);
    if (ic < lim) {
        int in_ = it.next(); CvJob jn = cv_decode(in_ < lim ? in_ : 0, a);
        CVD_ISSUE(jc, 0, 0); CVD_ISSUE(jc, 1, 1);
        int slot = 0, imc = 0, have_prev = 0; unsigned char* dprev = nullptr;
        for (int h = 0;; ++h) {
            const int p = h & 1;
            CVD_BAR(4);
            if (p == 0 && have_prev) { CVD_FLUSH(imc ^ 1, dprev); have_prev = 0; }
            {
                f32x4 v[4];
#pragma unroll
                for (int r = 0; r < 4; ++r) v[r] = *(const f32x4*)(lds + slot * 32768 + (4 * kr + r) * 512 + c4 * 16);
#pragma unroll
                for (int j = 0; j < 4; ++j) { int d = __builtin_amdgcn_cvt_pk_fp8_f32(v[0][j] * W8_SCALE, v[1][j] * W8_SCALE, 0, false);
                    d = __builtin_amdgcn_cvt_pk_fp8_f32(v[2][j] * W8_SCALE, v[3][j] * W8_SCALE, d, true);
                    *(int*)(img + imc * 16384 + (4 * c4 + j) * 128 + (((16 * p + kr) ^ c4) << 2)) = d; } }
            { const int s2 = slot + 2 >= 3 ? slot - 1 : slot + 2; CVD_ISSUE(jn, p, s2); }
            slot = slot + 1 >= 3 ? 0 : slot + 1;
            if (p == 1) { dprev = (unsigned char*)jc.dst; have_prev = 1; imc ^= 1; jc = jn; ic = in_; if (ic >= lim) break; in_ = it.next(); jn = cv_decode(in_ < lim ? in_ : 0, a); }
        }
        CVD_BAR(0);
        if (have_prev) CVD_FLUSH(imc ^ 1, dprev);
    }
#undef CVD_ISSUE
#undef CVD_BAR
#undef CVD_FLUSH
    __syncthreads();
}
__device__ __forceinline__ void p0_prologue(const Args& a, unsigned char* lds, int tid, int lane, int wave, int bid, int G) {
    {
        float* wfT = (float*)(lds + 65536);
        f32x4 g1v[8];
#pragma unroll
        for (int j = 0; j < 8; ++j) g1v[j] = ((const f32x4*)a.in[I_G1])[lane + 64 * j];
        const float bfv = a.in[I_BF][lane & 7];
        const int rstep = G * NWAVES; int row = bid * NWAVES + wave;
        f32x4 v[8], vn[8];
#define P0_XROW(r) ((r) < SEQ ? a.in[I_X] + (size_t)(r) * DM : a.in[I_META] + (size_t)((r) - SEQ) * DM)
        { const int lr = row < LTOT ? row : 0; const float* xr = P0_XROW(lr);
#pragma unroll
          for (int j = 0; j < 8; ++j) v[j] = ((const f32x4*)xr)[lane + 64 * j]; }
        asm volatile("" ::: "memory"); __builtin_amdgcn_sched_barrier(0);
#pragma unroll
        for (int i = 0; i < DM / NTHREADS; ++i) { const int k = tid + i * NTHREADS; const f32x4 w0 = *(const f32x4*)(a.in[I_WIN] + (size_t)k * INCOLS + 3072), w1 = *(const f32x4*)(a.in[I_WIN] + (size_t)k * INCOLS + 3076);
#pragma unroll
            for (int hh = 0; hh < 4; ++hh) { wfT[hh * DM + k] = w0[hh]; wfT[(4 + hh) * DM + k] = w1[hh]; } }
        __syncthreads();
        bf16* HN = (bf16*)(a.ws + WS_HN); float* LOGF = (float*)(a.ws + WS_LOGF);
        for (; row < MIN_ROWS; row += rstep) {
            { const int nr = row + rstep, lr = nr < LTOT ? nr : 0; const float* xr = P0_XROW(lr);
#pragma unroll
              for (int j = 0; j < 8; ++j) vn[j] = ((const f32x4*)xr)[lane + 64 * j];
              asm volatile("" ::: "memory"); __builtin_amdgcn_sched_barrier(0); }
            bf16* orow = HN + (size_t)row * DM;
            if (row >= LTOT) {
#pragma unroll
                for (int j = 0; j < 4; ++j) ((v4u*)orow)[lane + 64 * j] = (v4u){0u, 0u, 0u, 0u};
            } else {
                float ss = 0.f;
#pragma unroll
                for (int j = 0; j < 8; ++j) ss += (v[j][0] * v[j][0] + v[j][1] * v[j][1]) + (v[j][2] * v[j][2] + v[j][3] * v[j][3]);
                ss = wave_sum(ss);
                const float rstd = 1.0f / sqrtf(ss * (1.0f / DM) + NORM_EPS);
                float fa[8];
#pragma unroll
                for (int hh = 0; hh < 8; ++hh) fa[hh] = 0.f;
#pragma unroll
                for (int j = 0; j < 8; ++j) { const f32x4 y = v[j] * rstd * g1v[j];
                    ((v2u*)orow)[lane + 64 * j] = (v2u){pk2(y[0], y[1]), pk2(y[2], y[3])};
#pragma unroll
                    for (int hh = 0; hh < 8; ++hh) { const f32x4 wv = *(const f32x4*)(wfT + hh * DM + 256 * j + 4 * lane); fa[hh] += (y[0] * wv[0] + y[1] * wv[1]) + (y[2] * wv[2] + y[3] * wv[3]); } }
#pragma unroll
                for (int hh = 0; hh < 8; ++hh) fa[hh] = wave_sum(fa[hh]);
                if (lane < 8) {
                    float z = fa[0];
#pragma unroll
                    for (int hh = 1; hh < 8; ++hh) z = lane == hh ? fa[hh] : z;
                    z += bfv;
                    const float lf = fminf(z, 0.f) - log1pf(expf(-fabsf(z)));
                    const int pos = row < SEQ ? NMETA + row : row - SEQ;
                    LOGF[pos * 8 + lane] = lf; }
            }
#pragma unroll
            for (int j = 0; j < 8; ++j) v[j] = vn[j];
        }
#undef P0_XROW
        if (bid == 0) {
            bf16* Kb = (bf16*)(a.ws + WS_K); bf16* Vb = (bf16*)(a.ws + WS_V);
            for (int idx = tid; idx < NHEAD * 768; idx += NTHREADS) { const int head = idx / 768, o = idx - head * 768;
                ((v4u*)(Kb + (size_t)head * SKV * HDIM))[o] = (v4u){0u, 0u, 0u, 0u}; ((v4u*)(Vb + (size_t)head * SKV * HDIM))[o] = (v4u){0u, 0u, 0u, 0u}; } }
        __syncthreads();
    }
    cv_stream<0>(a, lds, nullptr, nullptr, tid, bid, G);
}
__device__ __forceinline__ void p1_cumsum(const Args& a, unsigned char* lds, int tid, int lane, int wave, int head) {
    const float* LOGF = (const float*)(a.ws + WS_LOGF); float* CS = (float*)(a.ws + WS_CS) + (size_t)head * SKV;
    float* wsum = (float*)lds;
    float loc[17]; float s = 0.f;
#pragma unroll
    for (int i = 0; i < 17; ++i) { const int p = 17 * tid + i; const float v = p < LTOT ? LOGF[p * 8 + head] : 0.f; s += v; loc[i] = s; }
    float incl = s;
#pragma unroll
    for (int o = 1; o < 64; o <<= 1) { const float n = __shfl_up(incl, o); if (lane >= o) incl += n; }
    if (lane == 63) wsum[wave] = incl;
    __syncthreads();
    float woff = 0.f;
    for (int w = 0; w < wave; ++w) woff += wsum[w];
    const float excl = woff + incl - s;
#pragma unroll
    for (int i = 0; i < 17; ++i) { const int p = 17 * tid + i; if (p < LTOT) { const float cv = (excl + loc[i]) * INV_SCALE; CS[48 + p] = cv; CS[fox::NC_OFF + 48 + p] = -cv; } }
    if (tid < 48) { CS[tid] = __builtin_inff(); CS[fox::NC_OFF + tid] = -__builtin_inff(); }
    __syncthreads();
}

constexpr int N_ATT_ENT = 80, N_ATT_ITEMS = N_ATT_ENT * NHEAD, CONV_TOK = 32, N_CONV_ITEMS = SEQ / CONV_TOK, N_P2_ITEMS = N_ATT_ITEMS + N_CONV_ITEMS;
__device__ const unsigned short ATT_TAB[N_ATT_ENT] = {
    1151, 855, 559, 263, 1055, 1087, 1119, 1150, 791, 823, 527, 1054, 1086, 1118, 1149, 790, 822, 854, 558, 1053, 1085, 1117, 1148, 821, 853, 526, 1052, 1084, 1116, 1147, 789, 852, 557, 262, 1051, 1083,
    1115, 1146, 788, 820, 525, 1050, 1082, 1114, 1145, 787, 819, 851, 556, 1049, 1081, 1113, 1144, 818, 850, 524, 1048, 1080, 1112, 786, 849, 555, 261, 785, 817, 523, 784, 816, 848, 554, 522, 553, 260, 521,
    552, 520, 259, 258, 257, 256};
__device__ __forceinline__ fox::FoxRef att_decode(int L, const Args& a, const unsigned* ctl) {
    const int ent = L >> 3, head = L & 7; const unsigned t = ATT_TAB[ent]; const int qb = t & 31, part = (t >> 5) & 7, np = t >> 8, NT = 4 * qb + 5;
    fox::FoxRef r;
    r.Q = (const fox::bf16*)(a.ws + WS_Q) + ((size_t)head * SEQ + (size_t)qb * 256) * HDIM;
    r.K = (const fox::bf16*)(a.ws + WS_K) + (size_t)head * SKV * HDIM; r.V = (const fox::bf16*)(a.ws + WS_V) + (size_t)head * SKV * HDIM;
    r.C = (const float*)(a.ws + WS_CS) + (size_t)head * SKV;
    r.P0 = 64 + 256 * qb; r.j_lo = part * NT / np; r.j_hi = (part + 1) * NT / np;
    {
        int lane = threadIdx.x & 63; asm volatile("" : "+v"(lane));
        float cv[3]; const float c0 = r.C[r.P0];
#pragma unroll
        for (int rep = 0; rep < 3; ++rep) { const int t = lane + 64 * rep; cv[rep] = r.C[64 * (t < NT ? t : 0) + 63]; }
        const unsigned* nr = ctl + CW_NORM; float q2 = 0.f, k2 = 0.f;
#pragma unroll
        for (int w = 0; w < 4; ++w) { q2 += __uint_as_float(__hip_atomic_load(nr + head * 4 + w, RLX_AGENT)); k2 += __uint_as_float(__hip_atomic_load(nr + (8 + head) * 4 + w, RLX_AGENT)); }
        const float Bnd = sqrtf(q2 * k2) * fox::SCALE * 1.02f, limit = c0 + (2.0f * Bnd + 110.0f) * INV_SCALE;
        int cnt = 0;
#pragma unroll
        for (int rep = 0; rep < 3; ++rep) { const int t = lane + 64 * rep; const bool past = t < NT && cv[rep] > limit; cnt += __popcll(__ballot(past)); }
        const int jmin = __builtin_amdgcn_readfirstlane(cnt);
        const int jl = jmin < r.j_hi - 1 ? jmin : r.j_hi - 1;
        r.dummy = jmin >= r.j_hi ? 1 : 0;
        if (jl > r.j_lo) r.j_lo = jl; }
    const int slot = (head * 32 + qb) * 4 + part; r.O = (fox::bf16*)(a.ws + WS_OPART) + (size_t)slot * 256 * HDIM; r.ML = (float*)(a.ws + WS_ML) + (size_t)slot * 512;
    return r;
}
__device__ __forceinline__ void conv_item(const Args& a, unsigned char* lds, int tid, int it) {
    const int i0 = it * CONV_TOK, pos0 = NMETA + i0;
    const bf16* U = (const bf16*)(a.ws + WS_U); bf16* MIX = (bf16*)(a.ws + WS_MIXED);
#pragma unroll 1
    for (int h = 0; h < 2; ++h) {
        v4u v[8];
#pragma unroll
        for (int i = 0; i < 8; ++i) { const int idx = tid + (h * 8 + i) * NTHREADS, row = idx >> 7, ch = idx & 127, p = pos0 - 30 + row;
            v[i] = (v4u){0u, 0u, 0u, 0u}; if (idx < 62 * 128 && p >= 0) v[i] = *(const v4u*)(U + (size_t)p * 1024 + ch * 8); }
#pragma unroll
        for (int i = 0; i < 8; ++i) { const int idx = tid + (h * 8 + i) * NTHREADS, row = idx >> 7, ch = idx & 127; if (idx < 62 * 128) *(v4u*)(lds + row * 2048 + ch * 16) = v[i]; } }
    const int c = 2 * tid;
    float cw0[CKW], cw1[CKW];
#pragma unroll
    for (int w = 0; w < CKW; ++w) { const float2 t = *(const float2*)(a.in[I_CW] + w * 1024 + c); cw0[w] = t.x; cw1[w] = t.y; }
    const float2 cb = *(const float2*)(a.in[I_CB] + c), gg = *(const float2*)(a.in[I_GNG] + c), gb = *(const float2*)(a.in[I_GNB] + c);
    __syncthreads();
#pragma unroll 1
    for (int tg = 0; tg < CONV_TOK; tg += 4) {
        float a0[4], a1[4];
#pragma unroll
        for (int q = 0; q < 4; ++q) { a0[q] = cb.x; a1[q] = cb.y; }
#pragma unroll
        for (int r = 0; r < CKW + 3; ++r) { const unsigned pk = *(const unsigned*)(lds + (tg + r) * 2048 + c * 2); const float x0 = bf_lo(pk), x1 = bf_hi(pk);
#pragma unroll
            for (int q = 0; q < 4; ++q) { const int w = r - q; if (w >= 0 && w < CKW) { a0[q] += x0 * cw0[w]; a1[q] += x1 * cw1[w]; } } }
        float sm[4], d0[4], d1[4], vr[4];
#pragma unroll
        for (int q = 0; q < 4; ++q) sm[q] = a0[q] + a1[q];
#pragma unroll
        for (int o = 1; o < 64; o <<= 1)
#pragma unroll
            for (int q = 0; q < 4; ++q) sm[q] += __shfl_xor(sm[q], o);
#pragma unroll
        for (int q = 0; q < 4; ++q) { const float mu = sm[q] * (1.0f / 128.0f); d0[q] = a0[q] - mu; d1[q] = a1[q] - mu; vr[q] = d0[q] * d0[q] + d1[q] * d1[q]; }
#pragma unroll
        for (int o = 1; o < 64; o <<= 1)
#pragma unroll
            for (int q = 0; q < 4; ++q) vr[q] += __shfl_xor(vr[q], o);
#pragma unroll
        for (int q = 0; q < 4; ++q) { const float rs = 1.0f / sqrtf(vr[q] * (1.0f / 128.0f) + NORM_EPS);
            const float y0 = d0[q] * rs * gg.x + gb.x, y1 = d1[q] * rs * gg.y + gb.y;
            const float s0 = y0 * __builtin_amdgcn_rcpf(1.0f + __builtin_amdgcn_exp2f(-1.4426950408889634f * y0)), s1 = y1 * __builtin_amdgcn_rcpf(1.0f + __builtin_amdgcn_exp2f(-1.4426950408889634f * y1));
            *(unsigned*)(MIX + (size_t)(i0 + tg + q) * DM + 1024 + c) = pk2(s0, s1); }
    }
    __syncthreads();
}
#ifndef P2_REP_ATT
#define P2_REP_ATT 1u
#endif
#ifndef P2_REP_CONV
#define P2_REP_CONV 1u
#endif
__device__ __forceinline__ unsigned p2_pop(unsigned* ctl, unsigned x, volatile LAS unsigned* MISC) {
    unsigned s = MISC[5];
    while (s < 8u) { const unsigned h = (x + s) & 7u; const unsigned i = __hip_atomic_fetch_add(ctl + CW_QUEUE + 16 * h, 1u, RLX_AGENT); if (i < (unsigned)N_ATT_ENT * P2_REP_ATT) { MISC[5] = s; return (i % (unsigned)N_ATT_ENT) * 8u + h; } ++s; }
    MISC[5] = 8u;
    { const unsigned i = __hip_atomic_fetch_add(ctl + CW_QUEUE + 16 * 8, 1u, RLX_AGENT); return (unsigned)N_ATT_ITEMS + (i < (unsigned)N_CONV_ITEMS * P2_REP_CONV ? i % (unsigned)N_CONV_ITEMS : (unsigned)N_CONV_ITEMS); }
}
__device__ __forceinline__ void p2_attn_conv(const Args& a, unsigned char* lds, volatile LAS unsigned* MISC, unsigned* ctl, int tid, unsigned xcc, int bid, int G) {
    const bool cv_first = ((bid >> 3) & 15) >= 7;
    if (cv_first) cv_stream_dma<1>(a, lds, MISC, ctl + CW_QUEUE + 16 * 9, tid, bid, G, CV_P1_JOBS);
    if (tid == 0) { MISC[5] = 0u; MISC[0] = p2_pop(ctl, xcc, MISC); MISC[1] = p2_pop(ctl, xcc, MISC); }
    __syncthreads();
    int ia = __builtin_amdgcn_readfirstlane((int)MISC[0]), ib = __builtin_amdgcn_readfirstlane((int)MISC[1]);
    __syncthreads();
    if (ia < N_ATT_ITEMS) {
        fox::FoxRef cur = att_decode(ia, a, ctl); fox::FoxSeam S; S.unused = 0;
        bool primed = false;
        for (int k = 0;; ++k) {
            if (tid == 0) MISC[2 + (k & 1)] = p2_pop(ctl, xcc, MISC);
            const bool last = ib >= N_ATT_ITEMS;
            const fox::FoxRef nxt = last ? cur : att_decode(ib, a, ctl);
            if (cur.dummy) {
                if (tid < 256) *(float2*)(cur.ML + tid * 2) = make_float2(-1e30f, 0.f);
                primed = false; __syncthreads();
            } else {
                if (!primed) fox::fox_prime(cur, (char*)lds, S);
                fox::fox_block(cur, nxt, (char*)lds, S);
                primed = true;
            }
            ia = ib; ib = __builtin_amdgcn_readfirstlane((int)MISC[2 + (k & 1)]);
            if (last) break;
            cur = nxt;
        }
    }
    __syncthreads();
    while (ia < N_P2_ITEMS) {
        if (tid == 0) MISC[4] = p2_pop(ctl, xcc, MISC);
        conv_item(a, lds, tid, ia - N_ATT_ITEMS);
        ia = ib; ib = __builtin_amdgcn_readfirstlane((int)MISC[4]);
        __syncthreads();
    }
    if (!cv_first) cv_stream_dma<1>(a, lds, MISC, ctl + CW_QUEUE + 16 * 9, tid, bid, G, CV_P1_JOBS);
}

__device__ __forceinline__ void p3_combine(const Args& a, int lane, int gw, int NGW) {
    const float C2 = 1.4426950408889634f * fox::SCALE;
    const bf16* OP = (const bf16*)(a.ws + WS_OPART); const float* ML = (const float*)(a.ws + WS_ML); bf16* MIX = (bf16*)(a.ws + WS_MIXED);
    float2 ml[4][4], mln[4][4]; unsigned pk[4][4], pkn[4][4];
#define P3_LOAD(MLr, PKr, r0_) do { const int blk_ = (r0_) >> 8, np_ = ((blk_ & 31) >> 3) + 1, slot_ = blk_ * 4;                                               \
        _Pragma("unroll") for (int q = 0; q < 4; ++q) _Pragma("unroll") for (int p = 0; p < 4; ++p) { const int pp_ = p < np_ ? p : np_ - 1, row_ = ((r0_) & 255) + q; \
            MLr[q][p] = *(const float2*)(ML + (size_t)(slot_ + pp_) * 512 + row_ * 2); PKr[q][p] = *(const unsigned*)(OP + ((size_t)(slot_ + pp_) * 256 + row_) * HDIM + 2 * lane); } \
        asm volatile("" ::: "memory"); __builtin_amdgcn_sched_barrier(0); } while (0)
    int r0 = 4 * gw;
    if (r0 < 256 * 256) P3_LOAD(ml, pk, r0);
    for (; r0 < 256 * 256; r0 += 4 * NGW) {
        { const int rn = r0 + 4 * NGW < 256 * 256 ? r0 + 4 * NGW : r0; P3_LOAD(mln, pkn, rn); }
        const int blk = r0 >> 8, head = blk >> 5, qb = blk & 31, np = (qb >> 3) + 1;
#pragma unroll
        for (int q = 0; q < 4; ++q) { const int row = (r0 & 255) + q; float M = -3.0e38f;
#pragma unroll
            for (int p = 0; p < 4; ++p) if (p < np && ml[q][p].y > 0.f) M = fmaxf(M, ml[q][p].x);
            float a0 = 0.f, a1 = 0.f, den = 0.f;
#pragma unroll
            for (int p = 0; p < 4; ++p) if (p < np && ml[q][p].y > 0.f) { const float w = __builtin_amdgcn_exp2f((ml[q][p].x - M) * C2) * ml[q][p].y; a0 += w * bf_lo(pk[q][p]); a1 += w * bf_hi(pk[q][p]); den += w; }
            const float inv = den > 0.f ? 1.0f / den : 0.f;
            *(unsigned*)(MIX + (size_t)(qb * 256 + row) * DM + head * HDIM + 2 * lane) = pk2(a0 * inv, a1 * inv); }
#pragma unroll
        for (int q = 0; q < 4; ++q)
#pragma unroll
            for (int p = 0; p < 4; ++p) { ml[q][p] = mln[q][p]; pk[q][p] = pkn[q][p]; }
    }
#undef P3_LOAD
}

__device__ __forceinline__ void p5_router(const Args& a, unsigned char* lds, unsigned* ctl, int tid, int lane, int wave, int bid, int G) {
    const float* Hh = (const float*)(a.ws + WS_H); unsigned char* HN2 = a.ws + WS_HN2;
    int* TE = (int*)(a.ws + WS_ROUTE); int* TS = TE + SEQ * 4; float* TG = (float*)(TS + SEQ * 4);
    float* part = (float*)lds; float* ssq = part + 8 * 32 * 33; float* logit = ssq + 8 * 32; float* rstd_l = logit + 32 * 33; unsigned* lcnt = (unsigned*)(rstd_l + 32);
    unsigned* CNTW = (unsigned*)(a.ws + WS_ROUTE) + 4 * SEQ * 4;
    const float* g2 = a.in[I_G2]; const float* rw = a.in[I_RW];
    for (int grp = bid; grp < SEQ / 32; grp += G) {
        const int t0 = grp * 32, i = lane & 31, kk = lane >> 5, kb = wave * 256;
        f32x16 acc = {}, accb = {}; float ss = 0.f;
        const float* hrow = Hh + (size_t)(t0 + i) * DM + kb + 4 * kk;
        f32x4 hA[4], gA[4], hB[4], gB[4], hC[4], gC[4]; float rA[4][4], rB[4][4], rC[4][4];
        unsigned rwo = (unsigned)((4 * kk * NEXP + i) * 4), g2o = (unsigned)(4 * kk * 4); asm volatile("" : "+v"(rwo), "+v"(g2o));
        const char* rwb = (const char*)(rw + (size_t)kb * NEXP); const char* g2b = (const char*)(g2 + kb);
#define P5_LOAD(H, Gv, R, c0) do { _Pragma("unroll") for (int c = 0; c < 4; ++c) {                                                                             \
            H[c] = *(const f32x4*)(hrow + 8 * ((c0) + c)); Gv[c] = *(const f32x4*)(g2b + g2o + 32 * ((c0) + c));                                              \
            _Pragma("unroll") for (int q = 0; q < 4; ++q) R[c][q] = *(const float*)(rwb + rwo + (8 * ((c0) + c) + q) * (NEXP * 4)); }                          \
        asm volatile("" ::: "memory"); __builtin_amdgcn_sched_barrier(0); } while (0)
#define P5_MMA(H, Gv, R) do { _Pragma("unroll") for (int c = 0; c < 4; ++c) { _Pragma("unroll") for (int q = 0; q < 4; q += 2) {                               \
            acc = __builtin_amdgcn_mfma_f32_32x32x2f32(H[c][q], R[c][q] * Gv[c][q], acc, 0, 0, 0);                                                              \
            accb = __builtin_amdgcn_mfma_f32_32x32x2f32(H[c][q + 1], R[c][q + 1] * Gv[c][q + 1], accb, 0, 0, 0);                                                \
            ss += H[c][q] * H[c][q] + H[c][q + 1] * H[c][q + 1]; } } __builtin_amdgcn_sched_barrier(0); } while (0)
        P5_LOAD(hA, gA, rA, 0); P5_LOAD(hB, gB, rB, 4); P5_LOAD(hC, gC, rC, 8);
        P5_MMA(hA, gA, rA); P5_LOAD(hA, gA, rA, 12);
        P5_MMA(hB, gB, rB); P5_LOAD(hB, gB, rB, 16);
        P5_MMA(hC, gC, rC); P5_LOAD(hC, gC, rC, 20);
        P5_MMA(hA, gA, rA); P5_LOAD(hA, gA, rA, 24);
        P5_MMA(hB, gB, rB); P5_LOAD(hB, gB, rB, 28);
        P5_MMA(hC, gC, rC); P5_MMA(hA, gA, rA); P5_MMA(hB, gB, rB);
#undef P5_LOAD
#undef P5_MMA
#pragma unroll
        for (int r = 0; r < 16; ++r) acc[r] += accb[r];
        const float rb0 = a.in[I_RB][2 * (tid & 15)], rb1 = a.in[I_RB][2 * (tid & 15) + 1];
        f32x4 gv[8], hv[4][8];
#pragma unroll
        for (int j = 0; j < 8; ++j) gv[j] = ((const f32x4*)g2)[lane + 64 * j];
#pragma unroll
        for (int r = 0; r < 4; ++r) { const float* hr = Hh + (size_t)(t0 + wave * 4 + r) * DM;
#pragma unroll
            for (int j = 0; j < 8; ++j) hv[r][j] = ((const f32x4*)hr)[lane + 64 * j]; }
        asm volatile("" ::: "memory"); __builtin_amdgcn_sched_barrier(0);
        ss += __shfl_xor(ss, 32);
        if (kk == 0) ssq[wave * 32 + i] = ss;
        if (tid < NEXP) lcnt[tid] = 0u;
#pragma unroll
        for (int r = 0; r < 16; ++r) { const int row = (r & 3) + 8 * (r >> 2) + 4 * kk; part[(wave * 32 + row) * 33 + i] = acc[r]; }
        __syncthreads();
        { const int tk = tid >> 4, e0 = 2 * (tid & 15); float sq = 0.f;
#pragma unroll
          for (int w = 0; w < 8; ++w) sq += ssq[w * 32 + tk];
          const float rs = 1.0f / sqrtf(sq * (1.0f / DM) + NORM_EPS);
          if ((tid & 15) == 0) rstd_l[tk] = rs;
#pragma unroll
          for (int d = 0; d < 2; ++d) { float s = 0.f;
#pragma unroll
              for (int w = 0; w < 8; ++w) s += part[(w * 32 + tk) * 33 + e0 + d];
              logit[tk * 33 + e0 + d] = s * rs + (d ? rb1 : rb0); } }
        __syncthreads();
        if (tid < 32) {
            unsigned taken = 0u; float tv[4]; int ti[4];
#pragma unroll
            for (int k = 0; k < 4; ++k) { float best = -3.0e38f; int bi = 0;
                for (int e = 0; e < NEXP; ++e) { const float v = logit[tid * 33 + e]; if (!((taken >> e) & 1u) && v > best) { best = v; bi = e; } }
                taken |= 1u << bi; tv[k] = best; ti[k] = bi; }
            float w[4], sum = 0.f;
#pragma unroll
            for (int k = 0; k < 4; ++k) { w[k] = expf(tv[k] - tv[0]); sum += w[k]; }
            const float inv = 1.0f / sum;
#pragma unroll
            for (int k = 0; k < 4; ++k) { const unsigned lr = atomicAdd(&lcnt[ti[k]], 1u);
                TE[(t0 + tid) * 4 + k] = ti[k]; TS[(t0 + tid) * 4 + k] = (int)lr; TG[(t0 + tid) * 4 + k] = w[k] * inv; }
        }
        __syncthreads();
        if (tid < NEXP) CNTW[grp * NEXP + tid] = lcnt[tid];
        {
#pragma unroll
            for (int r = 0; r < 4; ++r) { const int tk = wave * 4 + r; const float rs = rstd_l[tk]; unsigned char* orow = HN2 + (size_t)(t0 + tk) * DM;
#pragma unroll
                for (int j = 0; j < 8; ++j) { const f32x4 y = hv[r][j] * rs * gv[j];
                    int d = __builtin_amdgcn_cvt_pk_fp8_f32(y[0], y[1], 0, false); d = __builtin_amdgcn_cvt_pk_fp8_f32(y[2], y[3], d, true);
                    ((int*)orow)[lane + 64 * j] = d; } } }
        __syncthreads();
    }
}

__device__ __forceinline__ void p6_gather(const Args& a, unsigned char* lds, unsigned* ctl, int tid, int lane, int wave, int bid, int G) {
    const unsigned* CNTW = (const unsigned*)(a.ws + WS_ROUTE) + 4 * SEQ * 4;
    int* psum = (int*)lds;
    int* tst = psum + 16 * NEXP;
    int* gbase = tst + NEXP;
    const int* TE = (const int*)(a.ws + WS_ROUTE); const int* TS = TE + SEQ * 4; int* TR = (int*)(a.ws + WS_ROUTE) + 3 * SEQ * 4;
    const unsigned char* HN2 = a.ws + WS_HN2; unsigned char* XG = a.ws + WS_XG;
    const int g0 = bid < SEQ / 32 ? bid : 0;
    v4u v[4][2]; int te[4][4], ts[4][4]; int c2[15];
#define P6_LOADG(grp_) do { _Pragma("unroll") for (int r = 0; r < 4; ++r) { const int t = (grp_) * 32 + wave * 4 + r;                                   \
            _Pragma("unroll") for (int j = 0; j < 2; ++j) v[r][j] = ((const v4u*)(HN2 + (size_t)t * DM))[lane + 64 * j];                                \
            _Pragma("unroll") for (int k = 0; k < 4; ++k) { te[r][k] = TE[t * 4 + k]; ts[r][k] = TS[t * 4 + k]; } }                                     \
        _Pragma("unroll") for (int u = 0; u < 15; ++u) { const int w = ((grp_) >> 4) * 16 + u; c2[u] = (int)CNTW[(w < (grp_) ? w : 0) * NEXP + (tid & 31)]; } \
        asm volatile("" ::: "memory"); __builtin_amdgcn_sched_barrier(0); } while (0)
    P6_LOADG(g0);
    { const int e = tid & 31, p = tid >> 5; int s = 0;
#pragma unroll
      for (int w = 0; w < 16; ++w) s += (int)CNTW[(p * 16 + w) * NEXP + e];
      psum[p * NEXP + e] = s; }
    __syncthreads();
    if (tid < 64) {
        int c = 0;
        if (tid < NEXP) {
#pragma unroll
            for (int p = 0; p < 16; ++p) c += psum[p * NEXP + tid]; }
        const int nt = (c + 255) >> 8; int incl = nt;
#pragma unroll
        for (int o = 1; o < 32; o <<= 1) { const int n = __shfl_up(incl, o); if ((tid & 63) >= o) incl += n; }
        const int s0 = incl - nt;
        if (tid < NEXP) { tst[tid] = s0;
            if (bid == 0) { for (int i = 0; i < nt; ++i) ctl[CW_TEXP + s0 + i] = (unsigned)tid; if (tid == NEXP - 1) ctl[CW_NT] = (unsigned)incl; } }
    }
    __syncthreads();
    for (int grp = bid; grp < SEQ / 32; grp += G) {
        if (grp != g0) { P6_LOADG(grp); }
        if (tid < NEXP) { int s = 0; const int pp = grp >> 4; for (int p = 0; p < pp; ++p) s += psum[p * NEXP + tid];
#pragma unroll
            for (int u = 0; u < 15; ++u) s += (pp * 16 + u < grp) ? c2[u] : 0;
            gbase[tid] = tst[tid] * 256 + s; }
        __syncthreads();
        {
#pragma unroll
            for (int r = 0; r < 4; ++r) { const int t = grp * 32 + wave * 4 + r;
#pragma unroll
                for (int k = 0; k < 4; ++k) { const int row = gbase[te[r][k]] + ts[r][k];
                    if (lane == 0) TR[t * 4 + k] = row;
#pragma unroll
                    for (int j = 0; j < 2; ++j) ((v4u*)(XG + (size_t)row * DM))[lane + 64 * j] = v[r][j]; } } }
        __syncthreads();
    }
#undef P6_LOADG
}

__device__ __forceinline__ void p9_final(const Args& a, int lane, int gw, int NGW) {
    const float* Hh = (const float*)(a.ws + WS_H); const unsigned char* Y = a.ws + WS_Y;
    const float* TG = (const float*)(a.ws + WS_ROUTE) + 2 * SEQ * 4; const int* TR = (const int*)(a.ws + WS_ROUTE) + 3 * SEQ * 4;
    typedef float f32x2_ __attribute__((ext_vector_type(2)));
    f32x4 gfv[8];
#pragma unroll
    for (int j = 0; j < 8; ++j) gfv[j] = ((const f32x4*)a.in[I_GF])[lane + 64 * j];
    f32x4 tg[2], tgn[2]; int tr[2][4], trn[2][4];
    int t0 = 2 * gw;
    { const int tl = t0 < SEQ ? t0 : 0;
#pragma unroll
      for (int q = 0; q < 2; ++q) { tg[q] = *(const f32x4*)(TG + (tl + q) * 4);
#pragma unroll
          for (int k = 0; k < 4; ++k) tr[q][k] = TR[(tl + q) * 4 + k]; } }
    for (; t0 < SEQ; t0 += 2 * NGW) {
        f32x4 v[2][8];
        { const int tn = t0 + 2 * NGW < SEQ ? t0 + 2 * NGW : t0;
#pragma unroll
          for (int q = 0; q < 2; ++q) { tgn[q] = *(const f32x4*)(TG + (tn + q) * 4);
#pragma unroll
              for (int k = 0; k < 4; ++k) trn[q][k] = TR[(tn + q) * 4 + k]; } }
#pragma unroll
        for (int q = 0; q < 2; ++q) {
#pragma unroll
            for (int j = 0; j < 8; ++j) v[q][j] = ((const f32x4*)(Hh + (size_t)(t0 + q) * DM))[lane + 64 * j]; }
        int pk[2][4][8];
#pragma unroll
        for (int q = 0; q < 2; ++q)
#pragma unroll
            for (int k = 0; k < 4; ++k) { const unsigned char* yr = Y + (size_t)tr[q][k] * DM;
#pragma unroll
                for (int j = 0; j < 8; ++j) pk[q][k][j] = ((const int*)yr)[lane + 64 * j]; }
        asm volatile("" ::: "memory"); __builtin_amdgcn_sched_barrier(0);
#pragma unroll
        for (int q = 0; q < 2; ++q) {
#pragma unroll
            for (int k = 0; k < 4; ++k) { const float g = tg[q][k];
#pragma unroll
                for (int j = 0; j < 8; ++j) { const f32x2_ lo = __builtin_amdgcn_cvt_pk_f32_fp8(pk[q][k][j], false), hi = __builtin_amdgcn_cvt_pk_f32_fp8(pk[q][k][j], true);
                    v[q][j][0] += g * lo[0]; v[q][j][1] += g * lo[1]; v[q][j][2] += g * hi[0]; v[q][j][3] += g * hi[1]; } }
            float ss = 0.f;
#pragma unroll
            for (int j = 0; j < 8; ++j) ss += (v[q][j][0] * v[q][j][0] + v[q][j][1] * v[q][j][1]) + (v[q][j][2] * v[q][j][2] + v[q][j][3] * v[q][j][3]);
            ss = wave_sum(ss);
            const float rstd = 1.0f / sqrtf(ss * (1.0f / DM) + NORM_EPS);
#pragma unroll
            for (int j = 0; j < 8; ++j) ((f32x4*)(a.out + (size_t)(t0 + q) * DM))[lane + 64 * j] = v[q][j] * rstd * gfv[j]; }
#pragma unroll
        for (int q = 0; q < 2; ++q) {
#pragma unroll
            for (int k = 0; k < 4; ++k) { tg[q][k] = __uint_as_float(__builtin_amdgcn_readfirstlane(__float_as_uint(tgn[q][k]))); tr[q][k] = __builtin_amdgcn_readfirstlane(trn[q][k]); } }
    }
}

#ifndef MK_PER_PHASE
#define MK_PER_PHASE 0
#endif
constexpr int N_PHASES = 10;
#ifndef PROBE_TS
#define PROBE_TS 0
#endif

#ifndef PROBE_DBL
#define PROBE_DBL 0
#endif
template <int LO, int HI> __global__ void __launch_bounds__(NTHREADS, 2) hymba_fwd(Args a_in) {
    extern __shared__ __attribute__((aligned(16))) unsigned char lds[];
    const int tid0 = threadIdx.x, bid = blockIdx.x, G = gridDim.x;
    volatile LAS unsigned* MISC = (volatile LAS unsigned*)((LAS unsigned char*)lds + MISC_OFF);
    unsigned* ctl = (unsigned*)(a_in.ws + WS_CTL);
#if defined(__HIP_DEVICE_COMPILE__)
#define PHASE_ARGS() const __attribute__((address_space(4))) Args* ap_ = (const __attribute__((address_space(4))) Args*)__builtin_amdgcn_kernarg_segment_ptr(); asm volatile("" : "+s"(ap_)); const Args a = *ap_; int tid = threadIdx.x; asm volatile("" : "+v"(tid)); const int lane = tid & 63, wave = __builtin_amdgcn_readfirstlane(tid >> 6), gw = bid * NWAVES + wave, NGW = G * NWAVES; (void)lane; (void)gw; (void)NGW
#else
#define PHASE_ARGS() const Args& a = a_in; const int tid = threadIdx.x, lane = tid & 63, wave = tid >> 6, gw = bid * NWAVES + wave, NGW = G * NWAVES; (void)lane; (void)gw; (void)NGW
#endif
    for (int u = tid0; u < (LDS_BYTES - MISC_OFF) / 4; u += NTHREADS) MISC[u] = 0u;
    __syncthreads();
    if (PROBE_TS && bid == 0 && tid0 == 0) ((unsigned long long*)(ctl + 16384))[0] = wall_clock64();
    XcdBarrier bar; bar.bar = ctl + CW_BAR; bar.x = 0; bar.st = nullptr;
    if (HI - LO > 1) bar = xcd_barrier_post(ctl + CW_BAR, MISC + 8);
#ifndef PH_MASK
#define PH_MASK 0x3ff
#endif
#define IN(k) ((((PH_MASK) >> (k)) & 1) && LO <= (k) && (k) < HI)
#define SEAM(k) do { if (IN(k) && IN((k) + 1)) { xcd_barrier(bar); if (PROBE_DBL & 1024) xcd_barrier(bar); if (PROBE_TS && bid == 0 && threadIdx.x == 0) ((unsigned long long*)(ctl + 16384))[(k) + 1] = wall_clock64(); } } while (0)

    if (IN(0)) { PHASE_ARGS(); p0_prologue(a, lds, tid, lane, wave, bid, G); if (PROBE_DBL & 1) { __syncthreads(); p0_prologue(a, lds, tid, lane, wave, bid, G); } } SEAM(0);
    if (IN(1)) { PHASE_ARGS();
        if (bid >= G - NHEAD) p1_cumsum(a, lds, tid, lane, wave, bid - (G - NHEAD));
        pg8::Gemm g{(const pg8::bf16_t*)(a.ws + WS_HN), (const pg8::bf16_t*)(a.ws + WS_WIN), MIN_ROWS, NIN, DM}; pg8::StaticOrder S; S.init(MIN_ROWS, NIN, G, bid);
        pg8::EpiIn E{(pg8::bf16_t*)(a.ws + WS_Q), WS_K - WS_Q, WS_V - WS_Q, (pg8::bf16_t*)(a.ws + WS_U), a.in[I_BGLU], ctl + CW_NORM};
        pg8::gemm_phase<pg8::EpiIn, pg8::StaticOrder, true, true>((PG8_LAS unsigned char*)lds, g, S, E);
        if (PROBE_DBL & 2) pg8::gemm_phase<pg8::EpiIn, pg8::StaticOrder, true, true>((PG8_LAS unsigned char*)lds, g, S, E);
        if (G == 256 && bid >= G - CV_P1_WGS) { __syncthreads(); cv_stream_dma<2>(a, lds, nullptr, nullptr, tid, bid, G, 0, bid - (G - CV_P1_WGS), CV_P1_WGS, CV_P1_NB); }
        else if (G != 256 && bid == 0) { __syncthreads(); cv_stream_dma<2>(a, lds, nullptr, nullptr, tid, bid, G, 0, 0, 1, CV_P1_WGS * CV_P1_NB); }
    } SEAM(1);
    if (IN(2)) { PHASE_ARGS(); p2_attn_conv(a, lds, MISC, ctl, tid, xb_xcc_id(), bid, G); } SEAM(2);
    if (IN(3)) { PHASE_ARGS(); p3_combine(a, lane, gw, NGW); if (PROBE_DBL & 8) p3_combine(a, lane, gw, NGW); } SEAM(3);
    if (IN(4)) { PHASE_ARGS();
        pg8::Gemm g{(const pg8::bf16_t*)(a.ws + WS_MIXED), (const pg8::bf16_t*)(a.ws + WS_WOUT), SEQ, DM, DM}; pg8::StaticOrder S; S.init(SEQ, DM, G, bid);
        pg8::EpiOut E{a.in[I_X], (float*)(a.ws + WS_H)};
        pg8::gemm_phase<pg8::EpiOut, pg8::StaticOrder, true, true>((PG8_LAS unsigned char*)lds, g, S, E);
        if (PROBE_DBL & 16) pg8::gemm_phase<pg8::EpiOut, pg8::StaticOrder, true, true>((PG8_LAS unsigned char*)lds, g, S, E);
    } SEAM(4);
    if (IN(5)) { PHASE_ARGS(); p5_router(a, lds, ctl, tid, lane, wave, bid, G); if (PROBE_DBL & 32) p5_router(a, lds, ctl, tid, lane, wave, bid, G); } SEAM(5);
    if (IN(6)) { PHASE_ARGS(); p6_gather(a, lds, ctl, tid, lane, wave, bid, G); if (PROBE_DBL & 64) p6_gather(a, lds, ctl, tid, lane, wave, bid, G); } SEAM(6);
    if (IN(7)) { PHASE_ARGS();
        const int T = (int)__hip_atomic_load(ctl + CW_NT, RLX_AGENT);
        pg8::Gemm g{(const pg8::bf16_t*)(a.ws + WS_XG), (const pg8::bf16_t*)(a.ws + WS_WGU), PROWS, NEXP * 4096, DM  }; for (int i = tid; i < MAXT; i += NTHREADS) MISC[64 + i] = __hip_atomic_load(ctl + CW_TEXP + i, RLX_AGENT);
        __syncthreads();
        pg8::GroupedOrder S; S.init((const volatile PG8_LAS int*)(MISC + 64), T, 16, G, bid);
        pg8::EpiGU E{a.ws + WS_ACT, a.in[I_BGU], W8_INV};
        pg8::gemm_phase<pg8::EpiGU, pg8::GroupedOrder, true, true, true>((PG8_LAS unsigned char*)lds, g, S, E);
        if (PROBE_DBL & 128) pg8::gemm_phase<pg8::EpiGU, pg8::GroupedOrder, true, true, true>((PG8_LAS unsigned char*)lds, g, S, E);
    } SEAM(7);
    if (IN(8)) { PHASE_ARGS();
        const int T = (int)__hip_atomic_load(ctl + CW_NT, RLX_AGENT);
        pg8::Gemm g{(const pg8::bf16_t*)(a.ws + WS_ACT), (const pg8::bf16_t*)(a.ws + WS_WDN), PROWS, NEXP * DM, DM}; for (int i = tid; i < MAXT; i += NTHREADS) MISC[64 + i] = __hip_atomic_load(ctl + CW_TEXP + i, RLX_AGENT);
        __syncthreads();
        pg8::GroupedOrder S; S.init((const volatile PG8_LAS int*)(MISC + 64), T, 8, G, bid);
        pg8::EpiDN E{a.ws + WS_Y, a.in[I_BDN], W8_INV};
        pg8::gemm_phase<pg8::EpiDN, pg8::GroupedOrder, true, true, true>((PG8_LAS unsigned char*)lds, g, S, E);
        if (PROBE_DBL & 256) pg8::gemm_phase<pg8::EpiDN, pg8::GroupedOrder, true, true, true>((PG8_LAS unsigned char*)lds, g, S, E);
    } SEAM(8);
    if (IN(9)) { PHASE_ARGS(); p9_final(a, lane, gw, NGW); if (PROBE_DBL & 512) p9_final(a, lane, gw, NGW);
        if (PROBE_TS) {
            const unsigned long long* ts = (const unsigned long long*)(ctl + 16384);
            const int pa = (PROBE_TS >> 4) & 15, pb = PROBE_TS & 15;
            const float ta = (float)(ts[pa + 1] - ts[pa]) * 0.01f, tb = (float)(ts[pb + 1] - ts[pb]) * 0.01f;
            float M = ta * 0.01f; M = M < 1.0f ? 1.0f : (M > 9.9f ? 9.9f : M); int Ee = 2 + (int)(tb * 0.05f + 0.5f); Ee = Ee > 30 ? 30 : Ee;
            float val = M; for (int i = 0; i < Ee; ++i) val *= 10.0f;
            const float cst = sqrtf(val);
            __syncthreads();
            for (size_t i = (size_t)bid * NTHREADS + tid; i < (size_t)SEQ * DM; i += (size_t)G * NTHREADS) a.out[i] = cst; } }
#undef IN
#undef SEAM
}

template <int LO, int HI> static bool launch_range(const Args& a, int grid, hipStream_t stream) {
    static bool attr = false;
    if (!attr) { attr = true; if (hipFuncSetAttribute((const void*)hymba_fwd<LO, HI>, hipFuncAttributeMaxDynamicSharedMemorySize, LDS_BYTES) != hipSuccess) { fprintf(stderr, "kernel_launch: hipFuncSetAttribute failed\n"); return false; } }
    hipLaunchKernelGGL((hymba_fwd<LO, HI>), dim3(grid), dim3(NTHREADS), LDS_BYTES, stream, a);
    return hipPeekAtLastError() == hipSuccess;
}
extern "C" void kernel_launch(void* const* d_in, const int* in_sizes, int n_in, void* d_out, int out_size, void* d_ws, size_t ws_size, hipStream_t stream) {
    static int grid = 0;
    if (grid == 0) {
        if (n_in != 19 || out_size != SEQ * DM || ws_size < WS_END) { fprintf(stderr, "kernel_launch: unexpected shapes (n_in %d out %d ws %zu)\n", n_in, out_size, ws_size); grid = -1; return; }
        int dev = 0, cus = 0;
        if (hipGetDevice(&dev) != hipSuccess || hipDeviceGetAttribute(&cus, hipDeviceAttributeMultiprocessorCount, dev) != hipSuccess) { grid = -1; return; }
        grid = cus;
    }
    if (grid < 0) return;
    (void)in_sizes;
    if (hipMemsetAsync((char*)d_ws + WS_CTL, 0, CTL_ZERO_BYTES, stream) != hipSuccess) return;
    Args a{};
    for (int i = 0; i < 19; ++i) a.in[i] = (const float*)d_in[i];
    a.out = (float*)d_out; a.ws = (unsigned char*)d_ws;
#if MK_PER_PHASE
    launch_range<0, 1>(a, grid, stream); launch_range<1, 2>(a, grid, stream); launch_range<2, 3>(a, grid, stream); launch_range<3, 4>(a, grid, stream); launch_range<4, 5>(a, grid, stream);
    launch_range<5, 6>(a, grid, stream); launch_range<6, 7>(a, grid, stream); launch_range<7, 8>(a, grid, stream); launch_range<8, 9>(a, grid, stream); launch_range<9, 10>(a, grid, stream);
#else
    launch_range<0, N_PHASES>(a, grid, stream);
#endif
}
```
